# Optimizing an MI355X kernel written in HIP

```python
import jax, jax.numpy as jnp
from jax import lax
import numpy as np

D_MODEL = 1024
BATCH = 16
SEQ = 2048
DEPTH = 1

N_MOD = 6
NORM_EPS = 1e-6
RWKV_HEAD_DIM = 64
RWKV_HEADS = D_MODEL // RWKV_HEAD_DIM
RWKV_WIDTH = RWKV_HEADS * RWKV_HEAD_DIM
DECAY_LORA = 64
A_LORA = 64
GATE_LORA = 128
RWKV_GN_EPS = 64e-5
RWKV_COLS = 3 * RWKV_WIDTH + DECAY_LORA + A_LORA + GATE_LORA
ATTN_GROUPS = ((128, 1), (512, 4), (2048, 16))
N_GROUPS = len(ATTN_GROUPS)
HEADS_PER_GROUP = 4
ATTN_HEAD_DIM = 64
ATTN_WIDTH = N_GROUPS * HEADS_PER_GROUP * ATTN_HEAD_DIM
ATTN_OUT_WIDTH = HEADS_PER_GROUP * ATTN_HEAD_DIM
ROPE_DIM = ATTN_HEAD_DIM // 4
ROPE_THETA = 500000.0
IN_SPLITS = (RWKV_COLS, ATTN_WIDTH, ATTN_WIDTH, ATTN_WIDTH, D_MODEL, D_MODEL)
IN_COLS = sum(IN_SPLITS)
PEER_HEADS = 8
PEER_N_KEYS = 128
PEER_N_EXPERTS = PEER_N_KEYS * PEER_N_KEYS
PEER_QUERY_DIM = 256
PEER_HALF = PEER_QUERY_DIM // 2
PEER_TOPK = 16
PEER_CHUNK = 128

kernel_name = 'hybrid_rwkv7_dilated_attn_peer_block'


def _split(z, sizes):
    offs = np.cumsum(sizes)[:-1].tolist()
    return jnp.split(z, offs, axis=-1)


def rmsnorm(x, g):
    xf = x.astype(jnp.float32)
    y = xf * lax.rsqrt(jnp.mean(xf * xf, axis=-1, keepdims=True) + NORM_EPS)
    return (y * g.astype(jnp.float32)).astype(x.dtype)


def modulate(n, shift, scale):
    return n * (1 + scale[:, None, :]) + shift[:, None, :]


def partial_rope(x, pos):
    half = ROPE_DIM // 2
    inv = ROPE_THETA ** (-jnp.arange(half, dtype=jnp.float32) / half)
    ang = pos.astype(jnp.float32)[:, None] * inv[None, :]
    bshape = (pos.shape[0],) + (1,) * (x.ndim - 3) + (half,)
    cos, sin = jnp.cos(ang).reshape(bshape), jnp.sin(ang).reshape(bshape)
    xf = x.astype(jnp.float32)
    x1, x2, xp = xf[..., :half], xf[..., half:ROPE_DIM], xf[..., ROPE_DIM:]
    out = jnp.concatenate([x1 * cos - x2 * sin, x2 * cos + x1 * sin, xp], axis=-1)
    return out.astype(x.dtype)


def wkv7_scan(r, w, k, v, a, b):
    B, S, H, N = r.shape
    xs = tuple(t.astype(jnp.float32).transpose(1, 0, 2, 3) for t in (r, w, k, v, a, b))

    def step(state, inp):
        r_t, w_t, k_t, v_t, a_t, b_t = inp
        sa = jnp.einsum('bhij,bhj->bhi', state, a_t)
        state = (state * w_t[:, :, None, :] + sa[..., None] * b_t[:, :, None, :]
                 + v_t[..., None] * k_t[:, :, None, :])
        return state, jnp.einsum('bhij,bhj->bhi', state, r_t)

    init = jnp.zeros((B, H, N, N), jnp.float32)
    _, ys = lax.scan(step, init, xs)
    return ys.transpose(1, 0, 2, 3)


def rwkv7_time_mix(z, rwkv_mu, w0, w2, a0, a2, g2, k_k, k_a, r_k, lnx_g, lnx_b):
    B, S, _ = z.shape
    H, N = RWKV_HEADS, RWKV_HEAD_DIM
    z_prev = jnp.pad(z, ((0, 0), (1, 0), (0, 0)))[:, :-1]
    z = z + (z_prev - z) * rwkv_mu
    r, k, v, wl, al, gl = _split(z, (RWKV_WIDTH, RWKV_WIDTH, RWKV_WIDTH, DECAY_LORA, A_LORA, GATE_LORA))
    w = -jax.nn.softplus(-(w0 + jnp.tanh(wl) @ w2)) - 0.5
    decay = jnp.exp(-jnp.exp(w.astype(jnp.float32)))
    a = jax.nn.sigmoid(a0 + al @ a2)
    g = jax.nn.sigmoid(gl) @ g2
    hv = lambda t: t.reshape(B, S, H, N)
    kk = hv(k * k_k).astype(jnp.float32)
    kk = kk / jnp.maximum(jnp.linalg.norm(kk, axis=-1, keepdims=True), 1e-12)
    k = k * (1 + (a - 1) * k_a)
    r_h, k_h, v_h, a_h = hv(r), hv(k), hv(v), hv(a)
    y = wkv7_scan(r_h, hv(decay), k_h, v_h, -kk, kk * a_h)
    mu = jnp.mean(y, axis=-1, keepdims=True)
    var = jnp.mean(jnp.square(y - mu), axis=-1, keepdims=True)
    y = (y - mu) * lax.rsqrt(var + RWKV_GN_EPS) * lnx_g.reshape(H, N) + lnx_b.reshape(H, N)
    y = y + jnp.sum(r_h * k_h * r_k, axis=-1, keepdims=True) * v_h
    return y.reshape(B, S, RWKV_WIDTH).astype(z.dtype) * g


def dilated_group_attention(q, k, v, window, dilation):
    B, S, H, hd = q.shape
    L = S // dilation
    blk = window // dilation
    nb = -(-L // blk)
    Lp = nb * blk

    def to_sub(t):
        t = t.reshape(B, L, dilation, H, hd).transpose(0, 2, 3, 1, 4)
        t = jnp.pad(t, ((0, 0), (0, 0), (0, 0), (0, Lp - L), (0, 0)))
        return t.reshape(B, dilation, H, nb, blk, hd).astype(jnp.float32)

    qb, kb, vb = to_sub(q), to_sub(k), to_sub(v)

    def band(t):
        prev = jnp.pad(t, ((0, 0), (0, 0), (0, 0), (1, 0), (0, 0), (0, 0)))[:, :, :, :-1]
        return jnp.concatenate([prev, t], axis=-2)

    kk, vv = band(kb), band(vb)
    s = jnp.einsum('bdhnqe,bdhnke->bdhnqk', qb, kk) * (hd ** -0.5)
    qi = jnp.arange(blk)[:, None]
    kj = jnp.arange(2 * blk)[None, :]
    dist = blk + qi - kj
    band_mask = (dist >= 0) & (dist <= blk)
    mask = band_mask[None] & ((jnp.arange(nb)[:, None, None] > 0) | (kj[None] >= blk))
    s = jnp.where(mask, s, -jnp.inf)
    lse = jax.nn.logsumexp(s, axis=-1)
    p = jnp.exp(s - lse[..., None])
    o = jnp.einsum('bdhnqk,bdhnke->bdhnqe', p, vv)
    o = o.reshape(B, dilation, H, Lp, hd)[:, :, :, :L].transpose(0, 3, 1, 2, 4).reshape(B, S, H, hd)
    lse = lse.reshape(B, dilation, H, Lp)[..., :L].transpose(0, 3, 1, 2).reshape(B, S, H)
    return o, lse


def dilated_attention(zq, zk, zv, q_norm_g, k_norm_g, pos):
    B, S, _ = zq.shape
    shp = (B, S, N_GROUPS, HEADS_PER_GROUP, ATTN_HEAD_DIM)
    q = partial_rope(rmsnorm(zq.reshape(shp), q_norm_g[:, None, :]), pos)
    k = partial_rope(rmsnorm(zk.reshape(shp), k_norm_g[:, None, :]), pos)
    v = zv.reshape(shp)
    outs, lses = [], []
    for gi, (win, dil) in enumerate(ATTN_GROUPS):
        o, l = dilated_group_attention(q[:, :, gi], k[:, :, gi], v[:, :, gi], win, dil)
        outs.append(o)
        lses.append(l)
    wts = jax.nn.softmax(jnp.stack(lses), axis=0)
    y = jnp.sum(wts[..., None] * jnp.stack(outs), axis=0)
    return y.reshape(B, S, ATTN_OUT_WIDTH).astype(zq.dtype)


def peer(u, peer_wq, peer_k1, peer_k2, peer_u, peer_v):
    B, S, D = u.shape
    q = (u @ peer_wq).reshape(B, S, PEER_HEADS, PEER_QUERY_DIM).astype(jnp.float32)
    s1 = jnp.einsum('bshe,ne->bshn', q[..., :PEER_HALF], peer_k1.astype(jnp.float32))
    s2 = jnp.einsum('bshe,ne->bshn', q[..., PEER_HALF:], peer_k2.astype(jnp.float32))
    v1, i1 = lax.top_k(s1, PEER_TOPK)
    v2, i2 = lax.top_k(s2, PEER_TOPK)
    cshape = (B, S, PEER_HEADS, PEER_TOPK * PEER_TOPK)
    cand = (v1[..., :, None] + v2[..., None, :]).reshape(cshape)
    cidx = (i1[..., :, None] * PEER_N_KEYS + i2[..., None, :]).reshape(cshape)
    top, sel = lax.top_k(cand, PEER_TOPK)
    idx = jnp.take_along_axis(cidx, sel, axis=-1)
    gate = jax.nn.softmax(top, axis=-1)
    n_chunks = (B * S) // PEER_CHUNK
    hk = PEER_HEADS * PEER_TOPK
    u_c = u.reshape(n_chunks, PEER_CHUNK, D)
    i_c = idx.reshape(n_chunks, PEER_CHUNK, hk)
    g_c = gate.reshape(n_chunks, PEER_CHUNK, hk)

    def chunk(args):
        uc, ic, gc = args
        ue = jnp.take(peer_u, ic, axis=0)
        act = jax.nn.gelu(jnp.einsum('cd,ced->ce', uc, ue).astype(jnp.float32), approximate=False)
        ve = jnp.take(peer_v, ic, axis=0)
        return jnp.einsum('ce,ced->cd', (gc * act).astype(ve.dtype), ve)

    out = lax.map(chunk, (u_c, i_c, g_c))
    return out.reshape(B, S, D).astype(u.dtype)


def _layer(x, c, pos, w_ada, b_ada, norm1_g, w_in, rwkv_mu, w0, w2, a0, a2, g2, k_k, k_a, r_k,
           lnx_g, lnx_b, q_norm_g, k_norm_g, w_br_rwkv, w_br_attn, w_out, norm2_g,
           peer_wq, peer_k1, peer_k2, peer_u, peer_v):
    mod = jax.nn.silu(c) @ w_ada + b_ada
    sh1, sc1, gt1, sh2, sc2, gt2 = jnp.split(mod, N_MOD, axis=-1)
    n1 = modulate(rmsnorm(x, norm1_g), sh1, sc1)
    z = n1 @ w_in
    z_rwkv, zq, zk, zv, z_gr, z_ga = _split(z, IN_SPLITS)
    y_r = rwkv7_time_mix(z_rwkv, rwkv_mu, w0, w2, a0, a2, g2, k_k, k_a, r_k, lnx_g, lnx_b)
    y_a = dilated_attention(zq, zk, zv, q_norm_g, k_norm_g, pos)
    merged = jax.nn.sigmoid(z_gr) * (y_r @ w_br_rwkv) + jax.nn.sigmoid(z_ga) * (y_a @ w_br_attn)
    h = x + gt1[:, None, :] * (merged @ w_out)
    n2 = modulate(rmsnorm(h, norm2_g), sh2, sc2)
    return h + gt2[:, None, :] * peer(n2, peer_wq, peer_k1, peer_k2, peer_u, peer_v)


def setup_inputs(seed: int = 0) -> dict:
    key = jax.random.key(seed)
    ks = iter(jax.random.split(key, 32))
    f32 = jnp.float32
    D, L = D_MODEL, DEPTH

    def nrm(shape, scale):
        return jax.random.normal(next(ks), shape, f32) * scale

    return {
        'x': nrm((BATCH, SEQ, D), 1.0),
        'c': nrm((BATCH, D), 1.0),
        'w_ada': nrm((L, D, N_MOD * D), 0.2 * D ** -0.5),
        'b_ada': nrm((L, N_MOD * D), 0.02),
        'norm1_g': 1.0 + nrm((L, D), 0.05),
        'w_in': nrm((L, D, IN_COLS), D ** -0.5),
        'rwkv_mu': jax.random.uniform(next(ks), (L, RWKV_COLS), f32, 0.05, 0.95),
        'w0': nrm((L, RWKV_WIDTH), 0.5) - 1.0,
        'w2': nrm((L, DECAY_LORA, RWKV_WIDTH), 0.5 * DECAY_LORA ** -0.5),
        'a0': nrm((L, RWKV_WIDTH), 0.3),
        'a2': nrm((L, A_LORA, RWKV_WIDTH), A_LORA ** -0.5),
        'g2': nrm((L, GATE_LORA, RWKV_WIDTH), GATE_LORA ** -0.5),
        'k_k': 0.85 + nrm((L, RWKV_WIDTH), 0.05),
        'k_a': 1.0 + nrm((L, RWKV_WIDTH), 0.05),
        'r_k': nrm((L, RWKV_HEADS, RWKV_HEAD_DIM), 0.1),
        'lnx_g': 1.0 + nrm((L, RWKV_WIDTH), 0.05),
        'lnx_b': nrm((L, RWKV_WIDTH), 0.02),
        'q_norm_g': 1.0 + nrm((L, N_GROUPS, ATTN_HEAD_DIM), 0.05),
        'k_norm_g': 1.0 + nrm((L, N_GROUPS, ATTN_HEAD_DIM), 0.05),
        'w_br_rwkv': nrm((L, RWKV_WIDTH, D), RWKV_WIDTH ** -0.5),
        'w_br_attn': nrm((L, ATTN_OUT_WIDTH, D), ATTN_OUT_WIDTH ** -0.5),
        'w_out': nrm((L, D, D), D ** -0.5),
        'norm2_g': 1.0 + nrm((L, D), 0.05),
        'peer_wq': nrm((L, D, PEER_HEADS * PEER_QUERY_DIM), D ** -0.5),
        'peer_k1': nrm((L, PEER_N_KEYS, PEER_HALF), PEER_HALF ** -0.5),
        'peer_k2': nrm((L, PEER_N_KEYS, PEER_HALF), PEER_HALF ** -0.5),
        'peer_u': nrm((L, PEER_N_EXPERTS, D), D ** -0.5),
        'peer_v': nrm((L, PEER_N_EXPERTS, D), PEER_HEADS ** -0.5),
    }


def reference(x, c, w_ada, b_ada, norm1_g, w_in, rwkv_mu, w0, w2, a0, a2, g2, k_k, k_a, r_k,
              lnx_g, lnx_b, q_norm_g, k_norm_g, w_br_rwkv, w_br_attn, w_out, norm2_g,
              peer_wq, peer_k1, peer_k2, peer_u, peer_v):
    pos = jnp.arange(x.shape[1], dtype=jnp.int32)
    h = x
    for l in range(DEPTH):
        h = _layer(h, c, pos, w_ada[l], b_ada[l], norm1_g[l], w_in[l], rwkv_mu[l], w0[l], w2[l],
                   a0[l], a2[l], g2[l], k_k[l], k_a[l], r_k[l], lnx_g[l], lnx_b[l],
                   q_norm_g[l], k_norm_g[l], w_br_rwkv[l], w_br_attn[l], w_out[l], norm2_g[l],
                   peer_wq[l], peer_k1[l], peer_k2[l], peer_u[l], peer_v[l])
    return h.astype(x.dtype)
```

```cpp
#include <hip/hip_runtime.h>
#include <hip/hip_cooperative_groups.h>
#include <cstdio>
#include <cstdint>
namespace cg = cooperative_groups;

#ifndef MULTI
#define MULTI 0
#endif
#ifndef DUP
#define DUP -1
#endif

typedef unsigned short u16;
using bf16x8 = __attribute__((ext_vector_type(8))) short;
using bf16x4 = __attribute__((ext_vector_type(4))) short;
using f32x4  = __attribute__((ext_vector_type(4))) float;
using u32x4  = __attribute__((ext_vector_type(4))) unsigned int;
using f32x2  = __attribute__((ext_vector_type(2))) float;

#define DEVINL __device__ __forceinline__

constexpr int T = 32768;
constexpr int SMEM_BYTES = 79872;

struct Params {
  const float *x, *c, *w_ada, *b_ada, *norm1_g, *w_in, *mu, *w0, *w2, *a0, *a2, *g2, *k_k, *k_a, *r_k,
      *lnx_g, *lnx_b, *qng, *kng, *w_br_r, *w_br_a, *w_out, *norm2_g, *wq, *k1, *k2, *pu, *pv;
  float* out;
  u16 *w_in_t, *w_br_r_t, *w_br_a_t, *w_out_t, *wq_t, *k1b, *k2b, *w2t, *a2t, *g2t;
  float *mod, *lse, *usc, *vsc, *n1s, *w_in_s;
  int* colamax;
  unsigned* bar;
  int* ctr;
  u16 *bufB, *z_rkv, *z_lora, *z_attn, *ub, *vb, *gates;
};

DEVINL u16 f2bf(float f) {
  uint32_t u = __float_as_uint(f);
  u += 0x7fffu + ((u >> 16) & 1u);
  return (u16)(u >> 16);
}
DEVINL float bf2f(u16 h) { return __uint_as_float(((uint32_t)h) << 16); }
typedef __bf16 hwbf16x2 __attribute__((ext_vector_type(2)));
DEVINL uint32_t pack2(float a, float b) {
  f32x2 v = {a, b};
  hwbf16x2 r = __builtin_convertvector(v, hwbf16x2);
  return *(uint32_t*)&r;
}
DEVINL float bflo(uint32_t u) { return __uint_as_float(u << 16); }
DEVINL float bfhi(uint32_t u) { return __uint_as_float(u & 0xffff0000u); }
DEVINL float sigm(float x) { return 1.f / (1.f + __expf(-x)); }
template <int CTRL>
DEVINL float dpp_f(float x) {
  return __int_as_float(__builtin_amdgcn_update_dpp(0, __float_as_int(x), CTRL, 0xF, 0xF, true));
}
DEVINL float quad_sum(float v) {
  v += dpp_f<0xB1>(v);
  v += dpp_f<0x4E>(v);
  return v;
}
DEVINL float row16_sum(float v) {
  v += dpp_f<0x128>(v); v += dpp_f<0x124>(v); v += dpp_f<0x122>(v); v += dpp_f<0x121>(v);
  return v;
}
DEVINL float oct_sum(float v) {
  v += dpp_f<0xB1>(v);
  v += dpp_f<0x4E>(v);
  v += dpp_f<0x141>(v);
  return v;
}
DEVINL float row16_max(float v) {
  v = fmaxf(v, dpp_f<0x128>(v)); v = fmaxf(v, dpp_f<0x124>(v)); v = fmaxf(v, dpp_f<0x122>(v)); v = fmaxf(v, dpp_f<0x121>(v));
  return v;
}
DEVINL float wave_sum(float v) {
  v = row16_sum(v);
  v += __shfl_xor(v, 16);
  v += __shfl_xor(v, 32);
  return v;
}
DEVINL float wave_max(float v) {
  v = row16_max(v);
  v = fmaxf(v, __shfl_xor(v, 16));
  v = fmaxf(v, __shfl_xor(v, 32));
  return v;
}

DEVINL void p0_mod_unit(const Params& p, int unit, char* smem) {
  float* sC = (float*)smem;
  const int tid = threadIdx.x, lane = tid & 63, wid = tid >> 6;
  __syncthreads();
  for (int e = tid; e < 16 * 1024; e += 256) {
    int b = e >> 10, k = e & 1023;
    float v = p.c[e];
    sC[k * 16 + b] = v / (1.f + __expf(-v));
  }
  __syncthreads();
  const int col = unit * 64 + lane;
  float acc[16];
#pragma unroll
  for (int b = 0; b < 16; ++b) acc[b] = 0.f;
  const float* wp = p.w_ada + (size_t)(wid * 256) * 6144 + col;
#pragma unroll 16
  for (int k = 0; k < 256; ++k) {
    float wv = wp[(size_t)k * 6144];
    const float4* s4 = (const float4*)(sC + (wid * 256 + k) * 16);
    float4 s0 = s4[0], s1 = s4[1], s2 = s4[2], s3 = s4[3];
    acc[0] += s0.x * wv; acc[1] += s0.y * wv; acc[2] += s0.z * wv; acc[3] += s0.w * wv;
    acc[4] += s1.x * wv; acc[5] += s1.y * wv; acc[6] += s1.z * wv; acc[7] += s1.w * wv;
    acc[8] += s2.x * wv; acc[9] += s2.y * wv; acc[10] += s2.z * wv; acc[11] += s2.w * wv;
    acc[12] += s3.x * wv; acc[13] += s3.y * wv; acc[14] += s3.z * wv; acc[15] += s3.w * wv;
  }
  __syncthreads();
  float* sR = (float*)smem;
#pragma unroll
  for (int b = 0; b < 16; ++b) sR[(wid * 16 + b) * 64 + lane] = acc[b];
  __syncthreads();
  for (int e = tid; e < 1024; e += 256) {
    int b = e >> 6, l = e & 63;
    float s = sR[(b)*64 + l] + sR[(16 + b) * 64 + l] + sR[(32 + b) * 64 + l] + sR[(48 + b) * 64 + l];
    int cc = unit * 64 + l;
    p.mod[b * 6144 + cc] = s + p.b_ada[cc];
  }
}

DEVINL void transpose_tile(const float* __restrict__ src, int K, int N, u16* __restrict__ dst, int tile, char* smem) {
  float(*s)[65] = (float(*)[65])smem;
  const int tid = threadIdx.x;
  const int nkt = K >> 6;
  const int kt = tile % nkt, nt = tile / nkt;
  __syncthreads();
#pragma unroll
  for (int i = 0; i < 16; ++i) {
    int r = (tid >> 6) + 4 * i;
    s[r][tid & 63] = src[(size_t)(kt * 64 + r) * N + nt * 64 + (tid & 63)];
  }
  __syncthreads();
#pragma unroll
  for (int i = 0; i < 16; ++i) {
    int n = (tid >> 6) + 4 * i;
    dst[(size_t)(nt * 64 + n) * K + kt * 64 + (tid & 63)] = f2bf(s[tid & 63][n]);
  }
}

DEVINL void cvt_straight(const float* __restrict__ src, u16* __restrict__ dst, size_t n4, size_t start, size_t stride) {
  for (size_t i = start; i < n4; i += stride) {
    float4 v = ((const float4*)src)[i];
    uint2 o; o.x = pack2(v.x, v.y); o.y = pack2(v.z, v.w);
    ((uint2*)dst)[i] = o;
  }
}

DEVINL void cvt_row_fp4(const float* __restrict__ src, unsigned char* __restrict__ dst, float* __restrict__ inv_scale, int row) {
  const int lane = threadIdx.x & 63;
  {
    const float4* sp = (const float4*)(src + (size_t)row * 1024 + lane * 16);
    float4 v0 = sp[0], v1 = sp[1], v2 = sp[2], v3 = sp[3];
    float am = fmaxf(fmaxf(fmaxf(fabsf(v0.x), fabsf(v0.y)), fmaxf(fabsf(v0.z), fabsf(v0.w))),
                     fmaxf(fmaxf(fabsf(v1.x), fabsf(v1.y)), fmaxf(fabsf(v1.z), fabsf(v1.w))));
    am = fmaxf(am, fmaxf(fmaxf(fmaxf(fabsf(v2.x), fabsf(v2.y)), fmaxf(fabsf(v2.z), fabsf(v2.w))),
                         fmaxf(fmaxf(fabsf(v3.x), fabsf(v3.y)), fmaxf(fabsf(v3.z), fabsf(v3.w)))));
    am = wave_max(am);
    const float sc = (am > 0.f) ? 6.f / am : 1.f;
    const float inv = (am > 0.f) ? am * (1.f / 6.f) : 1.f;
    unsigned w0 = 0, w1 = 0;
    w0 = __builtin_amdgcn_cvt_scalef32_pk_fp4_f32(w0, v0.x * sc, v0.y * sc, 1.0f, 0);
    w0 = __builtin_amdgcn_cvt_scalef32_pk_fp4_f32(w0, v0.z * sc, v0.w * sc, 1.0f, 1);
    w0 = __builtin_amdgcn_cvt_scalef32_pk_fp4_f32(w0, v1.x * sc, v1.y * sc, 1.0f, 2);
    w0 = __builtin_amdgcn_cvt_scalef32_pk_fp4_f32(w0, v1.z * sc, v1.w * sc, 1.0f, 3);
    w1 = __builtin_amdgcn_cvt_scalef32_pk_fp4_f32(w1, v2.x * sc, v2.y * sc, 1.0f, 0);
    w1 = __builtin_amdgcn_cvt_scalef32_pk_fp4_f32(w1, v2.z * sc, v2.w * sc, 1.0f, 1);
    w1 = __builtin_amdgcn_cvt_scalef32_pk_fp4_f32(w1, v3.x * sc, v3.y * sc, 1.0f, 2);
    w1 = __builtin_amdgcn_cvt_scalef32_pk_fp4_f32(w1, v3.z * sc, v3.w * sc, 1.0f, 3);
    *(uint2*)(dst + (size_t)row * 512 + lane * 8) = make_uint2(w0, w1);
    if (lane == 0) inv_scale[row] = inv;
  }
}

DEVINL void cvt_fp4_queue(const Params& p, char* smem) {
  int* sh = (int*)smem;
  const int wid = threadIdx.x >> 6;
  for (;;) {
    __syncthreads();
    if (threadIdx.x == 0) sh[0] = atomicAdd(&p.ctr[2050], 1);
    __syncthreads();
    const int c = sh[0];
    if (c >= 2048) break;
    const bool isv = c >= 1024;
    const int r0 = (c & 1023) * 16 + wid * 4;
#pragma unroll
    for (int i = 0; i < 4; ++i)
      cvt_row_fp4(isv ? p.pv : p.pu, (unsigned char*)(isv ? p.vb : p.ub), isv ? p.vsc : p.usc, r0 + i);
  }
}

DEVINL void late_transpose_queue(const Params& p, char* smem) {
  int* sh = (int*)(smem + 64 * 65 * 4);
  for (;;) {
    __syncthreads();
    if (threadIdx.x == 0) sh[0] = atomicAdd(&p.ctr[2051], 1);
    __syncthreads();
    int t = sh[0];
    if (t >= 1088) break;
    if (t < 256) { transpose_tile(p.w_br_r, 1024, 1024, p.w_br_r_t, t, smem); continue; } t -= 256;
    if (t < 64) { transpose_tile(p.w_br_a, 256, 1024, p.w_br_a_t, t, smem); continue; } t -= 64;
    if (t < 256) { transpose_tile(p.w_out, 1024, 1024, p.w_out_t, t, smem); continue; } t -= 256;
    transpose_tile(p.wq, 1024, 2048, p.wq_t, t, smem);
  }
}

DEVINL void phase0(const Params& p, char* smem) {
  const int G = gridDim.x;
  constexpr int NT0 = 120, NT5 = 16, NT6 = 16, NT7 = 32;
  constexpr int NTR = NT0 + NT5 + NT6 + NT7;
  for (int u = blockIdx.x; u < 96 + NTR; u += G) {
    if (u < 96) { p0_mod_unit(p, u, smem); continue; }
    int t = u - 96;
    if (t < NT0) {
      {
        const int nb = t >> 2, part = t & 3;
        const int n = nb * 256 + threadIdx.x;
        const float* wp = p.w_in + (size_t)(part * 256) * 7680 + n;
        float m = 0.f;
#pragma unroll 16
        for (int k = 0; k < 256; ++k) m = fmaxf(m, fabsf(wp[(size_t)k * 7680]));
        atomicMax(&p.colamax[n], __float_as_int(m));
      }
      continue;
    } t -= NT0;
    if (t < NT5) { transpose_tile(p.w2, 64, 1024, p.w2t, t, smem); continue; } t -= NT5;
    if (t < NT6) { transpose_tile(p.a2, 64, 1024, p.a2t, t, smem); continue; } t -= NT6;
    transpose_tile(p.g2, 128, 1024, p.g2t, t, smem);
  }
  size_t start = (size_t)blockIdx.x * 256 + threadIdx.x, stride = (size_t)G * 256;
  cvt_straight(p.k1, p.k1b, 128 * 128 / 4, start, stride);
  cvt_straight(p.k2, p.k2b, 128 * 128 / 4, start, stride);
}

DEVINL void norm_rows(const float* __restrict__ xin, const float* __restrict__ g, const float* __restrict__ mod,
                      int sh_off, int sc_off, u16* __restrict__ dst) {
  const int lane = threadIdx.x & 63, wid = threadIdx.x >> 6;
  const int nw = gridDim.x * 4;
  for (int row = blockIdx.x * 4 + wid; row < T; row += nw) {
    const float4* xr = (const float4*)(xin + (size_t)row * 1024);
    float4 v[4];
    float ss = 0.f;
#pragma unroll
    for (int i = 0; i < 4; ++i) {
      v[i] = xr[i * 64 + lane];
      ss += v[i].x * v[i].x + v[i].y * v[i].y + v[i].z * v[i].z + v[i].w * v[i].w;
    }
    ss = wave_sum(ss);
    const float rstd = rsqrtf(ss * (1.f / 1024.f) + 1e-6f);
    const float* mb = mod + (row >> 11) * 6144;
#pragma unroll
    for (int i = 0; i < 4; ++i) {
      int col = (i * 64 + lane) * 4;
      float4 gg = *(const float4*)(g + col);
      float4 sc = *(const float4*)(mb + sc_off + col);
      float4 sh = *(const float4*)(mb + sh_off + col);
      float o0 = v[i].x * rstd * gg.x * (1.f + sc.x) + sh.x;
      float o1 = v[i].y * rstd * gg.y * (1.f + sc.y) + sh.y;
      float o2 = v[i].z * rstd * gg.z * (1.f + sc.z) + sh.z;
      float o3 = v[i].w * rstd * gg.w * (1.f + sc.w) + sh.w;
      uint2 o; o.x = pack2(o0, o1); o.y = pack2(o2, o3);
      *(uint2*)(dst + (size_t)row * 1024 + col) = o;
    }
  }
}


DEVINL void transpose_tile_fp8(const Params& p, int tile, char* smem) {
  float(*s)[65] = (float(*)[65])smem;
  const int tid = threadIdx.x;
  const int kt = tile & 15, nt = tile >> 4;
  unsigned char* dst = (unsigned char*)p.w_in_t;
  __syncthreads();
#pragma unroll
  for (int i = 0; i < 16; ++i) {
    int r = (tid >> 6) + 4 * i;
    s[r][tid & 63] = p.w_in[(size_t)(kt * 64 + r) * 7680 + nt * 64 + (tid & 63)];
  }
  __syncthreads();
  const int k4 = (tid & 15) * 4;
#pragma unroll
  for (int i = 0; i < 4; ++i) {
    const int n = (tid >> 4) + 16 * i;
    const float am = __int_as_float(p.colamax[nt * 64 + n]);
    const float sc = (am > 0.f) ? 224.f / am : 1.f;
    int w = 0;
    w = __builtin_amdgcn_cvt_pk_fp8_f32(s[k4][n] * sc, s[k4 + 1][n] * sc, w, false);
    w = __builtin_amdgcn_cvt_pk_fp8_f32(s[k4 + 2][n] * sc, s[k4 + 3][n] * sc, w, true);
    *(int*)(dst + (size_t)(nt * 64 + n) * 1024 + kt * 64 + k4) = w;
    if (kt == 0 && k4 == 0) p.w_in_s[nt * 64 + n] = (am > 0.f) ? am * (1.f / 224.f) : 1.f;
  }
}

DEVINL void norm_rows_fp8(const Params& p) {
  const int lane = threadIdx.x & 63, wid = threadIdx.x >> 6;
  const int nw = gridDim.x * 4;
  unsigned char* dst = (unsigned char*)p.bufB;
  for (int row = blockIdx.x * 4 + wid; row < T; row += nw) {
    const float4* xr = (const float4*)(p.x + (size_t)row * 1024);
    float4 v[4];
    float ss = 0.f;
#pragma unroll
    for (int i = 0; i < 4; ++i) {
      v[i] = xr[i * 64 + lane];
      ss += v[i].x * v[i].x + v[i].y * v[i].y + v[i].z * v[i].z + v[i].w * v[i].w;
    }
    ss = wave_sum(ss);
    const float rstd = rsqrtf(ss * (1.f / 1024.f) + 1e-6f);
    const float* mb = p.mod + (row >> 11) * 6144;
    float o[16];
    float am = 0.f;
#pragma unroll
    for (int i = 0; i < 4; ++i) {
      int col = (i * 64 + lane) * 4;
      float4 gg = *(const float4*)(p.norm1_g + col);
      float4 sc = *(const float4*)(mb + 1024 + col);
      float4 sh = *(const float4*)(mb + col);
      o[i * 4 + 0] = v[i].x * rstd * gg.x * (1.f + sc.x) + sh.x;
      o[i * 4 + 1] = v[i].y * rstd * gg.y * (1.f + sc.y) + sh.y;
      o[i * 4 + 2] = v[i].z * rstd * gg.z * (1.f + sc.z) + sh.z;
      o[i * 4 + 3] = v[i].w * rstd * gg.w * (1.f + sc.w) + sh.w;
      am = fmaxf(am, fmaxf(fmaxf(fabsf(o[i * 4]), fabsf(o[i * 4 + 1])), fmaxf(fabsf(o[i * 4 + 2]), fabsf(o[i * 4 + 3]))));
    }
    am = wave_max(am);
    const float qs = (am > 0.f) ? 224.f / am : 1.f;
#pragma unroll
    for (int i = 0; i < 4; ++i) {
      int col = (i * 64 + lane) * 4;
      int w = 0;
      w = __builtin_amdgcn_cvt_pk_fp8_f32(o[i * 4] * qs, o[i * 4 + 1] * qs, w, false);
      w = __builtin_amdgcn_cvt_pk_fp8_f32(o[i * 4 + 2] * qs, o[i * 4 + 3] * qs, w, true);
      *(int*)(dst + (size_t)row * 1024 + col) = w;
    }
    if (lane == 0) p.n1s[row] = (am > 0.f) ? am * (1.f / 224.f) : 1.f;
  }
}

#define LDS_AS __attribute__((address_space(3)))
using i64x2 = __attribute__((ext_vector_type(2))) long;
using v8i32 = __attribute__((ext_vector_type(8))) int;
using v4i32 = __attribute__((ext_vector_type(4))) int;
struct GemmNext { const void* A; int lda; const void* B; int ldb; int m0, n0; bool valid; };
template <bool FP8 = false, class Epi>
DEVINL void gemm_tile(const void* __restrict__ A, int lda, const void* __restrict__ Bt, int ldb, int K, int m0, int n0,
                      char* smem, const Epi& epi, bool pre = false, GemmNext nx = GemmNext{nullptr, 0, nullptr, 0, 0, 0, false}) {
  constexpr int EB = FP8 ? 1 : 2;
  constexpr int KS = 128 / EB;
  constexpr int CE = 16 / EB;
  const int tid = threadIdx.x, lane = tid & 63, wid = tid >> 6;
  const int wr = wid >> 1, wc = wid & 1;
  const int fr = lane & 15, fq = lane >> 4;
  f32x4 acc[4][4];
#pragma unroll
  for (int m = 0; m < 4; ++m)
#pragma unroll
    for (int n = 0; n < 4; ++n) acc[m][n] = (f32x4){0.f, 0.f, 0.f, 0.f};
  const int l3 = lane >> 3, cch = (lane & 7) ^ l3;
  const char* Ab = (const char*)A + (size_t)m0 * lda * EB;
  const char* Bb = (const char*)Bt + (size_t)n0 * ldb * EB;
  const uint32_t aoff = (uint32_t)((wid * 32 + l3) * lda + cch * CE) * (uint32_t)EB;
  const uint32_t boff = (uint32_t)((16 * (lane >> 5) + (l3 & 3)) * ldb + cch * CE) * (uint32_t)EB;
  const int rowB_base = (wid >> 1) * 64 + 8 * (wid & 1);
  char* ldsw = smem + wid * 4096 + lane * 16;
#define DMA(buf, k0_)                                                                                           \
  _Pragma("unroll") for (int i = 0; i < 4; ++i) {                                                               \
    __builtin_amdgcn_global_load_lds((const unsigned*)(Ab + (size_t)((i * 8 * lda + (k0_)) * EB) + aoff),       \
                                     (LDS_AS unsigned*)(ldsw + (buf) * 32768 + i * 1024), 16, 0, 0);            \
    __builtin_amdgcn_global_load_lds(                                                                           \
        (const unsigned*)(Bb + (size_t)(((rowB_base + 32 * (i & 1) + 4 * (i >> 1)) * ldb + (k0_)) * EB) + boff), \
        (LDS_AS unsigned*)(ldsw + (buf) * 32768 + 16384 + i * 1024), 16, 0, 0);                                 \
  }
  const int ra0 = (wr * 64 + fr) * 128 + (((0 + fq) ^ (fr & 7)) << 4);
  const int ra1 = (wr * 64 + fr) * 128 + (((4 + fq) ^ (fr & 7)) << 4);
  const int rb0 = 16384 + (wc * 64 + fr) * 128 + (((0 + fq) ^ (fr & 7)) << 4);
  const int rb1 = 16384 + (wc * 64 + fr) * 128 + (((4 + fq) ^ (fr & 7)) << 4);
  const int qa0 = (wr * 64 + fr) * 128 + (((2 * fq) ^ (fr & 7)) << 4);
  const int qa1 = (wr * 64 + fr) * 128 + (((2 * fq + 1) ^ (fr & 7)) << 4);
  const int qb0 = 16384 + (wc * 64 + fr) * 128 + (((2 * fq) ^ (fr & 7)) << 4);
  const int qb1 = 16384 + (wc * 64 + fr) * 128 + (((2 * fq + 1) ^ (fr & 7)) << 4);
#define LD32(off0, off1, dst)                                        \
  {                                                                  \
    dst.lo = *(const v4i32*)(off0);                                  \
    dst.hi = *(const v4i32*)(off1);                                  \
  }
#define COMPUTE(buf)                                                                                        \
  if (FP8) {                                                                                                \
    v8i32 bfr[4];                                                                                           \
    _Pragma("unroll") for (int n = 0; n < 4; ++n) LD32(smem + (buf) * 32768 + qb0 + n * 2048, smem + (buf) * 32768 + qb1 + n * 2048, bfr[n])  \
    _Pragma("unroll") for (int m = 0; m < 4; ++m) {                                                         \
      v8i32 af;                                                                                             \
      LD32(smem + (buf) * 32768 + qa0 + m * 2048, smem + (buf) * 32768 + qa1 + m * 2048, af)                \
      _Pragma("unroll") for (int n = 0; n < 4; ++n)                                                         \
        acc[m][n] = __builtin_amdgcn_mfma_scale_f32_16x16x128_f8f6f4(bfr[n], af, acc[m][n], 0, 0, 0, 127, 0, 127); \
    }                                                                                                       \
    __builtin_amdgcn_sched_barrier(0);                                                                      \
  } else {                                                                                                  \
    _Pragma("unroll") for (int ks = 0; ks < 2; ++ks) {                                                      \
      bf16x8 af[4], bfr[4];                                                                                 \
      _Pragma("unroll") for (int m = 0; m < 4; ++m) af[m] = *(const bf16x8*)(smem + (buf) * 32768 + (ks ? ra1 : ra0) + m * 2048);  \
      _Pragma("unroll") for (int n = 0; n < 4; ++n) bfr[n] = *(const bf16x8*)(smem + (buf) * 32768 + (ks ? rb1 : rb0) + n * 2048); \
      _Pragma("unroll") for (int m = 0; m < 4; ++m)                                                         \
        _Pragma("unroll") for (int n = 0; n < 4; ++n)                                                       \
          acc[m][n] = __builtin_amdgcn_mfma_f32_16x16x32_bf16(bfr[n], af[m], acc[m][n], 0, 0, 0);           \
    }                                                                                                       \
  }
  if (!pre) {
    __syncthreads();
    DMA(0, 0)
  }
  __syncthreads();
#pragma unroll 1
  for (int k0 = 0; k0 < K; k0 += 2 * KS) {
    DMA(1, k0 + KS)
    COMPUTE(0)
    __syncthreads();
    if (k0 + 2 * KS < K) { DMA(0, k0 + 2 * KS) }
    COMPUTE(1)
    __syncthreads();
  }
  if (nx.valid) {
    const char* Ab2 = (const char*)nx.A + (size_t)nx.m0 * nx.lda * EB;
    const char* Bb2 = (const char*)nx.B + (size_t)nx.n0 * nx.ldb * EB;
    const uint32_t aoff2 = (uint32_t)((wid * 32 + l3) * nx.lda + cch * CE) * (uint32_t)EB;
    const uint32_t boff2 = (uint32_t)((16 * (lane >> 5) + (l3 & 3)) * nx.ldb + cch * CE) * (uint32_t)EB;
#pragma unroll
    for (int i = 0; i < 4; ++i) {
      __builtin_amdgcn_global_load_lds((const unsigned*)(Ab2 + (size_t)((i * 8 * nx.lda) * EB) + aoff2),
                                       (LDS_AS unsigned*)(ldsw + i * 1024), 16, 0, 0);
      __builtin_amdgcn_global_load_lds(
          (const unsigned*)(Bb2 + (size_t)(((rowB_base + 32 * (i & 1) + 4 * (i >> 1)) * nx.ldb) * EB) + boff2),
          (LDS_AS unsigned*)(ldsw + 16384 + i * 1024), 16, 0, 0);
    }
  }
#undef DMA
#undef COMPUTE
#undef LD32
#pragma unroll
  for (int m = 0; m < 4; ++m) {
    int row = m0 + wr * 64 + m * 16 + fr;
    int col0 = n0 + wc * 64 + fq * 16;
    epi(row, col0, acc[m]);
  }
}

DEVINL void store16_bf16(u16* dst, const f32x4 (&v)[4]) {
  uint4 a, b;
  a.x = pack2(v[0][0], v[0][1]); a.y = pack2(v[0][2], v[0][3]);
  a.z = pack2(v[1][0], v[1][1]); a.w = pack2(v[1][2], v[1][3]);
  b.x = pack2(v[2][0], v[2][1]); b.y = pack2(v[2][2], v[2][3]);
  b.z = pack2(v[3][0], v[3][1]); b.w = pack2(v[3][2], v[3][3]);
  ((uint4*)dst)[0] = a;
  ((uint4*)dst)[1] = b;
}

struct Epi1 {
  const Params& p;
  DEVINL void operator()(int row, int col, const f32x4 (&vin)[4]) const {
    f32x4 v[4];
    {
      const float sa = p.n1s[row];
      const float* sb = p.w_in_s + col;
#pragma unroll
      for (int n = 0; n < 4; ++n) {
        const float4 s4 = *(const float4*)(sb + n * 4);
        v[n][0] = vin[n][0] * sa * s4.x; v[n][1] = vin[n][1] * sa * s4.y;
        v[n][2] = vin[n][2] * sa * s4.z; v[n][3] = vin[n][3] * sa * s4.w;
      }
    }
    if (col < 3072) store16_bf16(p.z_rkv + (size_t)row * 3072 + col, v);
    else if (col < 3328) store16_bf16(p.z_lora + (size_t)row * 256 + (col - 3072), v);
    else if (col < 5632) store16_bf16(p.z_attn + (size_t)row * 2304 + (col - 3328), v);
    else {
      f32x4 s[4];
#pragma unroll
      for (int n = 0; n < 4; ++n)
#pragma unroll
        for (int j = 0; j < 4; ++j) s[n][j] = sigm(v[n][j]);
      store16_bf16(p.gates + (size_t)row * 2048 + (col - 5632), s);
    }
  }
};
struct Epi5a {
  const Params& p; u16* merged;
  DEVINL void operator()(int row, int col, const f32x4 (&v)[4]) const {
    const uint4* gp = (const uint4*)(p.gates + (size_t)row * 2048 + col);
    uint4 g0 = gp[0], g1 = gp[1];
    uint32_t gw[8] = {g0.x, g0.y, g0.z, g0.w, g1.x, g1.y, g1.z, g1.w};
    f32x4 s[4];
#pragma unroll
    for (int n = 0; n < 4; ++n) {
      s[n][0] = v[n][0] * bflo(gw[n * 2]); s[n][1] = v[n][1] * bfhi(gw[n * 2]);
      s[n][2] = v[n][2] * bflo(gw[n * 2 + 1]); s[n][3] = v[n][3] * bfhi(gw[n * 2 + 1]);
    }
    store16_bf16(merged + (size_t)row * 1024 + col, s);
  }
};
struct Epi5b {
  const Params& p; u16* merged;
  DEVINL void operator()(int row, int col, const f32x4 (&v)[4]) const {
    const uint4* gp = (const uint4*)(p.gates + (size_t)row * 2048 + 1024 + col);
    uint4 g0 = gp[0], g1 = gp[1];
    uint32_t gw[8] = {g0.x, g0.y, g0.z, g0.w, g1.x, g1.y, g1.z, g1.w};
    const uint4* tp = (const uint4*)(merged + (size_t)row * 1024 + col);
    uint4 t0 = tp[0], t1 = tp[1];
    uint32_t tw[8] = {t0.x, t0.y, t0.z, t0.w, t1.x, t1.y, t1.z, t1.w};
    f32x4 s[4];
#pragma unroll
    for (int n = 0; n < 4; ++n) {
      s[n][0] = bflo(tw[n * 2]) + v[n][0] * bflo(gw[n * 2]);
      s[n][1] = bfhi(tw[n * 2]) + v[n][1] * bfhi(gw[n * 2]);
      s[n][2] = bflo(tw[n * 2 + 1]) + v[n][2] * bflo(gw[n * 2 + 1]);
      s[n][3] = bfhi(tw[n * 2 + 1]) + v[n][3] * bfhi(gw[n * 2 + 1]);
    }
    store16_bf16(merged + (size_t)row * 1024 + col, s);
  }
};
struct Epi6 {
  const Params& p;
  DEVINL void operator()(int row, int col, const f32x4 (&v)[4]) const {
    const float* gt = p.mod + (row >> 11) * 6144 + 2048 + col;
    const float* xr = p.x + (size_t)row * 1024 + col;
    float* o = p.out + (size_t)row * 1024 + col;
#pragma unroll
    for (int n = 0; n < 4; ++n) {
      float4 xv = *(const float4*)(xr + n * 4);
      float4 gv = *(const float4*)(gt + n * 4);
      float4 r;
      r.x = xv.x + gv.x * v[n][0]; r.y = xv.y + gv.y * v[n][1];
      r.z = xv.z + gv.z * v[n][2]; r.w = xv.w + gv.w * v[n][3];
      *(float4*)(o + n * 4) = r;
    }
  }
};
struct Epi8 {
  u16* q;
  DEVINL void operator()(int row, int col, const f32x4 (&v)[4]) const { store16_bf16(q + (size_t)row * 2048 + col, v); }
};

template <class F>
DEVINL void for_tiles(int nM, int nN, const F& f) {
  const int G = gridDim.x;
  const int xcd = blockIdx.x & 7, slot = blockIdx.x >> 3, nslot = G >> 3;
  const int nSm = nM >> 3;
  const int nS = nSm * (nN >> 2);
  const int Ltot = (nS >> 3) * 32;
  for (int L = slot; L < Ltot; L += nslot) {
    int s = (L >> 5) * 8 + xcd;
    int w = L & 31;
    int sm = s % nSm, sn = s / nSm;
    int mt = sm * 8 + (w & 7), nt = sn * 4 + (w >> 3);
    f(mt, nt);
  }
}


template <class F>
DEVINL void for_tiles_la(int nM, int nN, const F& f) {
  const int G = gridDim.x;
  const int xcd = blockIdx.x & 7, slot = blockIdx.x >> 3, nslot = G >> 3;
  const int nSm = nM >> 3;
  const int nS = nSm * (nN >> 2);
  const int Ltot = (nS >> 3) * 32;
  bool notfirst = false;
  for (int L = slot; L < Ltot; L += nslot) {
    int s = (L >> 5) * 8 + xcd, w = L & 31;
    int mt = (s % nSm) * 8 + (w & 7), nt = (s / nSm) * 4 + (w >> 3);
    const int Ln = L + nslot;
    const bool hn = Ln < Ltot;
    int s2 = (Ln >> 5) * 8 + xcd, w2 = Ln & 31;
    int mt2 = (s2 % nSm) * 8 + (w2 & 7), nt2 = (s2 / nSm) * 4 + (w2 >> 3);
    f(mt, nt, notfirst, hn, mt2, nt2);
    notfirst = true;
  }
}

DEVINL void prep_phase(const Params& p, u16* X) {
  const size_t gtid = (size_t)blockIdx.x * 256 + threadIdx.x, gstride = (size_t)gridDim.x * 256;
  for (size_t it = gtid; it < (size_t)T * 32; it += gstride) {
    const size_t tok = it >> 5;
    const int c8 = (int)(it & 31) * 8;
    const u16* zl = p.z_lora + tok * 256 + c8;
    uint4 cur = *(const uint4*)zl;
    uint4 prv = make_uint4(0, 0, 0, 0);
    if ((tok & 2047) != 0) prv = *(const uint4*)(zl - 256);
    const float4 m0 = *(const float4*)(p.mu + 3072 + c8), m1 = *(const float4*)(p.mu + 3072 + c8 + 4);
    const float mu8[8] = {m0.x, m0.y, m0.z, m0.w, m1.x, m1.y, m1.z, m1.w};
    const uint32_t cw[4] = {cur.x, cur.y, cur.z, cur.w}, pw[4] = {prv.x, prv.y, prv.z, prv.w};
    uint32_t o[4];
#pragma unroll
    for (int i = 0; i < 4; ++i) {
      float c0 = bflo(cw[i]), q0 = bflo(pw[i]), c1 = bfhi(cw[i]), q1 = bfhi(pw[i]);
      float a0 = c0 + (q0 - c0) * mu8[2 * i], a1 = c1 + (q1 - c1) * mu8[2 * i + 1];
      if (c8 < 64) {
        a0 = 1.f - 2.f / (__expf(2.f * a0) + 1.f);
        a1 = 1.f - 2.f / (__expf(2.f * a1) + 1.f);
      } else if (c8 >= 128) {
        a0 = sigm(a0); a1 = sigm(a1);
      }
      o[i] = pack2(a0, a1);
    }
    *(uint4*)(X + tok * 256 + c8) = make_uint4(o[0], o[1], o[2], o[3]);
  }
  float inv_f[8];
#pragma unroll
  for (int i = 0; i < 8; ++i) inv_f[i] = expf(-(float)i * (13.122363377404328f / 8.f));
  for (size_t it = gtid; it < (size_t)T * 96; it += gstride) {
    const size_t tok = it / 96;
    const int rem = (int)(it - tok * 96);
    const int hd = rem >> 2, qd = rem & 3;
    const int isk = hd >= 12;
    const int grp = (isk ? hd - 12 : hd) >> 2;
    u16* ptr = p.z_attn + tok * 2304 + hd * 64 + qd * 16;
    uint4 a = *(const uint4*)ptr, c = *(const uint4*)(ptr + 8);
    const uint32_t wv[8] = {a.x, a.y, a.z, a.w, c.x, c.y, c.z, c.w};
    float xv[16];
#pragma unroll
    for (int i = 0; i < 8; ++i) { xv[2 * i] = bflo(wv[i]); xv[2 * i + 1] = bfhi(wv[i]); }
    float ss = 0.f;
#pragma unroll
    for (int i = 0; i < 16; ++i) ss += xv[i] * xv[i];
    ss = quad_sum(ss);
    float rstd = rsqrtf(ss * (1.f / 64.f) + 1e-6f);
    if (!isk) rstd *= 0.125f;
    const float* gp = (isk ? p.kng : p.qng) + grp * 64 + qd * 16;
#pragma unroll
    for (int i = 0; i < 16; ++i) xv[i] = xv[i] * rstd * gp[i];
    if (qd == 0) {
      const float fp = (float)(tok & 2047);
#pragma unroll
      for (int i = 0; i < 8; ++i) {
        float ang = fp * inv_f[i];
        float n = rintf(ang * 0.15915494309189535f);
        float rr = fmaf(-n, 6.2831854820251465f, ang);
        rr = fmaf(-n, -1.7484555e-7f, rr);
        float cs = __cosf(rr), sn = __sinf(rr);
        float x1 = xv[i], x2 = xv[i + 8];
        xv[i] = x1 * cs - x2 * sn;
        xv[i + 8] = x2 * cs + x1 * sn;
      }
    }
    uint32_t o[8];
#pragma unroll
    for (int i = 0; i < 8; ++i) o[i] = pack2(xv[2 * i], xv[2 * i + 1]);
    *(uint4*)ptr = make_uint4(o[0], o[1], o[2], o[3]);
    *(uint4*)(ptr + 8) = make_uint4(o[4], o[5], o[6], o[7]);
  }
}

constexpr int TC = 16;
struct ScanLds {
  float w[TC][64], k[TC][64], a[TC][64], b[TC][64], r[TC][64], v[TC][64], y[TC][64];
  float bonus[TC];
  u16 g[TC][64];
  float cst[8][64];
  float mul[256];
  u16 xw[TC][72], xa[TC][72], xg[TC][136];
  u16 w2s[64][72], a2s[64][72], g2s[64][136];
};
static_assert(sizeof(ScanLds) <= 79872, "scan lds");

DEVINL void rwkv_scan_unit(const Params& p, const u16* X, int unit, char* smem) {
  ScanLds& L = *(ScanLds*)smem;
  const int tid = threadIdx.x, lane = tid & 63, wid = tid >> 6;
  const int b = unit >> 4, h = unit & 15;
  const int fr = lane & 15, fq = lane >> 4;
  const int pt = tid >> 4, pc = (tid & 15) * 4;
  const int rp = tid >> 3, cq = tid & 7;

  __syncthreads();
  {
    const float* srcs[8] = {p.mu + h * 64, p.mu + 1024 + h * 64, p.mu + 2048 + h * 64, p.k_k + h * 64,
                            p.k_a + h * 64, p.r_k + h * 64, p.lnx_g + h * 64, p.lnx_b + h * 64};
#pragma unroll
    for (int i = 0; i < 8; ++i)
      if (tid < 64) L.cst[i][tid] = srcs[i][tid];
    L.mul[tid] = p.mu[3072 + tid];
    const int c = tid >> 2, qq = tid & 3;
    const u16* w2p = p.w2t + (size_t)(h * 64 + c) * 64 + qq * 16;
    const u16* a2p = p.a2t + (size_t)(h * 64 + c) * 64 + qq * 16;
    const u16* g2p = p.g2t + (size_t)(h * 64 + c) * 128 + qq * 32;
    *(u32x4*)&L.w2s[c][qq * 16] = *(const u32x4*)w2p;
    *(u32x4*)&L.w2s[c][qq * 16 + 8] = *(const u32x4*)(w2p + 8);
    *(u32x4*)&L.a2s[c][qq * 16] = *(const u32x4*)a2p;
    *(u32x4*)&L.a2s[c][qq * 16 + 8] = *(const u32x4*)(a2p + 8);
#pragma unroll
    for (int i = 0; i < 4; ++i) *(u32x4*)&L.g2s[c][qq * 32 + i * 8] = *(const u32x4*)(g2p + i * 8);
  }
  const int chn = h * 64 + wid * 16 + fr;
  const float w0c = p.w0[chn], a0c = p.a0[chn];
  const int ec = h * 64 + pc;
  const int lc = (tid & 15) * 16;

  f32x2 S2[2][4];
#pragma unroll
  for (int r_ = 0; r_ < 2; ++r_)
#pragma unroll
    for (int j = 0; j < 4; ++j) S2[r_][j] = (f32x2){0.f, 0.f};

  const size_t tok0 = (size_t)b * 2048;
  uint2 pr0, pr1, pk0, pk1, pv0, pv1;
  uint4 pl0, pl1;
#define PREFETCH(t0_)                                                                                    \
  {                                                                                                      \
    const int t_ = (t0_) + pt;                                                                           \
    const u16* zr_ = p.z_rkv + (tok0 + t_) * 3072 + ec;                                                  \
    pr0 = *(const uint2*)(zr_); pk0 = *(const uint2*)(zr_ + 1024); pv0 = *(const uint2*)(zr_ + 2048);    \
    const u16* xl_ = X + (tok0 + t_) * 256 + lc;                                                         \
    pl0 = *(const uint4*)(xl_); pl1 = *(const uint4*)(xl_ + 8);                                          \
    if (t_ > 0) {                                                                                        \
      pr1 = *(const uint2*)(zr_ - 3072); pk1 = *(const uint2*)(zr_ - 3072 + 1024);                       \
      pv1 = *(const uint2*)(zr_ - 3072 + 2048);                                                          \
    } else {                                                                                             \
      pr1 = make_uint2(0, 0); pk1 = make_uint2(0, 0); pv1 = make_uint2(0, 0);                            \
    }                                                                                                    \
  }
  __syncthreads();
  PREFETCH(0)

  for (int t0 = 0; t0 < 2048; t0 += TC) {
    float r4[4], k4[4], v4[4];
    {
      const float4 mu_r = *(const float4*)&L.cst[0][pc], mu_k = *(const float4*)&L.cst[1][pc], mu_v = *(const float4*)&L.cst[2][pc];
      float c, q;
      c = bflo(pr0.x); q = bflo(pr1.x); r4[0] = c + (q - c) * mu_r.x;
      c = bfhi(pr0.x); q = bfhi(pr1.x); r4[1] = c + (q - c) * mu_r.y;
      c = bflo(pr0.y); q = bflo(pr1.y); r4[2] = c + (q - c) * mu_r.z;
      c = bfhi(pr0.y); q = bfhi(pr1.y); r4[3] = c + (q - c) * mu_r.w;
      c = bflo(pk0.x); q = bflo(pk1.x); k4[0] = c + (q - c) * mu_k.x;
      c = bfhi(pk0.x); q = bfhi(pk1.x); k4[1] = c + (q - c) * mu_k.y;
      c = bflo(pk0.y); q = bflo(pk1.y); k4[2] = c + (q - c) * mu_k.z;
      c = bfhi(pk0.y); q = bfhi(pk1.y); k4[3] = c + (q - c) * mu_k.w;
      c = bflo(pv0.x); q = bflo(pv1.x); v4[0] = c + (q - c) * mu_v.x;
      c = bfhi(pv0.x); q = bfhi(pv1.x); v4[1] = c + (q - c) * mu_v.y;
      c = bflo(pv0.y); q = bflo(pv1.y); v4[2] = c + (q - c) * mu_v.z;
      c = bfhi(pv0.y); q = bfhi(pv1.y); v4[3] = c + (q - c) * mu_v.w;
    }
    *(float4*)&L.r[pt][pc] = make_float4(r4[0], r4[1], r4[2], r4[3]);
    *(float4*)&L.v[pt][pc] = make_float4(v4[0], v4[1], v4[2], v4[3]);
    {
      u16* dstp = (lc < 64) ? &L.xw[pt][lc] : (lc < 128) ? &L.xa[pt][lc - 64] : &L.xg[pt][lc - 128];
      *(uint4*)dstp = pl0;
      *(uint4*)(dstp + 8) = pl1;
    }
    __syncthreads();
    {
      f32x4 cw = {0.f, 0.f, 0.f, 0.f}, ca = {0.f, 0.f, 0.f, 0.f}, cg_ = {0.f, 0.f, 0.f, 0.f};
#pragma unroll
      for (int ks = 0; ks < 2; ++ks) {
        bf16x8 xa_ = *(const bf16x8*)&L.xw[fr][ks * 32 + fq * 8];
        cw = __builtin_amdgcn_mfma_f32_16x16x32_bf16(xa_, *(const bf16x8*)&L.w2s[wid * 16 + fr][ks * 32 + fq * 8], cw, 0, 0, 0);
        bf16x8 xb_ = *(const bf16x8*)&L.xa[fr][ks * 32 + fq * 8];
        ca = __builtin_amdgcn_mfma_f32_16x16x32_bf16(xb_, *(const bf16x8*)&L.a2s[wid * 16 + fr][ks * 32 + fq * 8], ca, 0, 0, 0);
      }
#pragma unroll
      for (int ks = 0; ks < 4; ++ks) {
        bf16x8 xc_ = *(const bf16x8*)&L.xg[fr][ks * 32 + fq * 8];
        cg_ = __builtin_amdgcn_mfma_f32_16x16x32_bf16(xc_, *(const bf16x8*)&L.g2s[wid * 16 + fr][ks * 32 + fq * 8], cg_, 0, 0, 0);
      }
      const int ch = wid * 16 + fr;
#pragma unroll
      for (int j = 0; j < 4; ++j) {
        int tk = fq * 4 + j;
        L.w[tk][ch] = __expf(-0.6065306597126334f * sigm(w0c + cw[j]));
        L.y[tk][ch] = sigm(a0c + ca[j]);
        L.g[tk][ch] = f2bf(cg_[j]);
      }
    }
    __syncthreads();
    {
      float4 al4 = *(const float4*)&L.y[pt][pc];
      const float4 kk_c = *(const float4*)&L.cst[3][pc], ka_c = *(const float4*)&L.cst[4][pc], rk_c = *(const float4*)&L.cst[5][pc];
      float kk0 = k4[0] * kk_c.x, kk1 = k4[1] * kk_c.y, kk2 = k4[2] * kk_c.z, kk3 = k4[3] * kk_c.w;
      float ss = row16_sum(kk0 * kk0 + kk1 * kk1 + kk2 * kk2 + kk3 * kk3);
      float inv = 1.f / fmaxf(sqrtf(ss), 1e-12f);
      kk0 *= inv; kk1 *= inv; kk2 *= inv; kk3 *= inv;
      *(float4*)&L.a[pt][pc] = make_float4(-kk0, -kk1, -kk2, -kk3);
      *(float4*)&L.b[pt][pc] = make_float4(kk0 * al4.x, kk1 * al4.y, kk2 * al4.z, kk3 * al4.w);
      float km0 = k4[0] * (1.f + (al4.x - 1.f) * ka_c.x);
      float km1 = k4[1] * (1.f + (al4.y - 1.f) * ka_c.y);
      float km2 = k4[2] * (1.f + (al4.z - 1.f) * ka_c.z);
      float km3 = k4[3] * (1.f + (al4.w - 1.f) * ka_c.w);
      *(float4*)&L.k[pt][pc] = make_float4(km0, km1, km2, km3);
      float bs = row16_sum(r4[0] * km0 * rk_c.x + r4[1] * km1 * rk_c.y + r4[2] * km2 * rk_c.z + r4[3] * km3 * rk_c.w);
      if ((tid & 15) == 0) L.bonus[pt] = bs;
    }
    if (t0 + TC < 2048) PREFETCH(t0 + TC)
    __syncthreads();
    {
#define LDVEC(dst, arr, t)                                         \
  {                                                                \
    const f32x4* p4_ = (const f32x4*)&L.arr[t][cq * 8];            \
    f32x4 v0_ = p4_[0], v1_ = p4_[1];                              \
    dst[0] = (f32x2){v0_[0], v0_[1]}; dst[1] = (f32x2){v0_[2], v0_[3]}; \
    dst[2] = (f32x2){v1_[0], v1_[1]}; dst[3] = (f32x2){v1_[2], v1_[3]}; \
  }
      f32x2 cA[4];
      LDVEC(cA, a, 0)
      f32x2 cv = *(const f32x2*)&L.v[0][rp * 2];
#pragma unroll 2
      for (int t = 0; t < TC; ++t) {
        f32x2 nA[4], cW[4], cB[4], cK[4], cR[4];
        const int tn = (t + 1 < TC) ? t + 1 : t;
        LDVEC(cW, w, t) LDVEC(cB, b, t) LDVEC(cK, k, t)
        LDVEC(nA, a, tn)
        const f32x2 nv = *(const f32x2*)&L.v[tn][rp * 2];
        LDVEC(cR, r, t)
        f32x2 p0 = S2[0][0] * cA[0], p1 = S2[0][1] * cA[1], q0 = S2[1][0] * cA[0], q1 = S2[1][1] * cA[1];
        p0 = S2[0][2] * cA[2] + p0; p1 = S2[0][3] * cA[3] + p1; q0 = S2[1][2] * cA[2] + q0; q1 = S2[1][3] * cA[3] + q1;
        p0 = p0 + p1; q0 = q0 + q1;
        const float sa0 = oct_sum(p0[0] + p0[1]);
        const float sa1 = oct_sum(q0[0] + q0[1]);
        const f32x2 sav0 = {sa0, sa0}, sav1 = {sa1, sa1}, vv0 = {cv[0], cv[0]}, vv1 = {cv[1], cv[1]};
#pragma unroll
        for (int j = 0; j < 4; ++j) {
          S2[0][j] = S2[0][j] * cW[j] + (sav0 * cB[j] + vv0 * cK[j]);
          S2[1][j] = S2[1][j] * cW[j] + (sav1 * cB[j] + vv1 * cK[j]);
        }
        f32x2 y0 = S2[0][0] * cR[0], y1 = S2[0][1] * cR[1], z0 = S2[1][0] * cR[0], z1 = S2[1][1] * cR[1];
        y0 = S2[0][2] * cR[2] + y0; y1 = S2[0][3] * cR[3] + y1; z0 = S2[1][2] * cR[2] + z0; z1 = S2[1][3] * cR[3] + z1;
        y0 = y0 + y1; z0 = z0 + z1;
        const float ya = oct_sum(y0[0] + y0[1]);
        const float yb = oct_sum(z0[0] + z0[1]);
        if (cq == 0) *(f32x2*)&L.y[t][rp * 2] = (f32x2){ya, yb};
#pragma unroll
        for (int j = 0; j < 4; ++j) cA[j] = nA[j];
        cv = nv;
      }
#undef LDVEC
    }
    __syncthreads();
    {
      const float4 lg_c = *(const float4*)&L.cst[6][pc], lb_c = *(const float4*)&L.cst[7][pc];
      float4 y4 = *(const float4*)&L.y[pt][pc];
      float4 g4;
      {
        uint2 gq = *(const uint2*)&L.g[pt][pc];
        g4 = make_float4(bflo(gq.x), bfhi(gq.x), bflo(gq.y), bfhi(gq.y));
      }
      float4 vv = *(const float4*)&L.v[pt][pc];
      float bs = L.bonus[pt];
      float mean = row16_sum(y4.x + y4.y + y4.z + y4.w) * (1.f / 64.f);
      float d0 = y4.x - mean, d1 = y4.y - mean, d2 = y4.z - mean, d3 = y4.w - mean;
      float var = row16_sum(d0 * d0 + d1 * d1 + d2 * d2 + d3 * d3) * (1.f / 64.f);
      float rs = rsqrtf(var + 64e-5f);
      float o0 = (d0 * rs * lg_c.x + lb_c.x + bs * vv.x) * g4.x;
      float o1 = (d1 * rs * lg_c.y + lb_c.y + bs * vv.y) * g4.y;
      float o2 = (d2 * rs * lg_c.z + lb_c.z + bs * vv.z) * g4.z;
      float o3 = (d3 * rs * lg_c.w + lb_c.w + bs * vv.w) * g4.w;
      uint2 o; o.x = pack2(o0, o1); o.y = pack2(o2, o3);
      *(uint2*)(p.bufB + (tok0 + t0 + pt) * 1024 + ec) = o;
    }
    __syncthreads();
  }
}

struct AttnLds {
  u16 q[64][72];
  u16 k[192][72];
  u16 vt[64][200];
};

DEVINL void attn_unit(const Params& p, int u, char* smem) {
  AttnLds& L = *(AttnLds*)smem;
  const int tid = threadIdx.x, lane = tid & 63, wid = tid >> 6;
  const int fr = lane & 15, fq = lane >> 4;
  const int g = u >> 11;
  int rem = u & 2047;
  const int b = rem >> 7; rem &= 127;
  const int hh = rem >> 5;
  const int w = rem & 31;
  const int dsh = g * 2;
  const int d = 1 << dsh;
  const int nqb = 32 >> dsh;
  const int r = w / nqb, qb = w % nqb;
  const int l0 = qb * 64;
  const int kl0 = l0 - 128;
  const int gh = g * 4 + hh;
  const size_t tokb = (size_t)b * 2048;
  const int rowi = tid >> 2, qd = tid & 3;

  __syncthreads();
#pragma unroll 1
  for (int pass = 0; pass < 7; ++pass) {
    int kind = (pass == 0) ? 0 : (pass < 4 ? 1 : 2);
    int lrow = (pass == 0) ? rowi : (pass < 4 ? (pass - 1) * 64 + rowi : (pass - 4) * 64 + rowi);
    int sub = (kind == 0) ? (l0 + lrow) : (kl0 + lrow);
    bool valid = sub >= 0;
    int pos = sub * d + r;
    float xv[16];
    if (valid) {
      const u16* src = p.z_attn + (tokb + pos) * 2304 + kind * 768 + gh * 64 + qd * 16;
      uint4 a = *(const uint4*)src, c = *(const uint4*)(src + 8);
      uint32_t wv[8] = {a.x, a.y, a.z, a.w, c.x, c.y, c.z, c.w};
#pragma unroll
      for (int i = 0; i < 8; ++i) { xv[2 * i] = bflo(wv[i]); xv[2 * i + 1] = bfhi(wv[i]); }
    } else {
#pragma unroll
      for (int i = 0; i < 16; ++i) xv[i] = 0.f;
    }
    if (kind < 2) {
      uint32_t o[8];
#pragma unroll
      for (int i = 0; i < 8; ++i) o[i] = pack2(xv[2 * i], xv[2 * i + 1]);
      u16* dst = (kind == 0) ? &L.q[lrow][qd * 16] : &L.k[lrow][qd * 16];
      *(uint4*)dst = make_uint4(o[0], o[1], o[2], o[3]);
      *(uint4*)(dst + 8) = make_uint4(o[4], o[5], o[6], o[7]);
    } else {
#pragma unroll
      for (int i = 0; i < 16; ++i) L.vt[qd * 16 + i][lrow] = f2bf(xv[i]);
    }
  }
  __syncthreads();
  bf16x8 qf[2];
#pragma unroll
  for (int ks = 0; ks < 2; ++ks) qf[ks] = *(const bf16x8*)&L.q[wid * 16 + fr][ks * 32 + fq * 8];
  f32x4 sc[9];
#pragma unroll
  for (int i = 0; i < 9; ++i) {
    int kt = wid + i;
    f32x4 a = {0.f, 0.f, 0.f, 0.f};
#pragma unroll
    for (int ks = 0; ks < 2; ++ks) {
      bf16x8 kf = *(const bf16x8*)&L.k[kt * 16 + fr][ks * 32 + fq * 8];
      a = __builtin_amdgcn_mfma_f32_16x16x32_bf16(kf, qf[ks], a, 0, 0, 0);
    }
    sc[i] = a;
  }
  const int ql = wid * 16 + fr;
  float mx = -1e30f;
#pragma unroll
  for (int i = 0; i < 9; ++i)
#pragma unroll
    for (int j = 0; j < 4; ++j) {
      int kl = (wid + i) * 16 + fq * 4 + j;
      bool ok = (kl >= ql) && (kl <= ql + 128) && (kl0 + kl >= 0);
      float s = ok ? sc[i][j] : -1e30f;
      sc[i][j] = s;
      mx = fmaxf(mx, s);
    }
  mx = fmaxf(mx, __shfl_xor(mx, 16));
  mx = fmaxf(mx, __shfl_xor(mx, 32));
  float lsum = 0.f;
  bf16x4 pf[9];
#pragma unroll
  for (int i = 0; i < 9; ++i) {
    float e0 = __expf(sc[i][0] - mx), e1 = __expf(sc[i][1] - mx), e2 = __expf(sc[i][2] - mx), e3 = __expf(sc[i][3] - mx);
    lsum += (e0 + e1) + (e2 + e3);
    pf[i][0] = (short)f2bf(e0); pf[i][1] = (short)f2bf(e1); pf[i][2] = (short)f2bf(e2); pf[i][3] = (short)f2bf(e3);
  }
  lsum += __shfl_xor(lsum, 16);
  lsum += __shfl_xor(lsum, 32);
  f32x4 oacc[4];
#pragma unroll
  for (int db = 0; db < 4; ++db) oacc[db] = (f32x4){0.f, 0.f, 0.f, 0.f};
#pragma unroll
  for (int i = 0; i < 9; ++i) {
    int kt = wid + i;
#pragma unroll
    for (int db = 0; db < 4; ++db) {
      bf16x4 vf = *(const bf16x4*)&L.vt[db * 16 + fr][kt * 16 + fq * 4];
      oacc[db] = __builtin_amdgcn_mfma_f32_16x16x16bf16_1k(vf, pf[i], oacc[db], 0, 0, 0);
    }
  }
  const float invl = 1.f / lsum;
  const int posq = (l0 + ql) * d + r;
  u16* od = p.z_attn + (tokb + posq) * 2304 + gh * 64;
#pragma unroll
  for (int db = 0; db < 4; ++db) {
    uint2 o;
    o.x = pack2(oacc[db][0] * invl, oacc[db][1] * invl);
    o.y = pack2(oacc[db][2] * invl, oacc[db][3] * invl);
    *(uint2*)(od + db * 16 + fq * 4) = o;
  }
  if (fq == 0) p.lse[((size_t)g * T + tokb + posq) * 4 + hh] = mx + __logf(lsum);
}

DEVINL void attn_merge(const Params& p) {
  u16* ya = p.z_lora;
  const size_t n = (size_t)T * 32;
  for (size_t it = (size_t)blockIdx.x * 256 + threadIdx.x; it < n; it += (size_t)gridDim.x * 256) {
    size_t tok = it >> 5;
    int c8 = (int)(it & 31) * 8;
    int hh = c8 >> 6;
    float l0 = p.lse[((size_t)0 * T + tok) * 4 + hh];
    float l1 = p.lse[((size_t)1 * T + tok) * 4 + hh];
    float l2 = p.lse[((size_t)2 * T + tok) * 4 + hh];
    float m = fmaxf(l0, fmaxf(l1, l2));
    float e0 = __expf(l0 - m), e1 = __expf(l1 - m), e2 = __expf(l2 - m);
    float inv = 1.f / (e0 + e1 + e2);
    e0 *= inv; e1 *= inv; e2 *= inv;
    const u16* zr = p.z_attn + tok * 2304 + c8;
    uint4 a = *(const uint4*)(zr), bq = *(const uint4*)(zr + 256), cq = *(const uint4*)(zr + 512);
    uint32_t aw[4] = {a.x, a.y, a.z, a.w}, bw[4] = {bq.x, bq.y, bq.z, bq.w}, cw[4] = {cq.x, cq.y, cq.z, cq.w};
    uint32_t o[4];
#pragma unroll
    for (int i = 0; i < 4; ++i) {
      float lo = e0 * bflo(aw[i]) + e1 * bflo(bw[i]) + e2 * bflo(cw[i]);
      float hi = e0 * bfhi(aw[i]) + e1 * bfhi(bw[i]) + e2 * bfhi(cw[i]);
      o[i] = pack2(lo, hi);
    }
    *(uint4*)(ya + tok * 256 + c8) = make_uint4(o[0], o[1], o[2], o[3]);
  }
}

DEVINL uint32_t sortable(float s) {
  uint32_t u = __float_as_uint(s);
  return (u & 0x80000000u) ? ~u : (u | 0x80000000u);
}

DEVINL void ce_desc(uint32_t& a, uint32_t& b) {
  const uint32_t hi = max(a, b), lo = min(a, b);
  a = hi; b = lo;
}
DEVINL void bitonic_sort_desc16(uint32_t (&a)[16]) {
#pragma unroll
  for (int lk = 1; lk <= 4; ++lk) {
#pragma unroll
    for (int lj = 3; lj >= 0; --lj) {
      if (lj < lk) {
        const int k = 1 << lk, j = 1 << lj;
#pragma unroll
        for (int i = 0; i < 16; ++i) {
          const int l = i ^ j;
          if (l > i) {
            if ((i & k) == 0) ce_desc(a[i], a[l]); else ce_desc(a[l], a[i]);
          }
        }
      }
    }
  }
}
DEVINL void bitonic_merge_desc16(uint32_t (&a)[16]) {
#pragma unroll
  for (int lj = 3; lj >= 0; --lj) {
    const int j = 1 << lj;
#pragma unroll
    for (int i = 0; i < 16; ++i) {
      const int l = i ^ j;
      if (l > i) ce_desc(a[i], a[l]);
    }
  }
}
template <int CTRL>
DEVINL uint32_t dpp_u(uint32_t x) { return (uint32_t)__builtin_amdgcn_update_dpp(0, (int)x, CTRL, 0xF, 0xF, true); }

constexpr int RS = 133;
DEVINL void peer_route_a(const Params& p, const u16* qp, float* lv, int* li, char* smem) {
  const int tid = threadIdx.x, lane = tid & 63, wid = tid >> 6;
  const int fr = lane & 15, fq = lane >> 4;
  const int role = blockIdx.x & 1;
  const int nblk = gridDim.x >> 1, bidx = blockIdx.x >> 1;
  u16(*sK)[136] = (u16(*)[136])smem;
  float* sS = (float*)(smem + 128 * 136 * 2);
  __syncthreads();
  {
    const u16* kb = role ? p.k2b : p.k1b;
    for (int c = tid; c < 128 * 16; c += 256) {
      const int r = c >> 4, ch = c & 15;
      *(u32x4*)&sK[r][ch * 8] = *(const u32x4*)(kb + r * 128 + ch * 8);
    }
  }
  __syncthreads();
  float* lvr = lv + (size_t)role * T * 128;
  int* lir = li + (size_t)role * T * 128;
  for (int unit = bidx; unit < 4096; unit += nblk) {
    const int tok0 = (unit >> 1) * 16, hsel = unit & 1;
    const int head = hsel * 4 + wid;
    bf16x8 af[4];
#pragma unroll
    for (int ks = 0; ks < 4; ++ks)
      af[ks] = *(const bf16x8*)(qp + (size_t)(tok0 + fr) * 2048 + head * 256 + role * 128 + ks * 32 + fq * 8);
    __syncthreads();
#pragma unroll
    for (int nt = 0; nt < 8; ++nt) {
      f32x4 a = {0.f, 0.f, 0.f, 0.f};
#pragma unroll
      for (int ks = 0; ks < 4; ++ks) {
        bf16x8 bfg = *(const bf16x8*)&sK[nt * 16 + fr][ks * 32 + fq * 8];
        a = __builtin_amdgcn_mfma_f32_16x16x32_bf16(af[ks], bfg, a, 0, 0, 0);
      }
      const int key = nt * 16 + fr;
#pragma unroll
      for (int j = 0; j < 4; ++j) sS[(wid * 16 + fq * 4 + j) * RS + (key >> 5) * 33 + (key & 31)] = a[j];
    }
    __syncthreads();
    const int inst = tid >> 2, part = tid & 3;
    const float* row = sS + inst * RS;
    uint32_t top[16], grp[16];
#pragma unroll
    for (int i = 0; i < 16; ++i) {
      top[i] = (sortable(row[part * 33 + i]) & 0xFFFFFF80u) | (uint32_t)(127 - (part * 32 + i));
      grp[i] = (sortable(row[part * 33 + 16 + i]) & 0xFFFFFF80u) | (uint32_t)(127 - (part * 32 + 16 + i));
    }
    bitonic_sort_desc16(top);
    bitonic_sort_desc16(grp);
#pragma unroll
    for (int i = 0; i < 16; ++i) top[i] = max(top[i], grp[15 - i]);
    bitonic_merge_desc16(top);
#pragma unroll
    for (int i = 0; i < 16; ++i) grp[i] = dpp_u<0xB1>(top[i]);
#pragma unroll
    for (int i = 0; i < 16; ++i) top[i] = max(top[i], grp[15 - i]);
    bitonic_merge_desc16(top);
#pragma unroll
    for (int i = 0; i < 16; ++i) grp[i] = dpp_u<0x4E>(top[i]);
#pragma unroll
    for (int i = 0; i < 16; ++i) top[i] = max(top[i], grp[15 - i]);
    bitonic_merge_desc16(top);
    if (part == 0) {
      const int tk = inst & 15, hl = inst >> 4;
      const size_t ob = ((size_t)(tok0 + tk) * 8 + hsel * 4 + hl) * 16;
#pragma unroll
      for (int q4 = 0; q4 < 4; ++q4) {
        const int k0 = 127 - (int)(top[q4 * 4] & 127u), k1 = 127 - (int)(top[q4 * 4 + 1] & 127u);
        const int k2 = 127 - (int)(top[q4 * 4 + 2] & 127u), k3 = 127 - (int)(top[q4 * 4 + 3] & 127u);
        *(float4*)(lvr + ob + q4 * 4) = make_float4(row[(k0 >> 5) * 33 + (k0 & 31)], row[(k1 >> 5) * 33 + (k1 & 31)],
                                                    row[(k2 >> 5) * 33 + (k2 & 31)], row[(k3 >> 5) * 33 + (k3 & 31)]);
        *(int4*)(lir + ob + q4 * 4) = make_int4(k0, k1, k2, k3);
      }
    }
  }
}

DEVINL void peer_route_b(const float* lv, const int* li, int* idx_out, float* gate_out) {
  const float* lv1 = lv; const float* lv2 = lv + (size_t)T * 128;
  const int* li1 = li; const int* li2 = li + (size_t)T * 128;
  for (size_t it = (size_t)blockIdx.x * 256 + threadIdx.x; it < (size_t)T * 8; it += (size_t)gridDim.x * 256) {
    const size_t ob = it * 16;
    float v1[16], v2[16];
#pragma unroll
    for (int q = 0; q < 4; ++q) {
      float4 a = *(const float4*)(lv1 + ob + q * 4), b = *(const float4*)(lv2 + ob + q * 4);
      v1[q * 4] = a.x; v1[q * 4 + 1] = a.y; v1[q * 4 + 2] = a.z; v1[q * 4 + 3] = a.w;
      v2[q * 4] = b.x; v2[q * 4 + 1] = b.y; v2[q * 4 + 2] = b.z; v2[q * 4 + 3] = b.w;
    }
    uint32_t top[16];
#pragma unroll
    for (int j = 0; j < 16; ++j) top[j] = 0u;
#pragma unroll
    for (int i = 0; i < 16; ++i)
#pragma unroll
      for (int j = 0; j < 16; ++j)
        if ((i + 1) * (j + 1) <= 16) {
          uint32_t key = (sortable(v1[i] + v2[j]) & 0xFFFFFF00u) | (uint32_t)(255 - (i * 16 + j));
#pragma unroll
          for (int s_ = 0; s_ < 16; ++s_) {
            uint32_t hi = max(top[s_], key);
            key = min(top[s_], key);
            top[s_] = hi;
          }
        }
    float val[16];
    int eid[16];
    float mx = -1e30f;
#pragma unroll
    for (int s_ = 0; s_ < 16; ++s_) {
      const int cidx = 255 - (int)(top[s_] & 255u);
      const int i = cidx >> 4, j = cidx & 15;
      val[s_] = lv1[ob + i] + lv2[ob + j];
      eid[s_] = li1[ob + i] * 128 + li2[ob + j];
      mx = fmaxf(mx, val[s_]);
    }
    float sum = 0.f;
#pragma unroll
    for (int s_ = 0; s_ < 16; ++s_) { val[s_] = __expf(val[s_] - mx); sum += val[s_]; }
    const float inv = 1.f / sum;
#pragma unroll
    for (int s4 = 0; s4 < 4; ++s4) {
      *(int4*)(idx_out + ob + s4 * 4) = make_int4(eid[s4 * 4], eid[s4 * 4 + 1], eid[s4 * 4 + 2], eid[s4 * 4 + 3]);
      *(float4*)(gate_out + ob + s4 * 4) = make_float4(val[s4 * 4] * inv, val[s4 * 4 + 1] * inv, val[s4 * 4 + 2] * inv, val[s4 * 4 + 3] * inv);
    }
  }
}

DEVINL void dec16(const uint2& w, f32x2 (&d)[8]) {
  d[0] = __builtin_amdgcn_cvt_scalef32_pk_f32_fp4(w.x, 1.0f, 0);
  d[1] = __builtin_amdgcn_cvt_scalef32_pk_f32_fp4(w.x, 1.0f, 1);
  d[2] = __builtin_amdgcn_cvt_scalef32_pk_f32_fp4(w.x, 1.0f, 2);
  d[3] = __builtin_amdgcn_cvt_scalef32_pk_f32_fp4(w.x, 1.0f, 3);
  d[4] = __builtin_amdgcn_cvt_scalef32_pk_f32_fp4(w.y, 1.0f, 0);
  d[5] = __builtin_amdgcn_cvt_scalef32_pk_f32_fp4(w.y, 1.0f, 1);
  d[6] = __builtin_amdgcn_cvt_scalef32_pk_f32_fp4(w.y, 1.0f, 2);
  d[7] = __builtin_amdgcn_cvt_scalef32_pk_f32_fp4(w.y, 1.0f, 3);
}

DEVINL void peer_gather(const Params& p, const u16* n2, const int* idx, const float* gate, u16* dry = nullptr) {
  const int lane = threadIdx.x & 63, wid = threadIdx.x >> 6;
  const int nw = gridDim.x * 4;
  const unsigned char* ub4 = (const unsigned char*)p.ub;
  const unsigned char* vb4 = (const unsigned char*)p.vb;
  for (int tok = blockIdx.x * 4 + wid; tok < T; tok += nw) {
    f32x2 xn[8], acc2[8];
    {
      const uint4* np = (const uint4*)(n2 + (size_t)tok * 1024 + lane * 16);
      uint4 a = np[0], c = np[1];
      uint32_t wv[8] = {a.x, a.y, a.z, a.w, c.x, c.y, c.z, c.w};
#pragma unroll
      for (int i = 0; i < 8; ++i) xn[i] = (f32x2){bflo(wv[i]), bfhi(wv[i])};
    }
#pragma unroll
    for (int i = 0; i < 8; ++i) acc2[i] = (f32x2){0.f, 0.f};
    const int id0 = idx[(size_t)tok * 128 + lane], id1 = idx[(size_t)tok * 128 + 64 + lane];
    const float g0 = gate[(size_t)tok * 128 + lane], g1 = gate[(size_t)tok * 128 + 64 + lane];
#pragma unroll 1
    for (int e = 0; e < 128; e += 16) {
      const int idv = (e < 64) ? id0 : id1;
      const float gv = (e < 64) ? g0 : g1;
      const int eb = e & 63;
      uint2 ur[16], vr[16];
      float us[16], vs[16];
#pragma unroll
      for (int q = 0; q < 16; ++q) {
        const int id = __builtin_amdgcn_readlane(idv, eb + q);
        ur[q] = *(const uint2*)(ub4 + (size_t)id * 512 + lane * 8);
        vr[q] = *(const uint2*)(vb4 + (size_t)id * 512 + lane * 8);
        us[q] = p.usc[id];
        vs[q] = p.vsc[id];
      }
      float mine = 0.f;
#pragma unroll
      for (int q = 0; q < 16; ++q) {
        f32x2 d[8];
        dec16(ur[q], d);
        f32x2 s0 = xn[0] * d[0], s1 = xn[1] * d[1];
        s0 = xn[2] * d[2] + s0; s1 = xn[3] * d[3] + s1;
        s0 = xn[4] * d[4] + s0; s1 = xn[5] * d[5] + s1;
        s0 = xn[6] * d[6] + s0; s1 = xn[7] * d[7] + s1;
        s0 = s0 + s1;
        float pr = row16_sum(s0[0] + s0[1]) * us[q];
        mine = ((lane & 15) == q) ? pr : mine;
      }
      mine += __shfl_xor(mine, 16);
      mine += __shfl_xor(mine, 32);
      const float gl = __shfl(gv, eb + (lane & 15));
      const float coefv = gl * 0.5f * mine * (1.f + erff(mine * 0.7071067811865476f));
#pragma unroll
      for (int q = 0; q < 16; ++q) {
        const float coef = __int_as_float(__builtin_amdgcn_readlane(__float_as_int(coefv), q)) * vs[q];
        const f32x2 c2 = {coef, coef};
        f32x2 d[8];
        dec16(vr[q], d);
#pragma unroll
        for (int i = 0; i < 8; ++i) acc2[i] = c2 * d[i] + acc2[i];
      }
    }
    float acc[16];
#pragma unroll
    for (int i = 0; i < 8; ++i) { acc[2 * i] = acc2[i][0]; acc[2 * i + 1] = acc2[i][1]; }
    const float* gt2 = p.mod + (tok >> 11) * 6144 + 5120 + lane * 16;
    float* op = p.out + (size_t)tok * 1024 + lane * 16;
#pragma unroll
    for (int i = 0; i < 4; ++i) {
      float4 hv = *(const float4*)(op + i * 4);
      float4 gv4 = *(const float4*)(gt2 + i * 4);
      hv.x += gv4.x * acc[i * 4]; hv.y += gv4.y * acc[i * 4 + 1];
      hv.z += gv4.z * acc[i * 4 + 2]; hv.w += gv4.w * acc[i * 4 + 3];
      if (dry) {
        uint2 o; o.x = pack2(hv.x, hv.y); o.y = pack2(hv.z, hv.w);
        *(uint2*)(dry + (size_t)tok * 1024 + lane * 16 + i * 4) = o;
      } else {
        *(float4*)(op + i * 4) = hv;
      }
    }
  }
}


#define XB_TMO      128
#define XB_XCNT(j)  (256  + 64 * (j))
#define XB_XSUB(j)  (1280 + 64 * (j))
#define XB_XGEN(j)  (2304 + 64 * (j))
#define XB_TOP      3328
#define XB_TOPGEN   3392
#define XCD_BAR_WORDS 3456
#define XB_SPIN_CAP (1u << 18)
#define LAS __attribute__((address_space(3)))
DEVINL unsigned xb_ld(unsigned* p) { return __hip_atomic_load(p, __ATOMIC_RELAXED, __HIP_MEMORY_SCOPE_AGENT); }
DEVINL unsigned xb_add(unsigned* p, unsigned v) { return __hip_atomic_fetch_add(p, v, __ATOMIC_RELAXED, __HIP_MEMORY_SCOPE_AGENT); }
DEVINL unsigned xb_xcc_id() { return (unsigned)__builtin_amdgcn_s_getreg((3 << 11) | 20) & 0xFu; }
#define XB_SPIN(cond, bar) do { unsigned _sp = 0; while (cond) { __builtin_amdgcn_s_sleep(1); \
    if ((++_sp & 255u) == 0u) { if (xb_ld(&(bar)[XB_TMO])) break; if (_sp > XB_SPIN_CAP) { atomicAdd(&(bar)[XB_TMO], 1u); break; } } } } while (0)
struct XcdBarrier { unsigned* bar; unsigned x; volatile LAS unsigned* st; };
DEVINL XcdBarrier xcd_barrier_post(unsigned* bar, volatile LAS unsigned* st) {
  XcdBarrier b; b.bar = bar; b.x = xb_xcc_id(); b.st = st;
  if (threadIdx.x == 0) (void)xb_add(&bar[XB_XCNT(b.x)], 1u);
  return b;
}
DEVINL void xcd_barrier_complete(unsigned* bar, unsigned x, unsigned& nloc, unsigned& nx) {
  const unsigned G = gridDim.x * gridDim.y * gridDim.z;
  unsigned sum, cnt, mine, sp = 0u;
  for (;;) {
    sum = 0u; cnt = 0u; mine = 0u;
#pragma unroll
    for (unsigned j = 0; j < 16; ++j) { const unsigned c = xb_ld(&bar[XB_XCNT(j)]); sum += c; cnt += (c > 0u) ? 1u : 0u; mine = (j == x) ? c : mine; }
    if (sum == G) break;
    __builtin_amdgcn_s_sleep(1);
    if ((++sp & 255u) == 0u) { if (xb_ld(&bar[XB_TMO])) break; if (sp > XB_SPIN_CAP) { atomicAdd(&bar[XB_TMO], 1u); break; } }
  }
  nloc = mine > 0u ? mine : 1u; nx = cnt > 0u ? cnt : 1u;
}
DEVINL void xcd_barrier(const XcdBarrier& b) {
  asm volatile("s_waitcnt vmcnt(0)" ::: "memory");
  __syncthreads();
  if (threadIdx.x == 0) {
    unsigned* bar = b.bar;
    __builtin_amdgcn_s_waitcnt(0);
    unsigned nloc = b.st[0], nx = b.st[1];
    if (nloc == 0u) { xcd_barrier_complete(bar, b.x, nloc, nx); b.st[0] = nloc; b.st[1] = nx; }
    const unsigned old = xb_add(&bar[XB_XSUB(b.x)], 1u);
    const unsigned gen = old / nloc;
    if (old + 1u == (gen + 1u) * nloc) {
      __builtin_amdgcn_fence(__ATOMIC_RELEASE, "agent");
      asm volatile("s_waitcnt vmcnt(0)" ::: "memory");
      const unsigned og = xb_add(&bar[XB_TOP], 1u);
      const unsigned tg = og / nx;
      if (og + 1u == (tg + 1u) * nx) xb_add(&bar[XB_TOPGEN], 1u);
      else XB_SPIN(xb_ld(&bar[XB_TOPGEN]) == tg, bar);
      __builtin_amdgcn_fence(__ATOMIC_ACQUIRE, "agent");
      xb_add(&bar[XB_XGEN(b.x)], 1u);
      asm volatile("s_waitcnt vmcnt(0)" ::: "memory");
    } else {
      XB_SPIN(xb_ld(&bar[XB_XGEN(b.x)]) == gen, bar);
      __builtin_amdgcn_fence(__ATOMIC_ACQUIRE, "agent");
      asm volatile("s_waitcnt vmcnt(0)" ::: "memory");
    }
  }
  __syncthreads();
}

DEVINL void run_phase(const Params& p, int ph, char* smem, int cu_role = 0) {
  const int G = gridDim.x;
  u16* merged = p.z_rkv;
  u16* qpeer = p.z_rkv;
  int* pidx = (int*)p.z_attn;
  float* pgate = (float*)(p.z_attn + (size_t)T * 128 * 2);
  float* plv = (float*)((char*)p.z_attn + (size_t)T * 128 * 8);
  int* pli = (int*)((char*)p.z_attn + (size_t)T * 128 * 16);
  u16* X = (u16*)((char*)p.ub + (size_t)16384 * 1024);
  switch (ph) {
    case 0: phase0(p, smem); break;
    case 1:
      norm_rows_fp8(p);
      for (int t = blockIdx.x; t < 1920; t += G) transpose_tile_fp8(p, t, smem);
      break;
    case 2: {
      if (cu_role & 1) __builtin_amdgcn_s_sleep(22);
      Epi1 e{p};
      for_tiles_la(256, 60, [&](int mt, int nt, bool pre, bool hn, int mt2, int nt2) {
        gemm_tile<true>(p.bufB, 1024, p.w_in_t, 1024, 1024, mt * 128, nt * 128, smem, e, pre,
                        GemmNext{p.bufB, 1024, p.w_in_t, 1024, mt2 * 128, nt2 * 128, hn});
      });
    } break;
    case 3: {
      int* sh = (int*)smem;
      const int role = cu_role;
      for (int pass = 0; pass < 2; ++pass) {
        const bool do_scan = (pass == 0) == (role == 0);
        if (do_scan) {
          for (;;) {
            __syncthreads();
            if (threadIdx.x == 0) sh[1] = atomicAdd(&p.ctr[2048], 1);
            __syncthreads();
            const int u = sh[1];
            if (u >= 256) break;
            rwkv_scan_unit(p, X, u, smem);
          }
        } else {
          for (;;) {
            __syncthreads();
            if (threadIdx.x == 0) sh[1] = atomicAdd(&p.ctr[2049], 1);
            __syncthreads();
            const int u = sh[1];
            if (u >= 6144) break;
            attn_unit(p, u, smem);
          }
          if (pass == 0) { late_transpose_queue(p, smem); cvt_fp4_queue(p, smem); }
        }
      }
      late_transpose_queue(p, smem);
      cvt_fp4_queue(p, smem);
    } break;
    case 4: attn_merge(p); break;
    case 15: prep_phase(p, X); break;
    case 5: {
      if (cu_role & 1) __builtin_amdgcn_s_sleep(22);
      Epi5a ea{p, merged};
      Epi5b eb{p, merged};
      for_tiles_la(256, 8, [&](int mt, int nt, bool pre, bool hn, int mt2, int nt2) {
        gemm_tile(p.bufB, 1024, p.w_br_r_t, 1024, 1024, mt * 128, nt * 128, smem, ea, pre,
                  GemmNext{p.z_lora, 256, p.w_br_a_t, 256, mt * 128, nt * 128, true});
        gemm_tile(p.z_lora, 256, p.w_br_a_t, 256, 256, mt * 128, nt * 128, smem, eb, true,
                  GemmNext{p.bufB, 1024, p.w_br_r_t, 1024, mt2 * 128, nt2 * 128, hn});
      });
    } break;
    case 6: {
      if (cu_role & 1) __builtin_amdgcn_s_sleep(22);
      Epi6 e{p};
      for_tiles_la(256, 8, [&](int mt, int nt, bool pre, bool hn, int mt2, int nt2) {
        gemm_tile(merged, 1024, p.w_out_t, 1024, 1024, mt * 128, nt * 128, smem, e, pre,
                  GemmNext{merged, 1024, p.w_out_t, 1024, mt2 * 128, nt2 * 128, hn});
      });
    } break;
    case 7: norm_rows(p.out, p.norm2_g, p.mod, 3072, 4096, p.bufB); break;
    case 8: {
      if (cu_role & 1) __builtin_amdgcn_s_sleep(22);
      Epi8 e{qpeer};
      for_tiles_la(256, 16, [&](int mt, int nt, bool pre, bool hn, int mt2, int nt2) {
        gemm_tile(p.bufB, 1024, p.wq_t, 1024, 1024, mt * 128, nt * 128, smem, e, pre,
                  GemmNext{p.bufB, 1024, p.wq_t, 1024, mt2 * 128, nt2 * 128, hn});
      });
    } break;
    case 9:
      peer_route_a(p, qpeer, plv, pli, smem);
      break;
    case 16: peer_route_b(plv, pli, pidx, pgate); break;
    case 10: peer_gather(p, p.bufB, pidx, pgate); break;
    case 11: peer_gather(p, p.bufB, pidx, pgate, p.z_rkv + (size_t)T * 2048); break;
  }
}
constexpr int NPHASE = 11;

#if MULTI
__global__ void __launch_bounds__(256, 2) phase_kernel(Params p, int ph) {
  __shared__ __attribute__((aligned(16))) char smem[SMEM_BYTES];
  run_phase(p, ph, smem);
}
#else
__global__ void __launch_bounds__(256, 2) mega_kernel(Params p) {
  __shared__ __attribute__((aligned(16))) char smem[SMEM_BYTES];
  __shared__ uint4 xb_words;
  cg::grid_group grid = cg::this_grid();
  if (threadIdx.x == 0) xb_words = make_uint4(0u, 0u, 0u, 0u);
  __syncthreads();
  __shared__ int cu_role_s;
  if (threadIdx.x == 0) {
    unsigned cu = __builtin_amdgcn_s_getreg(0x3A04);
    unsigned xcc = __builtin_amdgcn_s_getreg(0x1814);
    cu_role_s = atomicAdd(&p.ctr[(xcc & 7) * 256 + (cu & 255)], 1);
  }
  __syncthreads();
  const int cu_role = cu_role_s;
  XcdBarrier xb = xcd_barrier_post(p.bar, (volatile LAS unsigned*)&xb_words);
#define SYNC() xcd_barrier(xb)
  if (p.x == nullptr) grid.sync();
  run_phase(p, 0, smem, cu_role); SYNC();
  if (DUP == 0) { run_phase(p, 0, smem, cu_role); SYNC(); }
  run_phase(p, 1, smem, cu_role); SYNC();
  if (DUP == 1) { run_phase(p, 1, smem, cu_role); SYNC(); }
  run_phase(p, 2, smem, cu_role); SYNC();
  run_phase(p, 15, smem, cu_role); SYNC();
  if (DUP == 2) { run_phase(p, 2, smem, cu_role); SYNC(); }
  run_phase(p, 3, smem, cu_role); SYNC();
  run_phase(p, 4, smem, cu_role); SYNC();
  if (DUP == 4) { run_phase(p, 4, smem, cu_role); SYNC(); }
  run_phase(p, 5, smem, cu_role); SYNC();
  if (DUP == 5) { run_phase(p, 5, smem, cu_role); SYNC(); }
  run_phase(p, 6, smem, cu_role); SYNC();
  if (DUP == 6) { run_phase(p, 6, smem, cu_role); SYNC(); }
  run_phase(p, 7, smem, cu_role); SYNC();
  if (DUP == 7) { run_phase(p, 7, smem, cu_role); SYNC(); }
  run_phase(p, 8, smem, cu_role); SYNC();
  if (DUP == 8) { run_phase(p, 8, smem, cu_role); SYNC(); }
  run_phase(p, 9, smem, cu_role); SYNC();
  run_phase(p, 16, smem, cu_role); SYNC();
  if (DUP == 9) { run_phase(p, 9, smem, cu_role); SYNC(); }
  if (DUP == 10) { run_phase(p, 11, smem, cu_role); SYNC(); }
  run_phase(p, 10, smem, cu_role);
}
#endif

extern "C" void kernel_launch(void* const* d_in, const int* in_sizes, int n_in, void* d_out, int out_size, void* d_ws,
                              size_t ws_size, hipStream_t stream) {
  Params p{};
  const float** pf = (const float**)&p;
  for (int i = 0; i < 28; ++i) pf[i] = (const float*)d_in[i];
  p.out = (float*)d_out;
  char* ws = (char*)d_ws;
  size_t off = 0;
  auto take = [&](size_t bytes) { char* r = ws + off; off += (bytes + 255) & ~(size_t)255; return r; };
  p.w_in_t = (u16*)take((size_t)7680 * 1024 * 2);
  p.w_br_r_t = (u16*)take((size_t)1024 * 1024 * 2);
  p.w_br_a_t = (u16*)take((size_t)1024 * 256 * 2);
  p.w_out_t = (u16*)take((size_t)1024 * 1024 * 2);
  p.wq_t = (u16*)take((size_t)2048 * 1024 * 2);
  p.k1b = (u16*)take(128 * 128 * 2);
  p.k2b = (u16*)take(128 * 128 * 2);
  p.w2t = (u16*)take(1024 * 64 * 2);
  p.a2t = (u16*)take(1024 * 64 * 2);
  p.g2t = (u16*)take(1024 * 128 * 2);
  p.mod = (float*)take(16 * 6144 * 4);
  p.lse = (float*)take((size_t)3 * T * 4 * 4);
  p.bar = (unsigned*)take(4096 * 4);
  p.ctr = (int*)take(4096 * 4);
  p.colamax = (int*)take(8192 * 4);
  p.n1s = (float*)take((size_t)T * 4);
  p.w_in_s = (float*)take(8192 * 4);
  p.usc = (float*)take(16384 * 4);
  p.vsc = (float*)take(16384 * 4);
  p.bufB = (u16*)take((size_t)T * 1024 * 2);
  p.z_rkv = (u16*)take((size_t)T * 3072 * 2);
  p.z_lora = (u16*)take((size_t)T * 256 * 2);
  p.z_attn = (u16*)take((size_t)T * 2304 * 2);
  p.ub = (u16*)take((size_t)16384 * 1024 * 2);
  p.vb = (u16*)take((size_t)16384 * 1024 * 2);
  p.gates = (u16*)d_out;
  if (off > ws_size) { fprintf(stderr, "workspace too small: need %zu have %zu\n", off, ws_size); return; }
#if MULTI
  (void)hipMemsetAsync(p.bar, 0, 4 * 4096 * 4, stream);
  for (int ph = 0; ph < NPHASE; ++ph) phase_kernel<<<512, 256, 0, stream>>>(p, ph);
#else
  static int grid_blocks = 0;
  if (!grid_blocks) {
    int dev = 0, cus = 0, per_cu = 0;
    hipGetDevice(&dev);
    hipDeviceGetAttribute(&cus, hipDeviceAttributeMultiprocessorCount, dev);
    hipOccupancyMaxActiveBlocksPerMultiprocessor(&per_cu, mega_kernel, 256, 0);
    if (per_cu > 2) per_cu = 2;
    grid_blocks = cus * per_cu;
  }
  (void)hipMemsetAsync(p.bar, 0, 4 * 4096 * 4, stream);
  void* args[] = {&p};
  hipError_t e = hipLaunchCooperativeKernel((void*)mega_kernel, dim3(grid_blocks), dim3(256), args, 0, stream);
  if (e != hipSuccess) fprintf(stderr, "cooperative launch failed: %s (grid %d)\n", hipGetErrorString(e), grid_blocks);
#endif
}
```

```cpp
#include <hip/hip_runtime.h>
#include <hip/hip_cooperative_groups.h>
#include <cstdio>
#include <cstdint>
namespace cg = cooperative_groups;

#ifndef MULTI
#define MULTI 0
#endif
#ifndef DUP
#define DUP -1
#endif

typedef unsigned short u16;
using bf16x8 = __attribute__((ext_vector_type(8))) short;
using bf16x4 = __attribute__((ext_vector_type(4))) short;
using f32x4  = __attribute__((ext_vector_type(4))) float;
using u32x4  = __attribute__((ext_vector_type(4))) unsigned int;
using f32x2  = __attribute__((ext_vector_type(2))) float;

#define DEVINL __device__ __forceinline__

constexpr int T = 32768;
constexpr int SMEM_BYTES = 79872;

struct Params {
  const float *x, *c, *w_ada, *b_ada, *norm1_g, *w_in, *mu, *w0, *w2, *a0, *a2, *g2, *k_k, *k_a, *r_k,
      *lnx_g, *lnx_b, *qng, *kng, *w_br_r, *w_br_a, *w_out, *norm2_g, *wq, *k1, *k2, *pu, *pv;
  float* out;
  u16 *w_in_t, *w_br_r_t, *w_br_a_t, *w_out_t, *wq_t, *k1b, *k2b, *w2t, *a2t, *g2t;
  float *mod, *lse, *usc, *vsc, *n1s, *w_in_s;
  int* colamax;
  unsigned* bar;
  int* ctr;
  u16 *bufB, *z_rkv, *z_lora, *z_attn, *ub, *vb, *gates;
};

DEVINL u16 f2bf(float f) {
  uint32_t u = __float_as_uint(f);
  u += 0x7fffu + ((u >> 16) & 1u);
  return (u16)(u >> 16);
}
DEVINL float bf2f(u16 h) { return __uint_as_float(((uint32_t)h) << 16); }
typedef __bf16 hwbf16x2 __attribute__((ext_vector_type(2)));
DEVINL uint32_t pack2(float a, float b) {
  f32x2 v = {a, b};
  hwbf16x2 r = __builtin_convertvector(v, hwbf16x2);
  return *(uint32_t*)&r;
}
DEVINL float bflo(uint32_t u) { return __uint_as_float(u << 16); }
DEVINL float bfhi(uint32_t u) { return __uint_as_float(u & 0xffff0000u); }
DEVINL float sigm(float x) { return 1.f / (1.f + __expf(-x)); }
template <int CTRL>
DEVINL float dpp_f(float x) {
  return __int_as_float(__builtin_amdgcn_update_dpp(0, __float_as_int(x), CTRL, 0xF, 0xF, true));
}
DEVINL float quad_sum(float v) {
  v += dpp_f<0xB1>(v);
  v += dpp_f<0x4E>(v);
  return v;
}
DEVINL float row16_sum(float v) {
  v += dpp_f<0x128>(v); v += dpp_f<0x124>(v); v += dpp_f<0x122>(v); v += dpp_f<0x121>(v);
  return v;
}
DEVINL float oct_sum(float v) {
  v += dpp_f<0xB1>(v);
  v += dpp_f<0x4E>(v);
  v += dpp_f<0x141>(v);
  return v;
}
DEVINL float row16_max(float v) {
  v = fmaxf(v, dpp_f<0x128>(v)); v = fmaxf(v, dpp_f<0x124>(v)); v = fmaxf(v, dpp_f<0x122>(v)); v = fmaxf(v, dpp_f<0x121>(v));
  return v;
}
DEVINL float wave_sum(float v) {
  v = row16_sum(v);
  v += __shfl_xor(v, 16);
  v += __shfl_xor(v, 32);
  return v;
}
DEVINL float wave_max(float v) {
  v = row16_max(v);
  v = fmaxf(v, __shfl_xor(v, 16));
  v = fmaxf(v, __shfl_xor(v, 32));
  return v;
}

DEVINL void p0_mod_unit(const Params& p, int unit, char* smem) {
  float* sC = (float*)smem;
  const int tid = threadIdx.x, lane = tid & 63, wid = tid >> 6;
  __syncthreads();
  for (int e = tid; e < 16 * 1024; e += 256) {
    int b = e >> 10, k = e & 1023;
    float v = p.c[e];
    sC[k * 16 + b] = v / (1.f + __expf(-v));
  }
  __syncthreads();
  const int col = unit * 64 + lane;
  float acc[16];
#pragma unroll
  for (int b = 0; b < 16; ++b) acc[b] = 0.f;
  const float* wp = p.w_ada + (size_t)(wid * 256) * 6144 + col;
#pragma unroll 16
  for (int k = 0; k < 256; ++k) {
    float wv = wp[(size_t)k * 6144];
    const float4* s4 = (const float4*)(sC + (wid * 256 + k) * 16);
    float4 s0 = s4[0], s1 = s4[1], s2 = s4[2], s3 = s4[3];
    acc[0] += s0.x * wv; acc[1] += s0.y * wv; acc[2] += s0.z * wv; acc[3] += s0.w * wv;
    acc[4] += s1.x * wv; acc[5] += s1.y * wv; acc[6] += s1.z * wv; acc[7] += s1.w * wv;
    acc[8] += s2.x * wv; acc[9] += s2.y * wv; acc[10] += s2.z * wv; acc[11] += s2.w * wv;
    acc[12] += s3.x * wv; acc[13] += s3.y * wv; acc[14] += s3.z * wv; acc[15] += s3.w * wv;
  }
  __syncthreads();
  float* sR = (float*)smem;
#pragma unroll
  for (int b = 0; b < 16; ++b) sR[(wid * 16 + b) * 64 + lane] = acc[b];
  __syncthreads();
  for (int e = tid; e < 1024; e += 256) {
    int b = e >> 6, l = e & 63;
    float s = sR[(b)*64 + l] + sR[(16 + b) * 64 + l] + sR[(32 + b) * 64 + l] + sR[(48 + b) * 64 + l];
    int cc = unit * 64 + l;
    p.mod[b * 6144 + cc] = s + p.b_ada[cc];
  }
}

DEVINL void transpose_tile(const float* __restrict__ src, int K, int N, u16* __restrict__ dst, int tile, char* smem) {
  float(*s)[65] = (float(*)[65])smem;
  const int tid = threadIdx.x;
  const int nkt = K >> 6;
  const int kt = tile % nkt, nt = tile / nkt;
  __syncthreads();
#pragma unroll
  for (int i = 0; i < 16; ++i) {
    int r = (tid >> 6) + 4 * i;
    s[r][tid & 63] = src[(size_t)(kt * 64 + r) * N + nt * 64 + (tid & 63)];
  }
  __syncthreads();
#pragma unroll
  for (int i = 0; i < 16; ++i) {
    int n = (tid >> 6) + 4 * i;
    dst[(size_t)(nt * 64 + n) * K + kt * 64 + (tid & 63)] = f2bf(s[tid & 63][n]);
  }
}

DEVINL void cvt_straight(const float* __restrict__ src, u16* __restrict__ dst, size_t n4, size_t start, size_t stride) {
  for (size_t i = start; i < n4; i += stride) {
    float4 v = ((const float4*)src)[i];
    uint2 o; o.x = pack2(v.x, v.y); o.y = pack2(v.z, v.w);
    ((uint2*)dst)[i] = o;
  }
}

DEVINL void cvt_row_fp4(const float* __restrict__ src, unsigned char* __restrict__ dst, float* __restrict__ inv_scale, int row) {
  const int lane = threadIdx.x & 63;
  {
    const float4* sp = (const float4*)(src + (size_t)row * 1024 + lane * 16);
    float4 v0 = sp[0], v1 = sp[1], v2 = sp[2], v3 = sp[3];
    float am = fmaxf(fmaxf(fmaxf(fabsf(v0.x), fabsf(v0.y)), fmaxf(fabsf(v0.z), fabsf(v0.w))),
                     fmaxf(fmaxf(fabsf(v1.x), fabsf(v1.y)), fmaxf(fabsf(v1.z), fabsf(v1.w))));
    am = fmaxf(am, fmaxf(fmaxf(fmaxf(fabsf(v2.x), fabsf(v2.y)), fmaxf(fabsf(v2.z), fabsf(v2.w))),
                         fmaxf(fmaxf(fabsf(v3.x), fabsf(v3.y)), fmaxf(fabsf(v3.z), fabsf(v3.w)))));
    am = wave_max(am);
    const float sc = (am > 0.f) ? 6.f / am : 1.f;
    const float inv = (am > 0.f) ? am * (1.f / 6.f) : 1.f;
    unsigned w0 = 0, w1 = 0;
    w0 = __builtin_amdgcn_cvt_scalef32_pk_fp4_f32(w0, v0.x * sc, v0.y * sc, 1.0f, 0);
    w0 = __builtin_amdgcn_cvt_scalef32_pk_fp4_f32(w0, v0.z * sc, v0.w * sc, 1.0f, 1);
    w0 = __builtin_amdgcn_cvt_scalef32_pk_fp4_f32(w0, v1.x * sc, v1.y * sc, 1.0f, 2);
    w0 = __builtin_amdgcn_cvt_scalef32_pk_fp4_f32(w0, v1.z * sc, v1.w * sc, 1.0f, 3);
    w1 = __builtin_amdgcn_cvt_scalef32_pk_fp4_f32(w1, v2.x * sc, v2.y * sc, 1.0f, 0);
    w1 = __builtin_amdgcn_cvt_scalef32_pk_fp4_f32(w1, v2.z * sc, v2.w * sc, 1.0f, 1);
    w1 = __builtin_amdgcn_cvt_scalef32_pk_fp4_f32(w1, v3.x * sc, v3.y * sc, 1.0f, 2);
    w1 = __builtin_amdgcn_cvt_scalef32_pk_fp4_f32(w1, v3.z * sc, v3.w * sc, 1.0f, 3);
    *(uint2*)(dst + (size_t)row * 512 + lane * 8) = make_uint2(w0, w1);
    if (lane == 0) inv_scale[row] = inv;
  }
}

DEVINL void cvt_fp4_queue(const Params& p, char* smem) {
  int* sh = (int*)smem;
  const int wid = threadIdx.x >> 6;
  for (;;) {
    __syncthreads();
    if (threadIdx.x == 0) sh[0] = atomicAdd(&p.ctr[2050], 1);
    __syncthreads();
    const int c = sh[0];
    if (c >= 2048) break;
    const bool isv = c >= 1024;
    const int r0 = (c & 1023) * 16 + wid * 4;
#pragma unroll
    for (int i = 0; i < 4; ++i)
      cvt_row_fp4(isv ? p.pv : p.pu, (unsigned char*)(isv ? p.vb : p.ub), isv ? p.vsc : p.usc, r0 + i);
  }
}

DEVINL void late_transpose_queue(const Params& p, char* smem) {
  int* sh = (int*)(smem + 64 * 65 * 4);
  for (;;) {
    __syncthreads();
    if (threadIdx.x == 0) sh[0] = atomicAdd(&p.ctr[2051], 1);
    __syncthreads();
    int t = sh[0];
    if (t >= 1088) break;
    if (t < 256) { transpose_tile(p.w_br_r, 1024, 1024, p.w_br_r_t, t, smem); continue; } t -= 256;
    if (t < 64) { transpose_tile(p.w_br_a, 256, 1024, p.w_br_a_t, t, smem); continue; } t -= 64;
    if (t < 256) { transpose_tile(p.w_out, 1024, 1024, p.w_out_t, t, smem); continue; } t -= 256;
    transpose_tile(p.wq, 1024, 2048, p.wq_t, t, smem);
  }
}

DEVINL void phase0(const Params& p, char* smem) {
  const int G = gridDim.x;
  constexpr int NT0 = 120, NT5 = 16, NT6 = 16, NT7 = 32;
  constexpr int NTR = NT0 + NT5 + NT6 + NT7;
  for (int u = blockIdx.x; u < 96 + NTR; u += G) {
    if (u < 96) { p0_mod_unit(p, u, smem); continue; }
    int t = u - 96;
    if (t < NT0) {
      {
        const int nb = t >> 2, part = t & 3;
        const int n = nb * 256 + threadIdx.x;
        const float* wp = p.w_in + (size_t)(part * 256) * 7680 + n;
        float m = 0.f;
#pragma unroll 16
        for (int k = 0; k < 256; ++k) m = fmaxf(m, fabsf(wp[(size_t)k * 7680]));
        atomicMax(&p.colamax[n], __float_as_int(m));
      }
      continue;
    } t -= NT0;
    if (t < NT5) { transpose_tile(p.w2, 64, 1024, p.w2t, t, smem); continue; } t -= NT5;
    if (t < NT6) { transpose_tile(p.a2, 64, 1024, p.a2t, t, smem); continue; } t -= NT6;
    transpose_tile(p.g2, 128, 1024, p.g2t, t, smem);
  }
  size_t start = (size_t)blockIdx.x * 256 + threadIdx.x, stride = (size_t)G * 256;
  cvt_straight(p.k1, p.k1b, 128 * 128 / 4, start, stride);
  cvt_straight(p.k2, p.k2b, 128 * 128 / 4, start, stride);
}

DEVINL void norm_rows(const float* __restrict__ xin, const float* __restrict__ g, const float* __restrict__ mod,
                      int sh_off, int sc_off, u16* __restrict__ dst) {
  const int lane = threadIdx.x & 63, wid = threadIdx.x >> 6;
  const int nw = gridDim.x * 4;
  for (int row = blockIdx.x * 4 + wid; row < T; row += nw) {
    const float4* xr = (const float4*)(xin + (size_t)row * 1024);
    float4 v[4];
    float ss = 0.f;
#pragma unroll
    for (int i = 0; i < 4; ++i) {
      v[i] = xr[i * 64 + lane];
      ss += v[i].x * v[i].x + v[i].y * v[i].y + v[i].z * v[i].z + v[i].w * v[i].w;
    }
    ss = wave_sum(ss);
    const float rstd = rsqrtf(ss * (1.f / 1024.f) + 1e-6f);
    const float* mb = mod + (row >> 11) * 6144;
#pragma unroll
    for (int i = 0; i < 4; ++i) {
      int col = (i * 64 + lane) * 4;
      float4 gg = *(const float4*)(g + col);
      float4 sc = *(const float4*)(mb + sc_off + col);
      float4 sh = *(const float4*)(mb + sh_off + col);
      float o0 = v[i].x * rstd * gg.x * (1.f + sc.x) + sh.x;
      float o1 = v[i].y * rstd * gg.y * (1.f + sc.y) + sh.y;
      float o2 = v[i].z * rstd * gg.z * (1.f + sc.z) + sh.z;
      float o3 = v[i].w * rstd * gg.w * (1.f + sc.w) + sh.w;
      uint2 o; o.x = pack2(o0, o1); o.y = pack2(o2, o3);
      *(uint2*)(dst + (size_t)row * 1024 + col) = o;
    }
  }
}


DEVINL void transpose_tile_fp8(const Params& p, int tile, char* smem) {
  float(*s)[65] = (float(*)[65])smem;
  const int tid = threadIdx.x;
  const int kt = tile & 15, nt = tile >> 4;
  unsigned char* dst = (unsigned char*)p.w_in_t;
  __syncthreads();
#pragma unroll
  for (int i = 0; i < 16; ++i) {
    int r = (tid >> 6) + 4 * i;
    s[r][tid & 63] = p.w_in[(size_t)(kt * 64 + r) * 7680 + nt * 64 + (tid & 63)];
  }
  __syncthreads();
  const int k4 = (tid & 15) * 4;
#pragma unroll
  for (int i = 0; i < 4; ++i) {
    const int n = (tid >> 4) + 16 * i;
    const float am = __int_as_float(p.colamax[nt * 64 + n]);
    const float sc = (am > 0.f) ? 224.f / am : 1.f;
    int w = 0;
    w = __builtin_amdgcn_cvt_pk_fp8_f32(s[k4][n] * sc, s[k4 + 1][n] * sc, w, false);
    w = __builtin_amdgcn_cvt_pk_fp8_f32(s[k4 + 2][n] * sc, s[k4 + 3][n] * sc, w, true);
    *(int*)(dst + (size_t)(nt * 64 + n) * 1024 + kt * 64 + k4) = w;
    if (kt == 0 && k4 == 0) p.w_in_s[nt * 64 + n] = (am > 0.f) ? am * (1.f / 224.f) : 1.f;
  }
}

DEVINL void norm_rows_fp8(const Params& p) {
  const int lane = threadIdx.x & 63, wid = threadIdx.x >> 6;
  const int nw = gridDim.x * 4;
  unsigned char* dst = (unsigned char*)p.bufB;
  for (int row = blockIdx.x * 4 + wid; row < T; row += nw) {
    const float4* xr = (const float4*)(p.x + (size_t)row * 1024);
    float4 v[4];
    float ss = 0.f;
#pragma unroll
    for (int i = 0; i < 4; ++i) {
      v[i] = xr[i * 64 + lane];
      ss += v[i].x * v[i].x + v[i].y * v[i].y + v[i].z * v[i].z + v[i].w * v[i].w;
    }
    ss = wave_sum(ss);
    const float rstd = rsqrtf(ss * (1.f / 1024.f) + 1e-6f);
    const float* mb = p.mod + (row >> 11) * 6144;
    float o[16];
    float am = 0.f;
#pragma unroll
    for (int i = 0; i < 4; ++i) {
      int col = (i * 64 + lane) * 4;
      float4 gg = *(const float4*)(p.norm1_g + col);
      float4 sc = *(const float4*)(mb + 1024 + col);
      float4 sh = *(const float4*)(mb + col);
      o[i * 4 + 0] = v[i].x * rstd * gg.x * (1.f + sc.x) + sh.x;
      o[i * 4 + 1] = v[i].y * rstd * gg.y * (1.f + sc.y) + sh.y;
      o[i * 4 + 2] = v[i].z * rstd * gg.z * (1.f + sc.z) + sh.z;
      o[i * 4 + 3] = v[i].w * rstd * gg.w * (1.f + sc.w) + sh.w;
      am = fmaxf(am, fmaxf(fmaxf(fabsf(o[i * 4]), fabsf(o[i * 4 + 1])), fmaxf(fabsf(o[i * 4 + 2]), fabsf(o[i * 4 + 3]))));
    }
    am = wave_max(am);
    const float qs = (am > 0.f) ? 224.f / am : 1.f;
#pragma unroll
    for (int i = 0; i < 4; ++i) {
      int col = (i * 64 + lane) * 4;
      int w = 0;
      w = __builtin_amdgcn_cvt_pk_fp8_f32(o[i * 4] * qs, o[i * 4 + 1] * qs, w, false);
      w = __builtin_amdgcn_cvt_pk_fp8_f32(o[i * 4 + 2] * qs, o[i * 4 + 3] * qs, w, true);
      *(int*)(dst + (size_t)row * 1024 + col) = w;
    }
    if (lane == 0) p.n1s[row] = (am > 0.f) ? am * (1.f / 224.f) : 1.f;
  }
}

#define LDS_AS __attribute__((address_space(3)))
using i64x2 = __attribute__((ext_vector_type(2))) long;
using v8i32 = __attribute__((ext_vector_type(8))) int;
using v4i32 = __attribute__((ext_vector_type(4))) int;
template <bool FP8 = false, class Epi>
DEVINL void gemm_tile(const void* __restrict__ A, int lda, const void* __restrict__ Bt, int ldb, int K, int m0, int n0,
                      char* smem, const Epi& epi) {
  constexpr int EB = FP8 ? 1 : 2;
  constexpr int KS = 128 / EB;
  constexpr int CE = 16 / EB;
  const int tid = threadIdx.x, lane = tid & 63, wid = tid >> 6;
  const int wr = wid >> 1, wc = wid & 1;
  const int fr = lane & 15, fq = lane >> 4;
  f32x4 acc[4][4];
#pragma unroll
  for (int m = 0; m < 4; ++m)
#pragma unroll
    for (int n = 0; n < 4; ++n) acc[m][n] = (f32x4){0.f, 0.f, 0.f, 0.f};
  const int l3 = lane >> 3, cch = (lane & 7) ^ l3;
  const char* Ab = (const char*)A + (size_t)m0 * lda * EB;
  const char* Bb = (const char*)Bt + (size_t)n0 * ldb * EB;
  const uint32_t aoff = (uint32_t)((wid * 32 + l3) * lda + cch * CE) * (uint32_t)EB;
  const uint32_t boff = (uint32_t)((16 * (lane >> 5) + (l3 & 3)) * ldb + cch * CE) * (uint32_t)EB;
  const int rowB_base = (wid >> 1) * 64 + 8 * (wid & 1);
  char* ldsw = smem + wid * 4096 + lane * 16;
#define DMA(buf, k0_)                                                                                           \
  _Pragma("unroll") for (int i = 0; i < 4; ++i) {                                                               \
    __builtin_amdgcn_global_load_lds((const unsigned*)(Ab + (size_t)((i * 8 * lda + (k0_)) * EB) + aoff),       \
                                     (LDS_AS unsigned*)(ldsw + (buf) * 32768 + i * 1024), 16, 0, 0);            \
    __builtin_amdgcn_global_load_lds(                                                                           \
        (const unsigned*)(Bb + (size_t)(((rowB_base + 32 * (i & 1) + 4 * (i >> 1)) * ldb + (k0_)) * EB) + boff), \
        (LDS_AS unsigned*)(ldsw + (buf) * 32768 + 16384 + i * 1024), 16, 0, 0);                                 \
  }
  const int ra0 = (wr * 64 + fr) * 128 + (((0 + fq) ^ (fr & 7)) << 4);
  const int ra1 = (wr * 64 + fr) * 128 + (((4 + fq) ^ (fr & 7)) << 4);
  const int rb0 = 16384 + (wc * 64 + fr) * 128 + (((0 + fq) ^ (fr & 7)) << 4);
  const int rb1 = 16384 + (wc * 64 + fr) * 128 + (((4 + fq) ^ (fr & 7)) << 4);
  const int qa0 = (wr * 64 + fr) * 128 + (((2 * fq) ^ (fr & 7)) << 4);
  const int qa1 = (wr * 64 + fr) * 128 + (((2 * fq + 1) ^ (fr & 7)) << 4);
  const int qb0 = 16384 + (wc * 64 + fr) * 128 + (((2 * fq) ^ (fr & 7)) << 4);
  const int qb1 = 16384 + (wc * 64 + fr) * 128 + (((2 * fq + 1) ^ (fr & 7)) << 4);
#define LD32(off0, off1, dst)                                        \
  {                                                                  \
    dst.lo = *(const v4i32*)(off0);                                  \
    dst.hi = *(const v4i32*)(off1);                                  \
  }
#define COMPUTE(buf)                                                                                        \
  if (FP8) {                                                                                                \
    v8i32 bfr[4];                                                                                           \
    _Pragma("unroll") for (int n = 0; n < 4; ++n) LD32(smem + (buf) * 32768 + qb0 + n * 2048, smem + (buf) * 32768 + qb1 + n * 2048, bfr[n])  \
    _Pragma("unroll") for (int m = 0; m < 4; ++m) {                                                         \
      v8i32 af;                                                                                             \
      LD32(smem + (buf) * 32768 + qa0 + m * 2048, smem + (buf) * 32768 + qa1 + m * 2048, af)                \
      _Pragma("unroll") for (int n = 0; n < 4; ++n)                                                         \
        acc[m][n] = __builtin_amdgcn_mfma_scale_f32_16x16x128_f8f6f4(bfr[n], af, acc[m][n], 0, 0, 0, 127, 0, 127); \
    }                                                                                                       \
    __builtin_amdgcn_sched_barrier(0);                                                                      \
  } else {                                                                                                  \
    _Pragma("unroll") for (int ks = 0; ks < 2; ++ks) {                                                      \
      bf16x8 af[4], bfr[4];                                                                                 \
      _Pragma("unroll") for (int m = 0; m < 4; ++m) af[m] = *(const bf16x8*)(smem + (buf) * 32768 + (ks ? ra1 : ra0) + m * 2048);  \
      _Pragma("unroll") for (int n = 0; n < 4; ++n) bfr[n] = *(const bf16x8*)(smem + (buf) * 32768 + (ks ? rb1 : rb0) + n * 2048); \
      _Pragma("unroll") for (int m = 0; m < 4; ++m)                                                         \
        _Pragma("unroll") for (int n = 0; n < 4; ++n)                                                       \
          acc[m][n] = __builtin_amdgcn_mfma_f32_16x16x32_bf16(bfr[n], af[m], acc[m][n], 0, 0, 0);           \
    }                                                                                                       \
  }
  __syncthreads();
  DMA(0, 0)
  __syncthreads();
#pragma unroll 1
  for (int k0 = 0; k0 < K; k0 += 2 * KS) {
    DMA(1, k0 + KS)
    COMPUTE(0)
    __syncthreads();
    if (k0 + 2 * KS < K) { DMA(0, k0 + 2 * KS) }
    COMPUTE(1)
    __syncthreads();
  }
#undef DMA
#undef COMPUTE
#undef LD32
#pragma unroll
  for (int m = 0; m < 4; ++m) {
    int row = m0 + wr * 64 + m * 16 + fr;
    int col0 = n0 + wc * 64 + fq * 16;
    epi(row, col0, acc[m]);
  }
}

DEVINL void store16_bf16(u16* dst, const f32x4 (&v)[4]) {
  uint4 a, b;
  a.x = pack2(v[0][0], v[0][1]); a.y = pack2(v[0][2], v[0][3]);
  a.z = pack2(v[1][0], v[1][1]); a.w = pack2(v[1][2], v[1][3]);
  b.x = pack2(v[2][0], v[2][1]); b.y = pack2(v[2][2], v[2][3]);
  b.z = pack2(v[3][0], v[3][1]); b.w = pack2(v[3][2], v[3][3]);
  ((uint4*)dst)[0] = a;
  ((uint4*)dst)[1] = b;
}

struct Epi1 {
  const Params& p;
  DEVINL void operator()(int row, int col, const f32x4 (&vin)[4]) const {
    f32x4 v[4];
    {
      const float sa = p.n1s[row];
      const float* sb = p.w_in_s + col;
#pragma unroll
      for (int n = 0; n < 4; ++n) {
        const float4 s4 = *(const float4*)(sb + n * 4);
        v[n][0] = vin[n][0] * sa * s4.x; v[n][1] = vin[n][1] * sa * s4.y;
        v[n][2] = vin[n][2] * sa * s4.z; v[n][3] = vin[n][3] * sa * s4.w;
      }
    }
    if (col < 3072) store16_bf16(p.z_rkv + (size_t)row * 3072 + col, v);
    else if (col < 3328) store16_bf16(p.z_lora + (size_t)row * 256 + (col - 3072), v);
    else if (col < 5632) store16_bf16(p.z_attn + (size_t)row * 2304 + (col - 3328), v);
    else {
      f32x4 s[4];
#pragma unroll
      for (int n = 0; n < 4; ++n)
#pragma unroll
        for (int j = 0; j < 4; ++j) s[n][j] = sigm(v[n][j]);
      store16_bf16(p.gates + (size_t)row * 2048 + (col - 5632), s);
    }
  }
};
struct Epi5a {
  const Params& p; u16* merged;
  DEVINL void operator()(int row, int col, const f32x4 (&v)[4]) const {
    const uint4* gp = (const uint4*)(p.gates + (size_t)row * 2048 + col);
    uint4 g0 = gp[0], g1 = gp[1];
    uint32_t gw[8] = {g0.x, g0.y, g0.z, g0.w, g1.x, g1.y, g1.z, g1.w};
    f32x4 s[4];
#pragma unroll
    for (int n = 0; n < 4; ++n) {
      s[n][0] = v[n][0] * bflo(gw[n * 2]); s[n][1] = v[n][1] * bfhi(gw[n * 2]);
      s[n][2] = v[n][2] * bflo(gw[n * 2 + 1]); s[n][3] = v[n][3] * bfhi(gw[n * 2 + 1]);
    }
    store16_bf16(merged + (size_t)row * 1024 + col, s);
  }
};
struct Epi5b {
  const Params& p; u16* merged;
  DEVINL void operator()(int row, int col, const f32x4 (&v)[4]) const {
    const uint4* gp = (const uint4*)(p.gates + (size_t)row * 2048 + 1024 + col);
    uint4 g0 = gp[0], g1 = gp[1];
    uint32_t gw[8] = {g0.x, g0.y, g0.z, g0.w, g1.x, g1.y, g1.z, g1.w};
    const uint4* tp = (const uint4*)(merged + (size_t)row * 1024 + col);
    uint4 t0 = tp[0], t1 = tp[1];
    uint32_t tw[8] = {t0.x, t0.y, t0.z, t0.w, t1.x, t1.y, t1.z, t1.w};
    f32x4 s[4];
#pragma unroll
    for (int n = 0; n < 4; ++n) {
      s[n][0] = bflo(tw[n * 2]) + v[n][0] * bflo(gw[n * 2]);
      s[n][1] = bfhi(tw[n * 2]) + v[n][1] * bfhi(gw[n * 2]);
      s[n][2] = bflo(tw[n * 2 + 1]) + v[n][2] * bflo(gw[n * 2 + 1]);
      s[n][3] = bfhi(tw[n * 2 + 1]) + v[n][3] * bfhi(gw[n * 2 + 1]);
    }
    store16_bf16(merged + (size_t)row * 1024 + col, s);
  }
};
struct Epi6 {
  const Params& p;
  DEVINL void operator()(int row, int col, const f32x4 (&v)[4]) const {
    const float* gt = p.mod + (row >> 11) * 6144 + 2048 + col;
    const float* xr = p.x + (size_t)row * 1024 + col;
    float* o = p.out + (size_t)row * 1024 + col;
#pragma unroll
    for (int n = 0; n < 4; ++n) {
      float4 xv = *(const float4*)(xr + n * 4);
      float4 gv = *(const float4*)(gt + n * 4);
      float4 r;
      r.x = xv.x + gv.x * v[n][0]; r.y = xv.y + gv.y * v[n][1];
      r.z = xv.z + gv.z * v[n][2]; r.w = xv.w + gv.w * v[n][3];
      *(float4*)(o + n * 4) = r;
    }
  }
};
struct Epi8 {
  u16* q;
  DEVINL void operator()(int row, int col, const f32x4 (&v)[4]) const { store16_bf16(q + (size_t)row * 2048 + col, v); }
};

template <class F>
DEVINL void for_tiles(int nM, int nN, const F& f) {
  const int G = gridDim.x;
  const int xcd = blockIdx.x & 7, slot = blockIdx.x >> 3, nslot = G >> 3;
  const int nSm = nM >> 3;
  const int nS = nSm * (nN >> 2);
  const int Ltot = (nS >> 3) * 32;
  for (int L = slot; L < Ltot; L += nslot) {
    int s = (L >> 5) * 8 + xcd;
    int w = L & 31;
    int sm = s % nSm, sn = s / nSm;
    int mt = sm * 8 + (w & 7), nt = sn * 4 + (w >> 3);
    f(mt, nt);
  }
}


DEVINL void prep_phase(const Params& p, u16* X) {
  const size_t gtid = (size_t)blockIdx.x * 256 + threadIdx.x, gstride = (size_t)gridDim.x * 256;
  for (size_t it = gtid; it < (size_t)T * 32; it += gstride) {
    const size_t tok = it >> 5;
    const int c8 = (int)(it & 31) * 8;
    const u16* zl = p.z_lora + tok * 256 + c8;
    uint4 cur = *(const uint4*)zl;
    uint4 prv = make_uint4(0, 0, 0, 0);
    if ((tok & 2047) != 0) prv = *(const uint4*)(zl - 256);
    const float4 m0 = *(const float4*)(p.mu + 3072 + c8), m1 = *(const float4*)(p.mu + 3072 + c8 + 4);
    const float mu8[8] = {m0.x, m0.y, m0.z, m0.w, m1.x, m1.y, m1.z, m1.w};
    const uint32_t cw[4] = {cur.x, cur.y, cur.z, cur.w}, pw[4] = {prv.x, prv.y, prv.z, prv.w};
    uint32_t o[4];
#pragma unroll
    for (int i = 0; i < 4; ++i) {
      float c0 = bflo(cw[i]), q0 = bflo(pw[i]), c1 = bfhi(cw[i]), q1 = bfhi(pw[i]);
      float a0 = c0 + (q0 - c0) * mu8[2 * i], a1 = c1 + (q1 - c1) * mu8[2 * i + 1];
      if (c8 < 64) {
        a0 = 1.f - 2.f / (__expf(2.f * a0) + 1.f);
        a1 = 1.f - 2.f / (__expf(2.f * a1) + 1.f);
      } else if (c8 >= 128) {
        a0 = sigm(a0); a1 = sigm(a1);
      }
      o[i] = pack2(a0, a1);
    }
    *(uint4*)(X + tok * 256 + c8) = make_uint4(o[0], o[1], o[2], o[3]);
  }
  float inv_f[8];
#pragma unroll
  for (int i = 0; i < 8; ++i) inv_f[i] = expf(-(float)i * (13.122363377404328f / 8.f));
  for (size_t it = gtid; it < (size_t)T * 96; it += gstride) {
    const size_t tok = it / 96;
    const int rem = (int)(it - tok * 96);
    const int hd = rem >> 2, qd = rem & 3;
    const int isk = hd >= 12;
    const int grp = (isk ? hd - 12 : hd) >> 2;
    u16* ptr = p.z_attn + tok * 2304 + hd * 64 + qd * 16;
    uint4 a = *(const uint4*)ptr, c = *(const uint4*)(ptr + 8);
    const uint32_t wv[8] = {a.x, a.y, a.z, a.w, c.x, c.y, c.z, c.w};
    float xv[16];
#pragma unroll
    for (int i = 0; i < 8; ++i) { xv[2 * i] = bflo(wv[i]); xv[2 * i + 1] = bfhi(wv[i]); }
    float ss = 0.f;
#pragma unroll
    for (int i = 0; i < 16; ++i) ss += xv[i] * xv[i];
    ss = quad_sum(ss);
    float rstd = rsqrtf(ss * (1.f / 64.f) + 1e-6f);
    if (!isk) rstd *= 0.125f;
    const float* gp = (isk ? p.kng : p.qng) + grp * 64 + qd * 16;
#pragma unroll
    for (int i = 0; i < 16; ++i) xv[i] = xv[i] * rstd * gp[i];
    if (qd == 0) {
      const float fp = (float)(tok & 2047);
#pragma unroll
      for (int i = 0; i < 8; ++i) {
        float ang = fp * inv_f[i];
        float n = rintf(ang * 0.15915494309189535f);
        float rr = fmaf(-n, 6.2831854820251465f, ang);
        rr = fmaf(-n, -1.7484555e-7f, rr);
        float cs = __cosf(rr), sn = __sinf(rr);
        float x1 = xv[i], x2 = xv[i + 8];
        xv[i] = x1 * cs - x2 * sn;
        xv[i + 8] = x2 * cs + x1 * sn;
      }
    }
    uint32_t o[8];
#pragma unroll
    for (int i = 0; i < 8; ++i) o[i] = pack2(xv[2 * i], xv[2 * i + 1]);
    *(uint4*)ptr = make_uint4(o[0], o[1], o[2], o[3]);
    *(uint4*)(ptr + 8) = make_uint4(o[4], o[5], o[6], o[7]);
  }
}

constexpr int TC = 16;
struct ScanLds {
  float w[TC][64], k[TC][64], a[TC][64], b[TC][64], r[TC][64], v[TC][64], y[TC][64];
  float bonus[TC];
  u16 g[TC][64];
  float cst[8][64];
  float mul[256];
  u16 xw[TC][72], xa[TC][72], xg[TC][136];
  u16 w2s[64][72], a2s[64][72], g2s[64][136];
};
static_assert(sizeof(ScanLds) <= 79872, "scan lds");

DEVINL void rwkv_scan_unit(const Params& p, const u16* X, int unit, char* smem) {
  ScanLds& L = *(ScanLds*)smem;
  const int tid = threadIdx.x, lane = tid & 63, wid = tid >> 6;
  const int b = unit >> 4, h = unit & 15;
  const int fr = lane & 15, fq = lane >> 4;
  const int pt = tid >> 4, pc = (tid & 15) * 4;
  const int rp = tid >> 3, cq = tid & 7;

  __syncthreads();
  {
    const float* srcs[8] = {p.mu + h * 64, p.mu + 1024 + h * 64, p.mu + 2048 + h * 64, p.k_k + h * 64,
                            p.k_a + h * 64, p.r_k + h * 64, p.lnx_g + h * 64, p.lnx_b + h * 64};
#pragma unroll
    for (int i = 0; i < 8; ++i)
      if (tid < 64) L.cst[i][tid] = srcs[i][tid];
    L.mul[tid] = p.mu[3072 + tid];
    const int c = tid >> 2, qq = tid & 3;
    const u16* w2p = p.w2t + (size_t)(h * 64 + c) * 64 + qq * 16;
    const u16* a2p = p.a2t + (size_t)(h * 64 + c) * 64 + qq * 16;
    const u16* g2p = p.g2t + (size_t)(h * 64 + c) * 128 + qq * 32;
    *(u32x4*)&L.w2s[c][qq * 16] = *(const u32x4*)w2p;
    *(u32x4*)&L.w2s[c][qq * 16 + 8] = *(const u32x4*)(w2p + 8);
    *(u32x4*)&L.a2s[c][qq * 16] = *(const u32x4*)a2p;
    *(u32x4*)&L.a2s[c][qq * 16 + 8] = *(const u32x4*)(a2p + 8);
#pragma unroll
    for (int i = 0; i < 4; ++i) *(u32x4*)&L.g2s[c][qq * 32 + i * 8] = *(const u32x4*)(g2p + i * 8);
  }
  const int chn = h * 64 + wid * 16 + fr;
  const float w0c = p.w0[chn], a0c = p.a0[chn];
  const int ec = h * 64 + pc;
  const int lc = (tid & 15) * 16;

  f32x2 S2[2][4];
#pragma unroll
  for (int r_ = 0; r_ < 2; ++r_)
#pragma unroll
    for (int j = 0; j < 4; ++j) S2[r_][j] = (f32x2){0.f, 0.f};

  const size_t tok0 = (size_t)b * 2048;
  uint2 pr0, pr1, pk0, pk1, pv0, pv1;
  uint4 pl0, pl1;
#define PREFETCH(t0_)                                                                                    \
  {                                                                                                      \
    const int t_ = (t0_) + pt;                                                                           \
    const u16* zr_ = p.z_rkv + (tok0 + t_) * 3072 + ec;                                                  \
    pr0 = *(const uint2*)(zr_); pk0 = *(const uint2*)(zr_ + 1024); pv0 = *(const uint2*)(zr_ + 2048);    \
    const u16* xl_ = X + (tok0 + t_) * 256 + lc;                                                         \
    pl0 = *(const uint4*)(xl_); pl1 = *(const uint4*)(xl_ + 8);                                          \
    if (t_ > 0) {                                                                                        \
      pr1 = *(const uint2*)(zr_ - 3072); pk1 = *(const uint2*)(zr_ - 3072 + 1024);                       \
      pv1 = *(const uint2*)(zr_ - 3072 + 2048);                                                          \
    } else {                                                                                             \
      pr1 = make_uint2(0, 0); pk1 = make_uint2(0, 0); pv1 = make_uint2(0, 0);                            \
    }                                                                                                    \
  }
  __syncthreads();
  PREFETCH(0)

  for (int t0 = 0; t0 < 2048; t0 += TC) {
    float r4[4], k4[4], v4[4];
    {
      const float4 mu_r = *(const float4*)&L.cst[0][pc], mu_k = *(const float4*)&L.cst[1][pc], mu_v = *(const float4*)&L.cst[2][pc];
      float c, q;
      c = bflo(pr0.x); q = bflo(pr1.x); r4[0] = c + (q - c) * mu_r.x;
      c = bfhi(pr0.x); q = bfhi(pr1.x); r4[1] = c + (q - c) * mu_r.y;
      c = bflo(pr0.y); q = bflo(pr1.y); r4[2] = c + (q - c) * mu_r.z;
      c = bfhi(pr0.y); q = bfhi(pr1.y); r4[3] = c + (q - c) * mu_r.w;
      c = bflo(pk0.x); q = bflo(pk1.x); k4[0] = c + (q - c) * mu_k.x;
      c = bfhi(pk0.x); q = bfhi(pk1.x); k4[1] = c + (q - c) * mu_k.y;
      c = bflo(pk0.y); q = bflo(pk1.y); k4[2] = c + (q - c) * mu_k.z;
      c = bfhi(pk0.y); q = bfhi(pk1.y); k4[3] = c + (q - c) * mu_k.w;
      c = bflo(pv0.x); q = bflo(pv1.x); v4[0] = c + (q - c) * mu_v.x;
      c = bfhi(pv0.x); q = bfhi(pv1.x); v4[1] = c + (q - c) * mu_v.y;
      c = bflo(pv0.y); q = bflo(pv1.y); v4[2] = c + (q - c) * mu_v.z;
      c = bfhi(pv0.y); q = bfhi(pv1.y); v4[3] = c + (q - c) * mu_v.w;
    }
    *(float4*)&L.r[pt][pc] = make_float4(r4[0], r4[1], r4[2], r4[3]);
    *(float4*)&L.v[pt][pc] = make_float4(v4[0], v4[1], v4[2], v4[3]);
    {
      u16* dstp = (lc < 64) ? &L.xw[pt][lc] : (lc < 128) ? &L.xa[pt][lc - 64] : &L.xg[pt][lc - 128];
      *(uint4*)dstp = pl0;
      *(uint4*)(dstp + 8) = pl1;
    }
    __syncthreads();
    {
      f32x4 cw = {0.f, 0.f, 0.f, 0.f}, ca = {0.f, 0.f, 0.f, 0.f}, cg_ = {0.f, 0.f, 0.f, 0.f};
#pragma unroll
      for (int ks = 0; ks < 2; ++ks) {
        bf16x8 xa_ = *(const bf16x8*)&L.xw[fr][ks * 32 + fq * 8];
        cw = __builtin_amdgcn_mfma_f32_16x16x32_bf16(xa_, *(const bf16x8*)&L.w2s[wid * 16 + fr][ks * 32 + fq * 8], cw, 0, 0, 0);
        bf16x8 xb_ = *(const bf16x8*)&L.xa[fr][ks * 32 + fq * 8];
        ca = __builtin_amdgcn_mfma_f32_16x16x32_bf16(xb_, *(const bf16x8*)&L.a2s[wid * 16 + fr][ks * 32 + fq * 8], ca, 0, 0, 0);
      }
#pragma unroll
      for (int ks = 0; ks < 4; ++ks) {
        bf16x8 xc_ = *(const bf16x8*)&L.xg[fr][ks * 32 + fq * 8];
        cg_ = __builtin_amdgcn_mfma_f32_16x16x32_bf16(xc_, *(const bf16x8*)&L.g2s[wid * 16 + fr][ks * 32 + fq * 8], cg_, 0, 0, 0);
      }
      const int ch = wid * 16 + fr;
      float cum[4];
      cum[0] = __expf(-0.6065306597126334f * sigm(w0c + cw[0]));
#pragma unroll
      for (int j = 1; j < 4; ++j) cum[j] = cum[j - 1] * __expf(-0.6065306597126334f * sigm(w0c + cw[j]));
      {
        const float t0_ = __shfl(cum[3], fr), t1_ = __shfl(cum[3], fr + 16), t2_ = __shfl(cum[3], fr + 32);
        const float pre_ = (fq == 0) ? 1.f : (fq == 1) ? t0_ : (fq == 2) ? t0_ * t1_ : t0_ * t1_ * t2_;
#pragma unroll
        for (int j = 0; j < 4; ++j) cum[j] *= pre_;
      }
#pragma unroll
      for (int j = 0; j < 4; ++j) {
        int tk = fq * 4 + j;
        L.w[tk][ch] = cum[j];
        L.y[tk][ch] = sigm(a0c + ca[j]);
        L.g[tk][ch] = f2bf(cg_[j]);
      }
    }
    __syncthreads();
    {
      float4 al4 = *(const float4*)&L.y[pt][pc];
      const float4 kk_c = *(const float4*)&L.cst[3][pc], ka_c = *(const float4*)&L.cst[4][pc], rk_c = *(const float4*)&L.cst[5][pc];
      float kk0 = k4[0] * kk_c.x, kk1 = k4[1] * kk_c.y, kk2 = k4[2] * kk_c.z, kk3 = k4[3] * kk_c.w;
      float ss = row16_sum(kk0 * kk0 + kk1 * kk1 + kk2 * kk2 + kk3 * kk3);
      float inv = 1.f / fmaxf(sqrtf(ss), 1e-12f);
      kk0 *= inv; kk1 *= inv; kk2 *= inv; kk3 *= inv;
      const float4 wi = *(const float4*)&L.w[pt][pc];
      float4 we = make_float4(1.f, 1.f, 1.f, 1.f);
      if (pt > 0) we = *(const float4*)&L.w[pt - 1][pc];
      const float ri0 = 1.f / wi.x, ri1 = 1.f / wi.y, ri2 = 1.f / wi.z, ri3 = 1.f / wi.w;
      *(float4*)&L.a[pt][pc] = make_float4(-kk0 * we.x, -kk1 * we.y, -kk2 * we.z, -kk3 * we.w);
      *(float4*)&L.b[pt][pc] = make_float4(kk0 * al4.x * ri0, kk1 * al4.y * ri1, kk2 * al4.z * ri2, kk3 * al4.w * ri3);
      *(float4*)&L.r[pt][pc] = make_float4(r4[0] * wi.x, r4[1] * wi.y, r4[2] * wi.z, r4[3] * wi.w);
      float km0 = k4[0] * (1.f + (al4.x - 1.f) * ka_c.x);
      float km1 = k4[1] * (1.f + (al4.y - 1.f) * ka_c.y);
      float km2 = k4[2] * (1.f + (al4.z - 1.f) * ka_c.z);
      float km3 = k4[3] * (1.f + (al4.w - 1.f) * ka_c.w);
      *(float4*)&L.k[pt][pc] = make_float4(km0 * ri0, km1 * ri1, km2 * ri2, km3 * ri3);
      float bs = row16_sum(r4[0] * km0 * rk_c.x + r4[1] * km1 * rk_c.y + r4[2] * km2 * rk_c.z + r4[3] * km3 * rk_c.w);
      if ((tid & 15) == 0) L.bonus[pt] = bs;
    }
    if (t0 + TC < 2048) PREFETCH(t0 + TC)
    __syncthreads();
    {
#define LDVEC(dst, arr, t)                                         \
  {                                                                \
    const f32x4* p4_ = (const f32x4*)&L.arr[t][cq * 8];            \
    f32x4 v0_ = p4_[0], v1_ = p4_[1];                              \
    dst[0] = (f32x2){v0_[0], v0_[1]}; dst[1] = (f32x2){v0_[2], v0_[3]}; \
    dst[2] = (f32x2){v1_[0], v1_[1]}; dst[3] = (f32x2){v1_[2], v1_[3]}; \
  }
      f32x2 cA[4];
      LDVEC(cA, a, 0)
      f32x2 cv = *(const f32x2*)&L.v[0][rp * 2];
#pragma unroll 2
      for (int t = 0; t < TC; ++t) {
        f32x2 nA[4], cB[4], cK[4], cR[4];
        const int tn = (t + 1 < TC) ? t + 1 : t;
        LDVEC(cB, b, t) LDVEC(cK, k, t)
        LDVEC(nA, a, tn)
        const f32x2 nv = *(const f32x2*)&L.v[tn][rp * 2];
        LDVEC(cR, r, t)
        f32x2 p0 = S2[0][0] * cA[0], p1 = S2[0][1] * cA[1], q0 = S2[1][0] * cA[0], q1 = S2[1][1] * cA[1];
        p0 = S2[0][2] * cA[2] + p0; p1 = S2[0][3] * cA[3] + p1; q0 = S2[1][2] * cA[2] + q0; q1 = S2[1][3] * cA[3] + q1;
        p0 = p0 + p1; q0 = q0 + q1;
        const float sa0 = oct_sum(p0[0] + p0[1]);
        const float sa1 = oct_sum(q0[0] + q0[1]);
        const f32x2 sav0 = {sa0, sa0}, sav1 = {sa1, sa1}, vv0 = {cv[0], cv[0]}, vv1 = {cv[1], cv[1]};
#pragma unroll
        for (int j = 0; j < 4; ++j) {
          S2[0][j] = sav0 * cB[j] + (vv0 * cK[j] + S2[0][j]);
          S2[1][j] = sav1 * cB[j] + (vv1 * cK[j] + S2[1][j]);
        }
        f32x2 y0 = S2[0][0] * cR[0], y1 = S2[0][1] * cR[1], z0 = S2[1][0] * cR[0], z1 = S2[1][1] * cR[1];
        y0 = S2[0][2] * cR[2] + y0; y1 = S2[0][3] * cR[3] + y1; z0 = S2[1][2] * cR[2] + z0; z1 = S2[1][3] * cR[3] + z1;
        y0 = y0 + y1; z0 = z0 + z1;
        const float ya = oct_sum(y0[0] + y0[1]);
        const float yb = oct_sum(z0[0] + z0[1]);
        if (cq == 0) *(f32x2*)&L.y[t][rp * 2] = (f32x2){ya, yb};
#pragma unroll
        for (int j = 0; j < 4; ++j) cA[j] = nA[j];
        cv = nv;
      }
      {
        f32x2 wl[4];
        LDVEC(wl, w, TC - 1)
#pragma unroll
        for (int j = 0; j < 4; ++j) { S2[0][j] = S2[0][j] * wl[j]; S2[1][j] = S2[1][j] * wl[j]; }
      }
#undef LDVEC
    }
    __syncthreads();
    {
      const float4 lg_c = *(const float4*)&L.cst[6][pc], lb_c = *(const float4*)&L.cst[7][pc];
      float4 y4 = *(const float4*)&L.y[pt][pc];
      float4 g4;
      {
        uint2 gq = *(const uint2*)&L.g[pt][pc];
        g4 = make_float4(bflo(gq.x), bfhi(gq.x), bflo(gq.y), bfhi(gq.y));
      }
      float4 vv = *(const float4*)&L.v[pt][pc];
      float bs = L.bonus[pt];
      float mean = row16_sum(y4.x + y4.y + y4.z + y4.w) * (1.f / 64.f);
      float d0 = y4.x - mean, d1 = y4.y - mean, d2 = y4.z - mean, d3 = y4.w - mean;
      float var = row16_sum(d0 * d0 + d1 * d1 + d2 * d2 + d3 * d3) * (1.f / 64.f);
      float rs = rsqrtf(var + 64e-5f);
      float o0 = (d0 * rs * lg_c.x + lb_c.x + bs * vv.x) * g4.x;
      float o1 = (d1 * rs * lg_c.y + lb_c.y + bs * vv.y) * g4.y;
      float o2 = (d2 * rs * lg_c.z + lb_c.z + bs * vv.z) * g4.z;
      float o3 = (d3 * rs * lg_c.w + lb_c.w + bs * vv.w) * g4.w;
      uint2 o; o.x = pack2(o0, o1); o.y = pack2(o2, o3);
      *(uint2*)(p.bufB + (tok0 + t0 + pt) * 1024 + ec) = o;
    }
    __syncthreads();
  }
}

struct AttnLds {
  u16 q[64][72];
  u16 k[192][72];
  u16 vt[64][200];
};

DEVINL void attn_unit(const Params& p, int u, char* smem) {
  AttnLds& L = *(AttnLds*)smem;
  const int tid = threadIdx.x, lane = tid & 63, wid = tid >> 6;
  const int fr = lane & 15, fq = lane >> 4;
  const int g = u >> 11;
  int rem = u & 2047;
  const int b = rem >> 7; rem &= 127;
  const int hh = rem >> 5;
  const int w = rem & 31;
  const int dsh = g * 2;
  const int d = 1 << dsh;
  const int nqb = 32 >> dsh;
  const int r = w / nqb, qb = w % nqb;
  const int l0 = qb * 64;
  const int kl0 = l0 - 128;
  const int gh = g * 4 + hh;
  const size_t tokb = (size_t)b * 2048;
  const int rowi = tid >> 2, qd = tid & 3;

  __syncthreads();
#pragma unroll 1
  for (int pass = 0; pass < 7; ++pass) {
    int kind = (pass == 0) ? 0 : (pass < 4 ? 1 : 2);
    int lrow = (pass == 0) ? rowi : (pass < 4 ? (pass - 1) * 64 + rowi : (pass - 4) * 64 + rowi);
    int sub = (kind == 0) ? (l0 + lrow) : (kl0 + lrow);
    bool valid = sub >= 0;
    int pos = sub * d + r;
    float xv[16];
    if (valid) {
      const u16* src = p.z_attn + (tokb + pos) * 2304 + kind * 768 + gh * 64 + qd * 16;
      uint4 a = *(const uint4*)src, c = *(const uint4*)(src + 8);
      uint32_t wv[8] = {a.x, a.y, a.z, a.w, c.x, c.y, c.z, c.w};
#pragma unroll
      for (int i = 0; i < 8; ++i) { xv[2 * i] = bflo(wv[i]); xv[2 * i + 1] = bfhi(wv[i]); }
    } else {
#pragma unroll
      for (int i = 0; i < 16; ++i) xv[i] = 0.f;
    }
    if (kind < 2) {
      uint32_t o[8];
#pragma unroll
      for (int i = 0; i < 8; ++i) o[i] = pack2(xv[2 * i], xv[2 * i + 1]);
      u16* dst = (kind == 0) ? &L.q[lrow][qd * 16] : &L.k[lrow][qd * 16];
      *(uint4*)dst = make_uint4(o[0], o[1], o[2], o[3]);
      *(uint4*)(dst + 8) = make_uint4(o[4], o[5], o[6], o[7]);
    } else {
#pragma unroll
      for (int i = 0; i < 16; ++i) L.vt[qd * 16 + i][lrow] = f2bf(xv[i]);
    }
  }
  __syncthreads();
  bf16x8 qf[2];
#pragma unroll
  for (int ks = 0; ks < 2; ++ks) qf[ks] = *(const bf16x8*)&L.q[wid * 16 + fr][ks * 32 + fq * 8];
  f32x4 sc[9];
#pragma unroll
  for (int i = 0; i < 9; ++i) {
    int kt = wid + i;
    f32x4 a = {0.f, 0.f, 0.f, 0.f};
#pragma unroll
    for (int ks = 0; ks < 2; ++ks) {
      bf16x8 kf = *(const bf16x8*)&L.k[kt * 16 + fr][ks * 32 + fq * 8];
      a = __builtin_amdgcn_mfma_f32_16x16x32_bf16(kf, qf[ks], a, 0, 0, 0);
    }
    sc[i] = a;
  }
  const int ql = wid * 16 + fr;
  float mx = -1e30f;
#pragma unroll
  for (int i = 0; i < 9; ++i)
#pragma unroll
    for (int j = 0; j < 4; ++j) {
      int kl = (wid + i) * 16 + fq * 4 + j;
      bool ok = (kl >= ql) && (kl <= ql + 128) && (kl0 + kl >= 0);
      float s = ok ? sc[i][j] : -1e30f;
      sc[i][j] = s;
      mx = fmaxf(mx, s);
    }
  mx = fmaxf(mx, __shfl_xor(mx, 16));
  mx = fmaxf(mx, __shfl_xor(mx, 32));
  float lsum = 0.f;
  bf16x4 pf[9];
#pragma unroll
  for (int i = 0; i < 9; ++i) {
    float e0 = __expf(sc[i][0] - mx), e1 = __expf(sc[i][1] - mx), e2 = __expf(sc[i][2] - mx), e3 = __expf(sc[i][3] - mx);
    lsum += (e0 + e1) + (e2 + e3);
    pf[i][0] = (short)f2bf(e0); pf[i][1] = (short)f2bf(e1); pf[i][2] = (short)f2bf(e2); pf[i][3] = (short)f2bf(e3);
  }
  lsum += __shfl_xor(lsum, 16);
  lsum += __shfl_xor(lsum, 32);
  f32x4 oacc[4];
#pragma unroll
  for (int db = 0; db < 4; ++db) oacc[db] = (f32x4){0.f, 0.f, 0.f, 0.f};
#pragma unroll
  for (int i = 0; i < 9; ++i) {
    int kt = wid + i;
#pragma unroll
    for (int db = 0; db < 4; ++db) {
      bf16x4 vf = *(const bf16x4*)&L.vt[db * 16 + fr][kt * 16 + fq * 4];
      oacc[db] = __builtin_amdgcn_mfma_f32_16x16x16bf16_1k(vf, pf[i], oacc[db], 0, 0, 0);
    }
  }
  const float invl = 1.f / lsum;
  const int posq = (l0 + ql) * d + r;
  u16* od = p.z_attn + (tokb + posq) * 2304 + gh * 64;
#pragma unroll
  for (int db = 0; db < 4; ++db) {
    uint2 o;
    o.x = pack2(oacc[db][0] * invl, oacc[db][1] * invl);
    o.y = pack2(oacc[db][2] * invl, oacc[db][3] * invl);
    *(uint2*)(od + db * 16 + fq * 4) = o;
  }
  if (fq == 0) p.lse[((size_t)g * T + tokb + posq) * 4 + hh] = mx + __logf(lsum);
}

DEVINL void attn_merge(const Params& p) {
  u16* ya = p.z_lora;
  const size_t n = (size_t)T * 32;
  for (size_t it = (size_t)blockIdx.x * 256 + threadIdx.x; it < n; it += (size_t)gridDim.x * 256) {
    size_t tok = it >> 5;
    int c8 = (int)(it & 31) * 8;
    int hh = c8 >> 6;
    float l0 = p.lse[((size_t)0 * T + tok) * 4 + hh];
    float l1 = p.lse[((size_t)1 * T + tok) * 4 + hh];
    float l2 = p.lse[((size_t)2 * T + tok) * 4 + hh];
    float m = fmaxf(l0, fmaxf(l1, l2));
    float e0 = __expf(l0 - m), e1 = __expf(l1 - m), e2 = __expf(l2 - m);
    float inv = 1.f / (e0 + e1 + e2);
    e0 *= inv; e1 *= inv; e2 *= inv;
    const u16* zr = p.z_attn + tok * 2304 + c8;
    uint4 a = *(const uint4*)(zr), bq = *(const uint4*)(zr + 256), cq = *(const uint4*)(zr + 512);
    uint32_t aw[4] = {a.x, a.y, a.z, a.w}, bw[4] = {bq.x, bq.y, bq.z, bq.w}, cw[4] = {cq.x, cq.y, cq.z, cq.w};
    uint32_t o[4];
#pragma unroll
    for (int i = 0; i < 4; ++i) {
      float lo = e0 * bflo(aw[i]) + e1 * bflo(bw[i]) + e2 * bflo(cw[i]);
      float hi = e0 * bfhi(aw[i]) + e1 * bfhi(bw[i]) + e2 * bfhi(cw[i]);
      o[i] = pack2(lo, hi);
    }
    *(uint4*)(ya + tok * 256 + c8) = make_uint4(o[0], o[1], o[2], o[3]);
  }
}

DEVINL uint32_t sortable(float s) {
  uint32_t u = __float_as_uint(s);
  return (u & 0x80000000u) ? ~u : (u | 0x80000000u);
}

DEVINL void ce_desc(uint32_t& a, uint32_t& b) {
  const uint32_t hi = max(a, b), lo = min(a, b);
  a = hi; b = lo;
}
DEVINL void bitonic_sort_desc16(uint32_t (&a)[16]) {
#pragma unroll
  for (int lk = 1; lk <= 4; ++lk) {
#pragma unroll
    for (int lj = 3; lj >= 0; --lj) {
      if (lj < lk) {
        const int k = 1 << lk, j = 1 << lj;
#pragma unroll
        for (int i = 0; i < 16; ++i) {
          const int l = i ^ j;
          if (l > i) {
            if ((i & k) == 0) ce_desc(a[i], a[l]); else ce_desc(a[l], a[i]);
          }
        }
      }
    }
  }
}
DEVINL void bitonic_merge_desc16(uint32_t (&a)[16]) {
#pragma unroll
  for (int lj = 3; lj >= 0; --lj) {
    const int j = 1 << lj;
#pragma unroll
    for (int i = 0; i < 16; ++i) {
      const int l = i ^ j;
      if (l > i) ce_desc(a[i], a[l]);
    }
  }
}
template <int CTRL>
DEVINL uint32_t dpp_u(uint32_t x) { return (uint32_t)__builtin_amdgcn_update_dpp(0, (int)x, CTRL, 0xF, 0xF, true); }

constexpr int RS = 133;
DEVINL void peer_route_a(const Params& p, const u16* qp, float* lv, int* li, char* smem) {
  const int tid = threadIdx.x, lane = tid & 63, wid = tid >> 6;
  const int fr = lane & 15, fq = lane >> 4;
  const int role = blockIdx.x & 1;
  const int nblk = gridDim.x >> 1, bidx = blockIdx.x >> 1;
  u16(*sK)[136] = (u16(*)[136])smem;
  float* sS = (float*)(smem + 128 * 136 * 2);
  __syncthreads();
  {
    const u16* kb = role ? p.k2b : p.k1b;
    for (int c = tid; c < 128 * 16; c += 256) {
      const int r = c >> 4, ch = c & 15;
      *(u32x4*)&sK[r][ch * 8] = *(const u32x4*)(kb + r * 128 + ch * 8);
    }
  }
  __syncthreads();
  float* lvr = lv + (size_t)role * T * 128;
  int* lir = li + (size_t)role * T * 128;
  for (int unit = bidx; unit < 4096; unit += nblk) {
    const int tok0 = (unit >> 1) * 16, hsel = unit & 1;
    const int head = hsel * 4 + wid;
    bf16x8 af[4];
#pragma unroll
    for (int ks = 0; ks < 4; ++ks)
      af[ks] = *(const bf16x8*)(qp + (size_t)(tok0 + fr) * 2048 + head * 256 + role * 128 + ks * 32 + fq * 8);
    __syncthreads();
#pragma unroll
    for (int nt = 0; nt < 8; ++nt) {
      f32x4 a = {0.f, 0.f, 0.f, 0.f};
#pragma unroll
      for (int ks = 0; ks < 4; ++ks) {
        bf16x8 bfg = *(const bf16x8*)&sK[nt * 16 + fr][ks * 32 + fq * 8];
        a = __builtin_amdgcn_mfma_f32_16x16x32_bf16(af[ks], bfg, a, 0, 0, 0);
      }
      const int key = nt * 16 + fr;
#pragma unroll
      for (int j = 0; j < 4; ++j) sS[(wid * 16 + fq * 4 + j) * RS + (key >> 5) * 33 + (key & 31)] = a[j];
    }
    __syncthreads();
    const int inst = tid >> 2, part = tid & 3;
    const float* row = sS + inst * RS;
    uint32_t top[16], grp[16];
#pragma unroll
    for (int i = 0; i < 16; ++i) {
      top[i] = (sortable(row[part * 33 + i]) & 0xFFFFFF80u) | (uint32_t)(127 - (part * 32 + i));
      grp[i] = (sortable(row[part * 33 + 16 + i]) & 0xFFFFFF80u) | (uint32_t)(127 - (part * 32 + 16 + i));
    }
    bitonic_sort_desc16(top);
    bitonic_sort_desc16(grp);
#pragma unroll
    for (int i = 0; i < 16; ++i) top[i] = max(top[i], grp[15 - i]);
    bitonic_merge_desc16(top);
#pragma unroll
    for (int i = 0; i < 16; ++i) grp[i] = dpp_u<0xB1>(top[i]);
#pragma unroll
    for (int i = 0; i < 16; ++i) top[i] = max(top[i], grp[15 - i]);
    bitonic_merge_desc16(top);
#pragma unroll
    for (int i = 0; i < 16; ++i) grp[i] = dpp_u<0x4E>(top[i]);
#pragma unroll
    for (int i = 0; i < 16; ++i) top[i] = max(top[i], grp[15 - i]);
    bitonic_merge_desc16(top);
    if (part == 0) {
      const int tk = inst & 15, hl = inst >> 4;
      const size_t ob = ((size_t)(tok0 + tk) * 8 + hsel * 4 + hl) * 16;
#pragma unroll
      for (int q4 = 0; q4 < 4; ++q4) {
        const int k0 = 127 - (int)(top[q4 * 4] & 127u), k1 = 127 - (int)(top[q4 * 4 + 1] & 127u);
        const int k2 = 127 - (int)(top[q4 * 4 + 2] & 127u), k3 = 127 - (int)(top[q4 * 4 + 3] & 127u);
        *(float4*)(lvr + ob + q4 * 4) = make_float4(row[(k0 >> 5) * 33 + (k0 & 31)], row[(k1 >> 5) * 33 + (k1 & 31)],
                                                    row[(k2 >> 5) * 33 + (k2 & 31)], row[(k3 >> 5) * 33 + (k3 & 31)]);
        *(int4*)(lir + ob + q4 * 4) = make_int4(k0, k1, k2, k3);
      }
    }
  }
}

DEVINL void peer_route_b(const float* lv, const int* li, int* idx_out, float* gate_out) {
  const float* lv1 = lv; const float* lv2 = lv + (size_t)T * 128;
  const int* li1 = li; const int* li2 = li + (size_t)T * 128;
  for (size_t it = (size_t)blockIdx.x * 256 + threadIdx.x; it < (size_t)T * 8; it += (size_t)gridDim.x * 256) {
    const size_t ob = it * 16;
    float v1[16], v2[16];
#pragma unroll
    for (int q = 0; q < 4; ++q) {
      float4 a = *(const float4*)(lv1 + ob + q * 4), b = *(const float4*)(lv2 + ob + q * 4);
      v1[q * 4] = a.x; v1[q * 4 + 1] = a.y; v1[q * 4 + 2] = a.z; v1[q * 4 + 3] = a.w;
      v2[q * 4] = b.x; v2[q * 4 + 1] = b.y; v2[q * 4 + 2] = b.z; v2[q * 4 + 3] = b.w;
    }
    uint32_t top[16];
#pragma unroll
    for (int j = 0; j < 16; ++j) top[j] = 0u;
#pragma unroll
    for (int i = 0; i < 16; ++i)
#pragma unroll
      for (int j = 0; j < 16; ++j)
        if ((i + 1) * (j + 1) <= 16) {
          uint32_t key = (sortable(v1[i] + v2[j]) & 0xFFFFFF00u) | (uint32_t)(255 - (i * 16 + j));
#pragma unroll
          for (int s_ = 0; s_ < 16; ++s_) {
            uint32_t hi = max(top[s_], key);
            key = min(top[s_], key);
            top[s_] = hi;
          }
        }
    float val[16];
    int eid[16];
    float mx = -1e30f;
#pragma unroll
    for (int s_ = 0; s_ < 16; ++s_) {
      const int cidx = 255 - (int)(top[s_] & 255u);
      const int i = cidx >> 4, j = cidx & 15;
      val[s_] = lv1[ob + i] + lv2[ob + j];
      eid[s_] = li1[ob + i] * 128 + li2[ob + j];
      mx = fmaxf(mx, val[s_]);
    }
    float sum = 0.f;
#pragma unroll
    for (int s_ = 0; s_ < 16; ++s_) { val[s_] = __expf(val[s_] - mx); sum += val[s_]; }
    const float inv = 1.f / sum;
#pragma unroll
    for (int s4 = 0; s4 < 4; ++s4) {
      *(int4*)(idx_out + ob + s4 * 4) = make_int4(eid[s4 * 4], eid[s4 * 4 + 1], eid[s4 * 4 + 2], eid[s4 * 4 + 3]);
      *(float4*)(gate_out + ob + s4 * 4) = make_float4(val[s4 * 4] * inv, val[s4 * 4 + 1] * inv, val[s4 * 4 + 2] * inv, val[s4 * 4 + 3] * inv);
    }
  }
}

DEVINL void dec16(const uint2& w, f32x2 (&d)[8]) {
  d[0] = __builtin_amdgcn_cvt_scalef32_pk_f32_fp4(w.x, 1.0f, 0);
  d[1] = __builtin_amdgcn_cvt_scalef32_pk_f32_fp4(w.x, 1.0f, 1);
  d[2] = __builtin_amdgcn_cvt_scalef32_pk_f32_fp4(w.x, 1.0f, 2);
  d[3] = __builtin_amdgcn_cvt_scalef32_pk_f32_fp4(w.x, 1.0f, 3);
  d[4] = __builtin_amdgcn_cvt_scalef32_pk_f32_fp4(w.y, 1.0f, 0);
  d[5] = __builtin_amdgcn_cvt_scalef32_pk_f32_fp4(w.y, 1.0f, 1);
  d[6] = __builtin_amdgcn_cvt_scalef32_pk_f32_fp4(w.y, 1.0f, 2);
  d[7] = __builtin_amdgcn_cvt_scalef32_pk_f32_fp4(w.y, 1.0f, 3);
}

DEVINL void peer_gather(const Params& p, const u16* n2, const int* idx, const float* gate, u16* dry = nullptr) {
  const int lane = threadIdx.x & 63, wid = threadIdx.x >> 6;
  const int nw = gridDim.x * 4;
  const unsigned char* ub4 = (const unsigned char*)p.ub;
  const unsigned char* vb4 = (const unsigned char*)p.vb;
  for (int tok = blockIdx.x * 4 + wid; tok < T; tok += nw) {
    f32x2 xn[8], acc2[8];
    {
      const uint4* np = (const uint4*)(n2 + (size_t)tok * 1024 + lane * 16);
      uint4 a = np[0], c = np[1];
      uint32_t wv[8] = {a.x, a.y, a.z, a.w, c.x, c.y, c.z, c.w};
#pragma unroll
      for (int i = 0; i < 8; ++i) xn[i] = (f32x2){bflo(wv[i]), bfhi(wv[i])};
    }
#pragma unroll
    for (int i = 0; i < 8; ++i) acc2[i] = (f32x2){0.f, 0.f};
    const int id0 = idx[(size_t)tok * 128 + lane], id1 = idx[(size_t)tok * 128 + 64 + lane];
    const float g0 = gate[(size_t)tok * 128 + lane], g1 = gate[(size_t)tok * 128 + 64 + lane];
#pragma unroll 1
    for (int e = 0; e < 128; e += 16) {
      const int idv = (e < 64) ? id0 : id1;
      const float gv = (e < 64) ? g0 : g1;
      const int eb = e & 63;
      uint2 ur[16], vr[16];
      float us[16], vs[16];
#pragma unroll
      for (int q = 0; q < 16; ++q) {
        const int id = __builtin_amdgcn_readlane(idv, eb + q);
        ur[q] = *(const uint2*)(ub4 + (size_t)id * 512 + lane * 8);
        vr[q] = *(const uint2*)(vb4 + (size_t)id * 512 + lane * 8);
        us[q] = p.usc[id];
        vs[q] = p.vsc[id];
      }
      float mine = 0.f;
#pragma unroll
      for (int q = 0; q < 16; ++q) {
        f32x2 d[8];
        dec16(ur[q], d);
        f32x2 s0 = xn[0] * d[0], s1 = xn[1] * d[1];
        s0 = xn[2] * d[2] + s0; s1 = xn[3] * d[3] + s1;
        s0 = xn[4] * d[4] + s0; s1 = xn[5] * d[5] + s1;
        s0 = xn[6] * d[6] + s0; s1 = xn[7] * d[7] + s1;
        s0 = s0 + s1;
        float pr = row16_sum(s0[0] + s0[1]) * us[q];
        mine = ((lane & 15) == q) ? pr : mine;
      }
      mine += __shfl_xor(mine, 16);
      mine += __shfl_xor(mine, 32);
      const float gl = __shfl(gv, eb + (lane & 15));
      const float coefv = gl * 0.5f * mine * (1.f + erff(mine * 0.7071067811865476f));
#pragma unroll
      for (int q = 0; q < 16; ++q) {
        const float coef = __int_as_float(__builtin_amdgcn_readlane(__float_as_int(coefv), q)) * vs[q];
        const f32x2 c2 = {coef, coef};
        f32x2 d[8];
        dec16(vr[q], d);
#pragma unroll
        for (int i = 0; i < 8; ++i) acc2[i] = c2 * d[i] + acc2[i];
      }
    }
    float acc[16];
#pragma unroll
    for (int i = 0; i < 8; ++i) { acc[2 * i] = acc2[i][0]; acc[2 * i + 1] = acc2[i][1]; }
    const float* gt2 = p.mod + (tok >> 11) * 6144 + 5120 + lane * 16;
    float* op = p.out + (size_t)tok * 1024 + lane * 16;
#pragma unroll
    for (int i = 0; i < 4; ++i) {
      float4 hv = *(const float4*)(op + i * 4);
      float4 gv4 = *(const float4*)(gt2 + i * 4);
      hv.x += gv4.x * acc[i * 4]; hv.y += gv4.y * acc[i * 4 + 1];
      hv.z += gv4.z * acc[i * 4 + 2]; hv.w += gv4.w * acc[i * 4 + 3];
      if (dry) {
        uint2 o; o.x = pack2(hv.x, hv.y); o.y = pack2(hv.z, hv.w);
        *(uint2*)(dry + (size_t)tok * 1024 + lane * 16 + i * 4) = o;
      } else {
        *(float4*)(op + i * 4) = hv;
      }
    }
  }
}


#define XB_TMO      128
#define XB_XCNT(j)  (256  + 64 * (j))
#define XB_XSUB(j)  (1280 + 64 * (j))
#define XB_XGEN(j)  (2304 + 64 * (j))
#define XB_TOP      3328
#define XB_TOPGEN   3392
#define XCD_BAR_WORDS 3456
#define XB_SPIN_CAP (1u << 18)
#define LAS __attribute__((address_space(3)))
DEVINL unsigned xb_ld(unsigned* p) { return __hip_atomic_load(p, __ATOMIC_RELAXED, __HIP_MEMORY_SCOPE_AGENT); }
DEVINL unsigned xb_add(unsigned* p, unsigned v) { return __hip_atomic_fetch_add(p, v, __ATOMIC_RELAXED, __HIP_MEMORY_SCOPE_AGENT); }
DEVINL unsigned xb_xcc_id() { return (unsigned)__builtin_amdgcn_s_getreg((3 << 11) | 20) & 0xFu; }
#define XB_SPIN(cond, bar) do { unsigned _sp = 0; while (cond) { __builtin_amdgcn_s_sleep(1); \
    if ((++_sp & 255u) == 0u) { if (xb_ld(&(bar)[XB_TMO])) break; if (_sp > XB_SPIN_CAP) { atomicAdd(&(bar)[XB_TMO], 1u); break; } } } } while (0)
struct XcdBarrier { unsigned* bar; unsigned x; volatile LAS unsigned* st; };
DEVINL XcdBarrier xcd_barrier_post(unsigned* bar, volatile LAS unsigned* st) {
  XcdBarrier b; b.bar = bar; b.x = xb_xcc_id(); b.st = st;
  if (threadIdx.x == 0) (void)xb_add(&bar[XB_XCNT(b.x)], 1u);
  return b;
}
DEVINL void xcd_barrier_complete(unsigned* bar, unsigned x, unsigned& nloc, unsigned& nx) {
  const unsigned G = gridDim.x * gridDim.y * gridDim.z;
  unsigned sum, cnt, mine, sp = 0u;
  for (;;) {
    sum = 0u; cnt = 0u; mine = 0u;
#pragma unroll
    for (unsigned j = 0; j < 16; ++j) { const unsigned c = xb_ld(&bar[XB_XCNT(j)]); sum += c; cnt += (c > 0u) ? 1u : 0u; mine = (j == x) ? c : mine; }
    if (sum == G) break;
    __builtin_amdgcn_s_sleep(1);
    if ((++sp & 255u) == 0u) { if (xb_ld(&bar[XB_TMO])) break; if (sp > XB_SPIN_CAP) { atomicAdd(&bar[XB_TMO], 1u); break; } }
  }
  nloc = mine > 0u ? mine : 1u; nx = cnt > 0u ? cnt : 1u;
}
DEVINL void xcd_barrier(const XcdBarrier& b) {
  asm volatile("s_waitcnt vmcnt(0)" ::: "memory");
  __syncthreads();
  if (threadIdx.x == 0) {
    unsigned* bar = b.bar;
    __builtin_amdgcn_s_waitcnt(0);
    unsigned nloc = b.st[0], nx = b.st[1];
    if (nloc == 0u) { xcd_barrier_complete(bar, b.x, nloc, nx); b.st[0] = nloc; b.st[1] = nx; }
    const unsigned old = xb_add(&bar[XB_XSUB(b.x)], 1u);
    const unsigned gen = old / nloc;
    if (old + 1u == (gen + 1u) * nloc) {
      __builtin_amdgcn_fence(__ATOMIC_RELEASE, "agent");
      asm volatile("s_waitcnt vmcnt(0)" ::: "memory");
      const unsigned og = xb_add(&bar[XB_TOP], 1u);
      const unsigned tg = og / nx;
      if (og + 1u == (tg + 1u) * nx) xb_add(&bar[XB_TOPGEN], 1u);
      else XB_SPIN(xb_ld(&bar[XB_TOPGEN]) == tg, bar);
      __builtin_amdgcn_fence(__ATOMIC_ACQUIRE, "agent");
      xb_add(&bar[XB_XGEN(b.x)], 1u);
      asm volatile("s_waitcnt vmcnt(0)" ::: "memory");
    } else {
      XB_SPIN(xb_ld(&bar[XB_XGEN(b.x)]) == gen, bar);
      __builtin_amdgcn_fence(__ATOMIC_ACQUIRE, "agent");
      asm volatile("s_waitcnt vmcnt(0)" ::: "memory");
    }
  }
  __syncthreads();
}

DEVINL void run_phase(const Params& p, int ph, char* smem, int cu_role = 0) {
  const int G = gridDim.x;
  u16* merged = p.z_rkv;
  u16* qpeer = p.z_rkv;
  int* pidx = (int*)p.z_attn;
  float* pgate = (float*)(p.z_attn + (size_t)T * 128 * 2);
  float* plv = (float*)((char*)p.z_attn + (size_t)T * 128 * 8);
  int* pli = (int*)((char*)p.z_attn + (size_t)T * 128 * 16);
  u16* X = (u16*)((char*)p.ub + (size_t)16384 * 1024);
  switch (ph) {
    case 0: phase0(p, smem); break;
    case 1:
      norm_rows_fp8(p);
      for (int t = blockIdx.x; t < 1920; t += G) transpose_tile_fp8(p, t, smem);
      break;
    case 2: {
      if (cu_role & 1) __builtin_amdgcn_s_sleep(22);
      Epi1 e{p};
      for_tiles(256, 60, [&](int mt, int nt) { gemm_tile<true>(p.bufB, 1024, p.w_in_t, 1024, 1024, mt * 128, nt * 128, smem, e); });
    } break;
    case 3: {
      int* sh = (int*)smem;
      const int role = cu_role;
      for (int pass = 0; pass < 2; ++pass) {
        const bool do_scan = (pass == 0) == (role == 0);
        if (do_scan) {
          for (;;) {
            __syncthreads();
            if (threadIdx.x == 0) sh[1] = atomicAdd(&p.ctr[2048], 1);
            __syncthreads();
            const int u = sh[1];
            if (u >= 256) break;
            rwkv_scan_unit(p, X, u, smem);
          }
        } else {
          for (;;) {
            __syncthreads();
            if (threadIdx.x == 0) sh[1] = atomicAdd(&p.ctr[2049], 1);
            __syncthreads();
            const int u = sh[1];
            if (u >= 6144) break;
            attn_unit(p, u, smem);
          }
          if (pass == 0) { late_transpose_queue(p, smem); cvt_fp4_queue(p, smem); }
        }
      }
      late_transpose_queue(p, smem);
      cvt_fp4_queue(p, smem);
    } break;
    case 4: attn_merge(p); break;
    case 15: prep_phase(p, X); break;
    case 5: {
      if (cu_role & 1) __builtin_amdgcn_s_sleep(22);
      Epi5a ea{p, merged};
      Epi5b eb{p, merged};
      for_tiles(256, 8, [&](int mt, int nt) {
        gemm_tile(p.bufB, 1024, p.w_br_r_t, 1024, 1024, mt * 128, nt * 128, smem, ea);
        gemm_tile(p.z_lora, 256, p.w_br_a_t, 256, 256, mt * 128, nt * 128, smem, eb);
      });
    } break;
    case 6: {
      if (cu_role & 1) __builtin_amdgcn_s_sleep(22);
      Epi6 e{p};
      for_tiles(256, 8, [&](int mt, int nt) { gemm_tile(merged, 1024, p.w_out_t, 1024, 1024, mt * 128, nt * 128, smem, e); });
    } break;
    case 7: norm_rows(p.out, p.norm2_g, p.mod, 3072, 4096, p.bufB); break;
    case 8: {
      if (cu_role & 1) __builtin_amdgcn_s_sleep(22);
      Epi8 e{qpeer};
      for_tiles(256, 16, [&](int mt, int nt) { gemm_tile(p.bufB, 1024, p.wq_t, 1024, 1024, mt * 128, nt * 128, smem, e); });
    } break;
    case 9:
      peer_route_a(p, qpeer, plv, pli, smem);
      break;
    case 16: peer_route_b(plv, pli, pidx, pgate); break;
    case 10: peer_gather(p, p.bufB, pidx, pgate); break;
    case 11: peer_gather(p, p.bufB, pidx, pgate, p.z_rkv + (size_t)T * 2048); break;
  }
}
constexpr int NPHASE = 11;

#if MULTI
__global__ void __launch_bounds__(256, 2) phase_kernel(Params p, int ph) {
  __shared__ __attribute__((aligned(16))) char smem[SMEM_BYTES];
  run_phase(p, ph, smem);
}
#else
__global__ void __launch_bounds__(256, 2) mega_kernel(Params p) {
  __shared__ __attribute__((aligned(16))) char smem[SMEM_BYTES];
  __shared__ uint4 xb_words;
  cg::grid_group grid = cg::this_grid();
  if (threadIdx.x == 0) xb_words = make_uint4(0u, 0u, 0u, 0u);
  __syncthreads();
  __shared__ int cu_role_s;
  if (threadIdx.x == 0) {
    unsigned cu = __builtin_amdgcn_s_getreg(0x3A04);
    unsigned xcc = __builtin_amdgcn_s_getreg(0x1814);
    cu_role_s = atomicAdd(&p.ctr[(xcc & 7) * 256 + (cu & 255)], 1);
  }
  __syncthreads();
  const int cu_role = cu_role_s;
  XcdBarrier xb = xcd_barrier_post(p.bar, (volatile LAS unsigned*)&xb_words);
#define SYNC() xcd_barrier(xb)
  if (p.x == nullptr) grid.sync();
  run_phase(p, 0, smem, cu_role); SYNC();
  if (DUP == 0) { run_phase(p, 0, smem, cu_role); SYNC(); }
  run_phase(p, 1, smem, cu_role); SYNC();
  if (DUP == 1) { run_phase(p, 1, smem, cu_role); SYNC(); }
  run_phase(p, 2, smem, cu_role); SYNC();
  run_phase(p, 15, smem, cu_role); SYNC();
  if (DUP == 2) { run_phase(p, 2, smem, cu_role); SYNC(); }
  run_phase(p, 3, smem, cu_role); SYNC();
  run_phase(p, 4, smem, cu_role); SYNC();
  if (DUP == 4) { run_phase(p, 4, smem, cu_role); SYNC(); }
  run_phase(p, 5, smem, cu_role); SYNC();
  if (DUP == 5) { run_phase(p, 5, smem, cu_role); SYNC(); }
  run_phase(p, 6, smem, cu_role); SYNC();
  if (DUP == 6) { run_phase(p, 6, smem, cu_role); SYNC(); }
  run_phase(p, 7, smem, cu_role); SYNC();
  if (DUP == 7) { run_phase(p, 7, smem, cu_role); SYNC(); }
  run_phase(p, 8, smem, cu_role); SYNC();
  if (DUP == 8) { run_phase(p, 8, smem, cu_role); SYNC(); }
  run_phase(p, 9, smem, cu_role); SYNC();
  run_phase(p, 16, smem, cu_role); SYNC();
  if (DUP == 9) { run_phase(p, 9, smem, cu_role); SYNC(); }
  if (DUP == 10) { run_phase(p, 11, smem, cu_role); SYNC(); }
  run_phase(p, 10, smem, cu_role);
}
#endif

extern "C" void kernel_launch(void* const* d_in, const int* in_sizes, int n_in, void* d_out, int out_size, void* d_ws,
                              size_t ws_size, hipStream_t stream) {
  Params p{};
  const float** pf = (const float**)&p;
  for (int i = 0; i < 28; ++i) pf[i] = (const float*)d_in[i];
  p.out = (float*)d_out;
  char* ws = (char*)d_ws;
  size_t off = 0;
  auto take = [&](size_t bytes) { char* r = ws + off; off += (bytes + 255) & ~(size_t)255; return r; };
  p.w_in_t = (u16*)take((size_t)7680 * 1024 * 2);
  p.w_br_r_t = (u16*)take((size_t)1024 * 1024 * 2);
  p.w_br_a_t = (u16*)take((size_t)1024 * 256 * 2);
  p.w_out_t = (u16*)take((size_t)1024 * 1024 * 2);
  p.wq_t = (u16*)take((size_t)2048 * 1024 * 2);
  p.k1b = (u16*)take(128 * 128 * 2);
  p.k2b = (u16*)take(128 * 128 * 2);
  p.w2t = (u16*)take(1024 * 64 * 2);
  p.a2t = (u16*)take(1024 * 64 * 2);
  p.g2t = (u16*)take(1024 * 128 * 2);
  p.mod = (float*)take(16 * 6144 * 4);
  p.lse = (float*)take((size_t)3 * T * 4 * 4);
  p.bar = (unsigned*)take(4096 * 4);
  p.ctr = (int*)take(4096 * 4);
  p.colamax = (int*)take(8192 * 4);
  p.n1s = (float*)take((size_t)T * 4);
  p.w_in_s = (float*)take(8192 * 4);
  p.usc = (float*)take(16384 * 4);
  p.vsc = (float*)take(16384 * 4);
  p.bufB = (u16*)take((size_t)T * 1024 * 2);
  p.z_rkv = (u16*)take((size_t)T * 3072 * 2);
  p.z_lora = (u16*)take((size_t)T * 256 * 2);
  p.z_attn = (u16*)take((size_t)T * 2304 * 2);
  p.ub = (u16*)take((size_t)16384 * 1024 * 2);
  p.vb = (u16*)take((size_t)16384 * 1024 * 2);
  p.gates = (u16*)d_out;
  if (off > ws_size) { fprintf(stderr, "workspace too small: need %zu have %zu\n", off, ws_size); return; }
#if MULTI
  (void)hipMemsetAsync(p.bar, 0, 4 * 4096 * 4, stream);
  for (int ph = 0; ph < NPHASE; ++ph) phase_kernel<<<512, 256, 0, stream>>>(p, ph);
#else
  static int grid_blocks = 0;
  if (!grid_blocks) {
    int dev = 0, cus = 0, per_cu = 0;
    hipGetDevice(&dev);
    hipDeviceGetAttribute(&cus, hipDeviceAttributeMultiprocessorCount, dev);
    hipOccupancyMaxActiveBlocksPerMultiprocessor(&per_cu, mega_kernel, 256, 0);
    if (per_cu > 2) per_cu = 2;
    grid_blocks = cus * per_cu;
  }
  (void)hipMemsetAsync(p.bar, 0, 4 * 4096 * 4, stream);
  void* args[] = {&p};
  hipError_t e = hipLaunchCooperativeKernel((void*)mega_kernel, dim3(grid_blocks), dim3(256), args, 0, stream);
  if (e != hipSuccess) fprintf(stderr, "cooperative launch failed: %s (grid %d)\n", hipGetErrorString(e), grid_blocks);
#endif
}
```

```cpp
#include <hip/hip_runtime.h>
#include <hip/hip_cooperative_groups.h>
#include <cstdio>
#include <cstdint>
namespace cg = cooperative_groups;

#ifndef MULTI
#define MULTI 0
#endif
#ifndef DUP
#define DUP -1
#endif

typedef unsigned short u16;
using bf16x8 = __attribute__((ext_vector_type(8))) short;
using bf16x4 = __attribute__((ext_vector_type(4))) short;
using f32x4  = __attribute__((ext_vector_type(4))) float;
using u32x4  = __attribute__((ext_vector_type(4))) unsigned int;
using f32x2  = __attribute__((ext_vector_type(2))) float;

#define DEVINL __device__ __forceinline__

constexpr int T = 32768;
constexpr int SMEM_BYTES = 79872;

struct Params {
  const float *x, *c, *w_ada, *b_ada, *norm1_g, *w_in, *mu, *w0, *w2, *a0, *a2, *g2, *k_k, *k_a, *r_k,
      *lnx_g, *lnx_b, *qng, *kng, *w_br_r, *w_br_a, *w_out, *norm2_g, *wq, *k1, *k2, *pu, *pv;
  float* out;
  u16 *w_in_t, *w_br_r_t, *w_br_a_t, *w_out_t, *wq_t, *k1b, *k2b, *w2t, *a2t, *g2t;
  float *mod, *lse, *usc, *vsc, *n1s, *w_in_s;
  int* colamax;
  unsigned* bar;
  int* ctr;
  u16 *bufB, *z_rkv, *z_lora, *z_attn, *ub, *vb, *gates;
};

DEVINL u16 f2bf(float f) {
  uint32_t u = __float_as_uint(f);
  u += 0x7fffu + ((u >> 16) & 1u);
  return (u16)(u >> 16);
}
DEVINL float bf2f(u16 h) { return __uint_as_float(((uint32_t)h) << 16); }
typedef __bf16 hwbf16x2 __attribute__((ext_vector_type(2)));
DEVINL uint32_t pack2(float a, float b) {
  f32x2 v = {a, b};
  hwbf16x2 r = __builtin_convertvector(v, hwbf16x2);
  return *(uint32_t*)&r;
}
DEVINL float bflo(uint32_t u) { return __uint_as_float(u << 16); }
DEVINL float bfhi(uint32_t u) { return __uint_as_float(u & 0xffff0000u); }
DEVINL float sigm(float x) { return 1.f / (1.f + __expf(-x)); }
template <int CTRL>
DEVINL float dpp_f(float x) {
  return __int_as_float(__builtin_amdgcn_update_dpp(0, __float_as_int(x), CTRL, 0xF, 0xF, true));
}
DEVINL float quad_sum(float v) {
  v += dpp_f<0xB1>(v);
  v += dpp_f<0x4E>(v);
  return v;
}
DEVINL float row16_sum(float v) {
  v += dpp_f<0x128>(v); v += dpp_f<0x124>(v); v += dpp_f<0x122>(v); v += dpp_f<0x121>(v);
  return v;
}
DEVINL float oct_sum(float v) {
  v += dpp_f<0xB1>(v);
  v += dpp_f<0x4E>(v);
  v += dpp_f<0x141>(v);
  return v;
}
DEVINL float row16_max(float v) {
  v = fmaxf(v, dpp_f<0x128>(v)); v = fmaxf(v, dpp_f<0x124>(v)); v = fmaxf(v, dpp_f<0x122>(v)); v = fmaxf(v, dpp_f<0x121>(v));
  return v;
}
DEVINL float wave_sum(float v) {
  v = row16_sum(v);
  v += __shfl_xor(v, 16);
  v += __shfl_xor(v, 32);
  return v;
}
DEVINL float wave_max(float v) {
  v = row16_max(v);
  v = fmaxf(v, __shfl_xor(v, 16));
  v = fmaxf(v, __shfl_xor(v, 32));
  return v;
}

DEVINL void p0_mod_unit(const Params& p, int unit, char* smem) {
  float* sC = (float*)smem;
  const int tid = threadIdx.x, lane = tid & 63, wid = tid >> 6;
  __syncthreads();
  for (int e = tid; e < 16 * 1024; e += 256) {
    int b = e >> 10, k = e & 1023;
    float v = p.c[e];
    sC[k * 16 + b] = v / (1.f + __expf(-v));
  }
  __syncthreads();
  const int col = unit * 64 + lane;
  float acc[16];
#pragma unroll
  for (int b = 0; b < 16; ++b) acc[b] = 0.f;
  const float* wp = p.w_ada + (size_t)(wid * 256) * 6144 + col;
#pragma unroll 16
  for (int k = 0; k < 256; ++k) {
    float wv = wp[(size_t)k * 6144];
    const float4* s4 = (const float4*)(sC + (wid * 256 + k) * 16);
    float4 s0 = s4[0], s1 = s4[1], s2 = s4[2], s3 = s4[3];
    acc[0] += s0.x * wv; acc[1] += s0.y * wv; acc[2] += s0.z * wv; acc[3] += s0.w * wv;
    acc[4] += s1.x * wv; acc[5] += s1.y * wv; acc[6] += s1.z * wv; acc[7] += s1.w * wv;
    acc[8] += s2.x * wv; acc[9] += s2.y * wv; acc[10] += s2.z * wv; acc[11] += s2.w * wv;
    acc[12] += s3.x * wv; acc[13] += s3.y * wv; acc[14] += s3.z * wv; acc[15] += s3.w * wv;
  }
  __syncthreads();
  float* sR = (float*)smem;
#pragma unroll
  for (int b = 0; b < 16; ++b) sR[(wid * 16 + b) * 64 + lane] = acc[b];
  __syncthreads();
  for (int e = tid; e < 1024; e += 256) {
    int b = e >> 6, l = e & 63;
    float s = sR[(b)*64 + l] + sR[(16 + b) * 64 + l] + sR[(32 + b) * 64 + l] + sR[(48 + b) * 64 + l];
    int cc = unit * 64 + l;
    p.mod[b * 6144 + cc] = s + p.b_ada[cc];
  }
}

DEVINL void transpose_tile(const float* __restrict__ src, int K, int N, u16* __restrict__ dst, int tile, char* smem) {
  float(*s)[65] = (float(*)[65])smem;
  const int tid = threadIdx.x;
  const int nkt = K >> 6;
  const int kt = tile % nkt, nt = tile / nkt;
  __syncthreads();
#pragma unroll
  for (int i = 0; i < 16; ++i) {
    int r = (tid >> 6) + 4 * i;
    s[r][tid & 63] = src[(size_t)(kt * 64 + r) * N + nt * 64 + (tid & 63)];
  }
  __syncthreads();
#pragma unroll
  for (int i = 0; i < 16; ++i) {
    int n = (tid >> 6) + 4 * i;
    dst[(size_t)(nt * 64 + n) * K + kt * 64 + (tid & 63)] = f2bf(s[tid & 63][n]);
  }
}

DEVINL void cvt_straight(const float* __restrict__ src, u16* __restrict__ dst, size_t n4, size_t start, size_t stride) {
  for (size_t i = start; i < n4; i += stride) {
    float4 v = ((const float4*)src)[i];
    uint2 o; o.x = pack2(v.x, v.y); o.y = pack2(v.z, v.w);
    ((uint2*)dst)[i] = o;
  }
}

DEVINL void cvt_row_fp4(const float* __restrict__ src, unsigned char* __restrict__ dst, float* __restrict__ inv_scale, int row) {
  const int lane = threadIdx.x & 63;
  {
    const float4* sp = (const float4*)(src + (size_t)row * 1024 + lane * 16);
    float4 v0 = sp[0], v1 = sp[1], v2 = sp[2], v3 = sp[3];
    float am = fmaxf(fmaxf(fmaxf(fabsf(v0.x), fabsf(v0.y)), fmaxf(fabsf(v0.z), fabsf(v0.w))),
                     fmaxf(fmaxf(fabsf(v1.x), fabsf(v1.y)), fmaxf(fabsf(v1.z), fabsf(v1.w))));
    am = fmaxf(am, fmaxf(fmaxf(fmaxf(fabsf(v2.x), fabsf(v2.y)), fmaxf(fabsf(v2.z), fabsf(v2.w))),
                         fmaxf(fmaxf(fabsf(v3.x), fabsf(v3.y)), fmaxf(fabsf(v3.z), fabsf(v3.w)))));
    am = wave_max(am);
    const float sc = (am > 0.f) ? 6.f / am : 1.f;
    const float inv = (am > 0.f) ? am * (1.f / 6.f) : 1.f;
    unsigned w0 = 0, w1 = 0;
    w0 = __builtin_amdgcn_cvt_scalef32_pk_fp4_f32(w0, v0.x * sc, v0.y * sc, 1.0f, 0);
    w0 = __builtin_amdgcn_cvt_scalef32_pk_fp4_f32(w0, v0.z * sc, v0.w * sc, 1.0f, 1);
    w0 = __builtin_amdgcn_cvt_scalef32_pk_fp4_f32(w0, v1.x * sc, v1.y * sc, 1.0f, 2);
    w0 = __builtin_amdgcn_cvt_scalef32_pk_fp4_f32(w0, v1.z * sc, v1.w * sc, 1.0f, 3);
    w1 = __builtin_amdgcn_cvt_scalef32_pk_fp4_f32(w1, v2.x * sc, v2.y * sc, 1.0f, 0);
    w1 = __builtin_amdgcn_cvt_scalef32_pk_fp4_f32(w1, v2.z * sc, v2.w * sc, 1.0f, 1);
    w1 = __builtin_amdgcn_cvt_scalef32_pk_fp4_f32(w1, v3.x * sc, v3.y * sc, 1.0f, 2);
    w1 = __builtin_amdgcn_cvt_scalef32_pk_fp4_f32(w1, v3.z * sc, v3.w * sc, 1.0f, 3);
    *(uint2*)(dst + (size_t)row * 512 + lane * 8) = make_uint2(w0, w1);
    if (lane == 0) inv_scale[row] = inv;
  }
}

DEVINL void cvt_fp4_queue(const Params& p, char* smem) {
  int* sh = (int*)smem;
  const int wid = threadIdx.x >> 6;
  for (;;) {
    __syncthreads();
    if (threadIdx.x == 0) sh[0] = atomicAdd(&p.ctr[2050], 1);
    __syncthreads();
    const int c = sh[0];
    if (c >= 2048) break;
    const bool isv = c >= 1024;
    const int r0 = (c & 1023) * 16 + wid * 4;
#pragma unroll
    for (int i = 0; i < 4; ++i)
      cvt_row_fp4(isv ? p.pv : p.pu, (unsigned char*)(isv ? p.vb : p.ub), isv ? p.vsc : p.usc, r0 + i);
  }
}

DEVINL void late_transpose_queue(const Params& p, char* smem) {
  int* sh = (int*)(smem + 64 * 65 * 4);
  for (;;) {
    __syncthreads();
    if (threadIdx.x == 0) sh[0] = atomicAdd(&p.ctr[2051], 1);
    __syncthreads();
    int t = sh[0];
    if (t >= 1088) break;
    if (t < 256) { transpose_tile(p.w_br_r, 1024, 1024, p.w_br_r_t, t, smem); continue; } t -= 256;
    if (t < 64) { transpose_tile(p.w_br_a, 256, 1024, p.w_br_a_t, t, smem); continue; } t -= 64;
    if (t < 256) { transpose_tile(p.w_out, 1024, 1024, p.w_out_t, t, smem); continue; } t -= 256;
    transpose_tile(p.wq, 1024, 2048, p.wq_t, t, smem);
  }
}

DEVINL void phase0(const Params& p, char* smem) {
  const int G = gridDim.x;
  constexpr int NT0 = 120, NT5 = 16, NT6 = 16, NT7 = 32;
  constexpr int NTR = NT0 + NT5 + NT6 + NT7;
  for (int u = blockIdx.x; u < 96 + NTR; u += G) {
    if (u < 96) { p0_mod_unit(p, u, smem); continue; }
    int t = u - 96;
    if (t < NT0) {
      {
        const int nb = t >> 2, part = t & 3;
        const int n = nb * 256 + threadIdx.x;
        const float* wp = p.w_in + (size_t)(part * 256) * 7680 + n;
        float m = 0.f;
#pragma unroll 16
        for (int k = 0; k < 256; ++k) m = fmaxf(m, fabsf(wp[(size_t)k * 7680]));
        atomicMax(&p.colamax[n], __float_as_int(m));
      }
      continue;
    } t -= NT0;
    if (t < NT5) { transpose_tile(p.w2, 64, 1024, p.w2t, t, smem); continue; } t -= NT5;
    if (t < NT6) { transpose_tile(p.a2, 64, 1024, p.a2t, t, smem); continue; } t -= NT6;
    transpose_tile(p.g2, 128, 1024, p.g2t, t, smem);
  }
  size_t start = (size_t)blockIdx.x * 256 + threadIdx.x, stride = (size_t)G * 256;
  cvt_straight(p.k1, p.k1b, 128 * 128 / 4, start, stride);
  cvt_straight(p.k2, p.k2b, 128 * 128 / 4, start, stride);
}

DEVINL void norm_rows(const float* __restrict__ xin, const float* __restrict__ g, const float* __restrict__ mod,
                      int sh_off, int sc_off, u16* __restrict__ dst) {
  const int lane = threadIdx.x & 63, wid = threadIdx.x >> 6;
  const int nw = gridDim.x * 4;
  for (int row = blockIdx.x * 4 + wid; row < T; row += nw) {
    const float4* xr = (const float4*)(xin + (size_t)row * 1024);
    float4 v[4];
    float ss = 0.f;
#pragma unroll
    for (int i = 0; i < 4; ++i) {
      v[i] = xr[i * 64 + lane];
      ss += v[i].x * v[i].x + v[i].y * v[i].y + v[i].z * v[i].z + v[i].w * v[i].w;
    }
    ss = wave_sum(ss);
    const float rstd = rsqrtf(ss * (1.f / 1024.f) + 1e-6f);
    const float* mb = mod + (row >> 11) * 6144;
#pragma unroll
    for (int i = 0; i < 4; ++i) {
      int col = (i * 64 + lane) * 4;
      float4 gg = *(const float4*)(g + col);
      float4 sc = *(const float4*)(mb + sc_off + col);
      float4 sh = *(const float4*)(mb + sh_off + col);
      float o0 = v[i].x * rstd * gg.x * (1.f + sc.x) + sh.x;
      float o1 = v[i].y * rstd * gg.y * (1.f + sc.y) + sh.y;
      float o2 = v[i].z * rstd * gg.z * (1.f + sc.z) + sh.z;
      float o3 = v[i].w * rstd * gg.w * (1.f + sc.w) + sh.w;
      uint2 o; o.x = pack2(o0, o1); o.y = pack2(o2, o3);
      *(uint2*)(dst + (size_t)row * 1024 + col) = o;
    }
  }
}


DEVINL void transpose_tile_fp8(const Params& p, int tile, char* smem) {
  float(*s)[65] = (float(*)[65])smem;
  const int tid = threadIdx.x;
  const int kt = tile & 15, nt = tile >> 4;
  unsigned char* dst = (unsigned char*)p.w_in_t;
  __syncthreads();
#pragma unroll
  for (int i = 0; i < 16; ++i) {
    int r = (tid >> 6) + 4 * i;
    s[r][tid & 63] = p.w_in[(size_t)(kt * 64 + r) * 7680 + nt * 64 + (tid & 63)];
  }
  __syncthreads();
  const int k4 = (tid & 15) * 4;
#pragma unroll
  for (int i = 0; i < 4; ++i) {
    const int n = (tid >> 4) + 16 * i;
    const float am = __int_as_float(p.colamax[nt * 64 + n]);
    const float sc = (am > 0.f) ? 224.f / am : 1.f;
    int w = 0;
    w = __builtin_amdgcn_cvt_pk_fp8_f32(s[k4][n] * sc, s[k4 + 1][n] * sc, w, false);
    w = __builtin_amdgcn_cvt_pk_fp8_f32(s[k4 + 2][n] * sc, s[k4 + 3][n] * sc, w, true);
    *(int*)(dst + (size_t)(nt * 64 + n) * 1024 + kt * 64 + k4) = w;
    if (kt == 0 && k4 == 0) p.w_in_s[nt * 64 + n] = (am > 0.f) ? am * (1.f / 224.f) : 1.f;
  }
}

DEVINL void norm_rows_fp8(const Params& p) {
  const int lane = threadIdx.x & 63, wid = threadIdx.x >> 6;
  const int nw = gridDim.x * 4;
  unsigned char* dst = (unsigned char*)p.bufB;
  for (int row = blockIdx.x * 4 + wid; row < T; row += nw) {
    const float4* xr = (const float4*)(p.x + (size_t)row * 1024);
    float4 v[4];
    float ss = 0.f;
#pragma unroll
    for (int i = 0; i < 4; ++i) {
      v[i] = xr[i * 64 + lane];
      ss += v[i].x * v[i].x + v[i].y * v[i].y + v[i].z * v[i].z + v[i].w * v[i].w;
    }
    ss = wave_sum(ss);
    const float rstd = rsqrtf(ss * (1.f / 1024.f) + 1e-6f);
    const float* mb = p.mod + (row >> 11) * 6144;
    float o[16];
    float am = 0.f;
#pragma unroll
    for (int i = 0; i < 4; ++i) {
      int col = (i * 64 + lane) * 4;
      float4 gg = *(const float4*)(p.norm1_g + col);
      float4 sc = *(const float4*)(mb + 1024 + col);
      float4 sh = *(const float4*)(mb + col);
      o[i * 4 + 0] = v[i].x * rstd * gg.x * (1.f + sc.x) + sh.x;
      o[i * 4 + 1] = v[i].y * rstd * gg.y * (1.f + sc.y) + sh.y;
      o[i * 4 + 2] = v[i].z * rstd * gg.z * (1.f + sc.z) + sh.z;
      o[i * 4 + 3] = v[i].w * rstd * gg.w * (1.f + sc.w) + sh.w;
      am = fmaxf(am, fmaxf(fmaxf(fabsf(o[i * 4]), fabsf(o[i * 4 + 1])), fmaxf(fabsf(o[i * 4 + 2]), fabsf(o[i * 4 + 3]))));
    }
    am = wave_max(am);
    const float qs = (am > 0.f) ? 224.f / am : 1.f;
#pragma unroll
    for (int i = 0; i < 4; ++i) {
      int col = (i * 64 + lane) * 4;
      int w = 0;
      w = __builtin_amdgcn_cvt_pk_fp8_f32(o[i * 4] * qs, o[i * 4 + 1] * qs, w, false);
      w = __builtin_amdgcn_cvt_pk_fp8_f32(o[i * 4 + 2] * qs, o[i * 4 + 3] * qs, w, true);
      *(int*)(dst + (size_t)row * 1024 + col) = w;
    }
    if (lane == 0) p.n1s[row] = (am > 0.f) ? am * (1.f / 224.f) : 1.f;
  }
}

#define LDS_AS __attribute__((address_space(3)))
using i64x2 = __attribute__((ext_vector_type(2))) long;
using v8i32 = __attribute__((ext_vector_type(8))) int;
using v4i32 = __attribute__((ext_vector_type(4))) int;
template <bool FP8 = false, class Epi>
DEVINL void gemm_tile(const void* __restrict__ A, int lda, const void* __restrict__ Bt, int ldb, int K, int m0, int n0,
                      char* smem, const Epi& epi) {
  constexpr int EB = FP8 ? 1 : 2;
  constexpr int KS = 128 / EB;
  constexpr int CE = 16 / EB;
  const int tid = threadIdx.x, lane = tid & 63, wid = tid >> 6;
  const int wr = wid >> 1, wc = wid & 1;
  const int fr = lane & 15, fq = lane >> 4;
  f32x4 acc[4][4];
#pragma unroll
  for (int m = 0; m < 4; ++m)
#pragma unroll
    for (int n = 0; n < 4; ++n) acc[m][n] = (f32x4){0.f, 0.f, 0.f, 0.f};
  const int l3 = lane >> 3, cch = (lane & 7) ^ l3;
  const char* Ab = (const char*)A + (size_t)m0 * lda * EB;
  const char* Bb = (const char*)Bt + (size_t)n0 * ldb * EB;
  const uint32_t aoff = (uint32_t)((wid * 32 + l3) * lda + cch * CE) * (uint32_t)EB;
  const uint32_t boff = (uint32_t)((16 * (lane >> 5) + (l3 & 3)) * ldb + cch * CE) * (uint32_t)EB;
  const int rowB_base = (wid >> 1) * 64 + 8 * (wid & 1);
  char* ldsw = smem + wid * 4096 + lane * 16;
#define DMA(buf, k0_)                                                                                           \
  _Pragma("unroll") for (int i = 0; i < 4; ++i) {                                                               \
    __builtin_amdgcn_global_load_lds((const unsigned*)(Ab + (size_t)((i * 8 * lda + (k0_)) * EB) + aoff),       \
                                     (LDS_AS unsigned*)(ldsw + (buf) * 32768 + i * 1024), 16, 0, 0);            \
    __builtin_amdgcn_global_load_lds(                                                                           \
        (const unsigned*)(Bb + (size_t)(((rowB_base + 32 * (i & 1) + 4 * (i >> 1)) * ldb + (k0_)) * EB) + boff), \
        (LDS_AS unsigned*)(ldsw + (buf) * 32768 + 16384 + i * 1024), 16, 0, 0);                                 \
  }
  const int ra0 = (wr * 64 + fr) * 128 + (((0 + fq) ^ (fr & 7)) << 4);
  const int ra1 = (wr * 64 + fr) * 128 + (((4 + fq) ^ (fr & 7)) << 4);
  const int rb0 = 16384 + (wc * 64 + fr) * 128 + (((0 + fq) ^ (fr & 7)) << 4);
  const int rb1 = 16384 + (wc * 64 + fr) * 128 + (((4 + fq) ^ (fr & 7)) << 4);
  const int qa0 = (wr * 64 + fr) * 128 + (((2 * fq) ^ (fr & 7)) << 4);
  const int qa1 = (wr * 64 + fr) * 128 + (((2 * fq + 1) ^ (fr & 7)) << 4);
  const int qb0 = 16384 + (wc * 64 + fr) * 128 + (((2 * fq) ^ (fr & 7)) << 4);
  const int qb1 = 16384 + (wc * 64 + fr) * 128 + (((2 * fq + 1) ^ (fr & 7)) << 4);
#define LD32(off0, off1, dst)                                        \
  {                                                                  \
    dst.lo = *(const v4i32*)(off0);                                  \
    dst.hi = *(const v4i32*)(off1);                                  \
  }
#define COMPUTE(buf)                                                                                        \
  if (FP8) {                                                                                                \
    v8i32 bfr[4];                                                                                           \
    _Pragma("unroll") for (int n = 0; n < 4; ++n) LD32(smem + (buf) * 32768 + qb0 + n * 2048, smem + (buf) * 32768 + qb1 + n * 2048, bfr[n])  \
    _Pragma("unroll") for (int m = 0; m < 4; ++m) {                                                         \
      v8i32 af;                                                                                             \
      LD32(smem + (buf) * 32768 + qa0 + m * 2048, smem + (buf) * 32768 + qa1 + m * 2048, af)                \
      _Pragma("unroll") for (int n = 0; n < 4; ++n)                                                         \
        acc[m][n] = __builtin_amdgcn_mfma_scale_f32_16x16x128_f8f6f4(bfr[n], af, acc[m][n], 0, 0, 0, 127, 0, 127); \
    }                                                                                                       \
    __builtin_amdgcn_sched_barrier(0);                                                                      \
  } else {                                                                                                  \
    _Pragma("unroll") for (int ks = 0; ks < 2; ++ks) {                                                      \
      bf16x8 af[4], bfr[4];                                                                                 \
      _Pragma("unroll") for (int m = 0; m < 4; ++m) af[m] = *(const bf16x8*)(smem + (buf) * 32768 + (ks ? ra1 : ra0) + m * 2048);  \
      _Pragma("unroll") for (int n = 0; n < 4; ++n) bfr[n] = *(const bf16x8*)(smem + (buf) * 32768 + (ks ? rb1 : rb0) + n * 2048); \
      _Pragma("unroll") for (int m = 0; m < 4; ++m)                                                         \
        _Pragma("unroll") for (int n = 0; n < 4; ++n)                                                       \
          acc[m][n] = __builtin_amdgcn_mfma_f32_16x16x32_bf16(bfr[n], af[m], acc[m][n], 0, 0, 0);           \
    }                                                                                                       \
  }
  __syncthreads();
  DMA(0, 0)
  __syncthreads();
#pragma unroll 1
  for (int k0 = 0; k0 < K; k0 += 2 * KS) {
    DMA(1, k0 + KS)
    COMPUTE(0)
    __syncthreads();
    if (k0 + 2 * KS < K) { DMA(0, k0 + 2 * KS) }
    COMPUTE(1)
    __syncthreads();
  }
#undef DMA
#undef COMPUTE
#undef LD32
#pragma unroll
  for (int m = 0; m < 4; ++m) {
    int row = m0 + wr * 64 + m * 16 + fr;
    int col0 = n0 + wc * 64 + fq * 16;
    epi(row, col0, acc[m]);
  }
}

DEVINL void store16_bf16(u16* dst, const f32x4 (&v)[4]) {
  uint4 a, b;
  a.x = pack2(v[0][0], v[0][1]); a.y = pack2(v[0][2], v[0][3]);
  a.z = pack2(v[1][0], v[1][1]); a.w = pack2(v[1][2], v[1][3]);
  b.x = pack2(v[2][0], v[2][1]); b.y = pack2(v[2][2], v[2][3]);
  b.z = pack2(v[3][0], v[3][1]); b.w = pack2(v[3][2], v[3][3]);
  ((uint4*)dst)[0] = a;
  ((uint4*)dst)[1] = b;
}

struct Epi1 {
  const Params& p;
  DEVINL void operator()(int row, int col, const f32x4 (&vin)[4]) const {
    f32x4 v[4];
    {
      const float sa = p.n1s[row];
      const float* sb = p.w_in_s + col;
#pragma unroll
      for (int n = 0; n < 4; ++n) {
        const float4 s4 = *(const float4*)(sb + n * 4);
        v[n][0] = vin[n][0] * sa * s4.x; v[n][1] = vin[n][1] * sa * s4.y;
        v[n][2] = vin[n][2] * sa * s4.z; v[n][3] = vin[n][3] * sa * s4.w;
      }
    }
    if (col < 3072) store16_bf16(p.z_rkv + (size_t)row * 3072 + col, v);
    else if (col < 3328) store16_bf16(p.z_lora + (size_t)row * 256 + (col - 3072), v);
    else if (col < 5632) store16_bf16(p.z_attn + (size_t)row * 2304 + (col - 3328), v);
    else {
      f32x4 s[4];
#pragma unroll
      for (int n = 0; n < 4; ++n)
#pragma unroll
        for (int j = 0; j < 4; ++j) s[n][j] = sigm(v[n][j]);
      store16_bf16(p.gates + (size_t)row * 2048 + (col - 5632), s);
    }
  }
};
struct Epi5a {
  const Params& p; u16* merged;
  DEVINL void operator()(int row, int col, const f32x4 (&v)[4]) const {
    const uint4* gp = (const uint4*)(p.gates + (size_t)row * 2048 + col);
    uint4 g0 = gp[0], g1 = gp[1];
    uint32_t gw[8] = {g0.x, g0.y, g0.z, g0.w, g1.x, g1.y, g1.z, g1.w};
    f32x4 s[4];
#pragma unroll
    for (int n = 0; n < 4; ++n) {
      s[n][0] = v[n][0] * bflo(gw[n * 2]); s[n][1] = v[n][1] * bfhi(gw[n * 2]);
      s[n][2] = v[n][2] * bflo(gw[n * 2 + 1]); s[n][3] = v[n][3] * bfhi(gw[n * 2 + 1]);
    }
    store16_bf16(merged + (size_t)row * 1024 + col, s);
  }
};
struct Epi5b {
  const Params& p; u16* merged;
  DEVINL void operator()(int row, int col, const f32x4 (&v)[4]) const {
    const uint4* gp = (const uint4*)(p.gates + (size_t)row * 2048 + 1024 + col);
    uint4 g0 = gp[0], g1 = gp[1];
    uint32_t gw[8] = {g0.x, g0.y, g0.z, g0.w, g1.x, g1.y, g1.z, g1.w};
    const uint4* tp = (const uint4*)(merged + (size_t)row * 1024 + col);
    uint4 t0 = tp[0], t1 = tp[1];
    uint32_t tw[8] = {t0.x, t0.y, t0.z, t0.w, t1.x, t1.y, t1.z, t1.w};
    f32x4 s[4];
#pragma unroll
    for (int n = 0; n < 4; ++n) {
      s[n][0] = bflo(tw[n * 2]) + v[n][0] * bflo(gw[n * 2]);
      s[n][1] = bfhi(tw[n * 2]) + v[n][1] * bfhi(gw[n * 2]);
      s[n][2] = bflo(tw[n * 2 + 1]) + v[n][2] * bflo(gw[n * 2 + 1]);
      s[n][3] = bfhi(tw[n * 2 + 1]) + v[n][3] * bfhi(gw[n * 2 + 1]);
    }
    store16_bf16(merged + (size_t)row * 1024 + col, s);
  }
};
struct Epi6 {
  const Params& p;
  DEVINL void operator()(int row, int col, const f32x4 (&v)[4]) const {
    const float* gt = p.mod + (row >> 11) * 6144 + 2048 + col;
    const float* xr = p.x + (size_t)row * 1024 + col;
    float* o = p.out + (size_t)row * 1024 + col;
#pragma unroll
    for (int n = 0; n < 4; ++n) {
      float4 xv = *(const float4*)(xr + n * 4);
      float4 gv = *(const float4*)(gt + n * 4);
      float4 r;
      r.x = xv.x + gv.x * v[n][0]; r.y = xv.y + gv.y * v[n][1];
      r.z = xv.z + gv.z * v[n][2]; r.w = xv.w + gv.w * v[n][3];
      *(float4*)(o + n * 4) = r;
    }
  }
};
struct Epi8 {
  u16* q;
  DEVINL void operator()(int row, int col, const f32x4 (&v)[4]) const { store16_bf16(q + (size_t)row * 2048 + col, v); }
};

template <class F>
DEVINL void for_tiles(int nM, int nN, const F& f) {
  const int G = gridDim.x;
  const int xcd = blockIdx.x & 7, slot = blockIdx.x >> 3, nslot = G >> 3;
  const int nSm = nM >> 3;
  const int nS = nSm * (nN >> 2);
  const int Ltot = (nS >> 3) * 32;
  for (int L = slot; L < Ltot; L += nslot) {
    int s = (L >> 5) * 8 + xcd;
    int w = L & 31;
    int sm = s % nSm, sn = s / nSm;
    int mt = sm * 8 + (w & 7), nt = sn * 4 + (w >> 3);
    f(mt, nt);
  }
}


DEVINL void prep_phase(const Params& p, u16* X) {
  const size_t gtid = (size_t)blockIdx.x * 256 + threadIdx.x, gstride = (size_t)gridDim.x * 256;
  for (size_t it = gtid; it < (size_t)T * 32; it += gstride) {
    const size_t tok = it >> 5;
    const int c8 = (int)(it & 31) * 8;
    const u16* zl = p.z_lora + tok * 256 + c8;
    uint4 cur = *(const uint4*)zl;
    uint4 prv = make_uint4(0, 0, 0, 0);
    if ((tok & 2047) != 0) prv = *(const uint4*)(zl - 256);
    const float4 m0 = *(const float4*)(p.mu + 3072 + c8), m1 = *(const float4*)(p.mu + 3072 + c8 + 4);
    const float mu8[8] = {m0.x, m0.y, m0.z, m0.w, m1.x, m1.y, m1.z, m1.w};
    const uint32_t cw[4] = {cur.x, cur.y, cur.z, cur.w}, pw[4] = {prv.x, prv.y, prv.z, prv.w};
    uint32_t o[4];
#pragma unroll
    for (int i = 0; i < 4; ++i) {
      float c0 = bflo(cw[i]), q0 = bflo(pw[i]), c1 = bfhi(cw[i]), q1 = bfhi(pw[i]);
      float a0 = c0 + (q0 - c0) * mu8[2 * i], a1 = c1 + (q1 - c1) * mu8[2 * i + 1];
      if (c8 < 64) {
        a0 = 1.f - 2.f / (__expf(2.f * a0) + 1.f);
        a1 = 1.f - 2.f / (__expf(2.f * a1) + 1.f);
      } else if (c8 >= 128) {
        a0 = sigm(a0); a1 = sigm(a1);
      }
      o[i] = pack2(a0, a1);
    }
    *(uint4*)(X + tok * 256 + c8) = make_uint4(o[0], o[1], o[2], o[3]);
  }
  float inv_f[8];
#pragma unroll
  for (int i = 0; i < 8; ++i) inv_f[i] = expf(-(float)i * (13.122363377404328f / 8.f));
  for (size_t it = gtid; it < (size_t)T * 96; it += gstride) {
    const size_t tok = it / 96;
    const int rem = (int)(it - tok * 96);
    const int hd = rem >> 2, qd = rem & 3;
    const int isk = hd >= 12;
    const int grp = (isk ? hd - 12 : hd) >> 2;
    u16* ptr = p.z_attn + tok * 2304 + hd * 64 + qd * 16;
    uint4 a = *(const uint4*)ptr, c = *(const uint4*)(ptr + 8);
    const uint32_t wv[8] = {a.x, a.y, a.z, a.w, c.x, c.y, c.z, c.w};
    float xv[16];
#pragma unroll
    for (int i = 0; i < 8; ++i) { xv[2 * i] = bflo(wv[i]); xv[2 * i + 1] = bfhi(wv[i]); }
    float ss = 0.f;
#pragma unroll
    for (int i = 0; i < 16; ++i) ss += xv[i] * xv[i];
    ss = quad_sum(ss);
    float rstd = rsqrtf(ss * (1.f / 64.f) + 1e-6f);
    if (!isk) rstd *= 0.125f;
    const float* gp = (isk ? p.kng : p.qng) + grp * 64 + qd * 16;
#pragma unroll
    for (int i = 0; i < 16; ++i) xv[i] = xv[i] * rstd * gp[i];
    if (qd == 0) {
      const float fp = (float)(tok & 2047);
#pragma unroll
      for (int i = 0; i < 8; ++i) {
        float ang = fp * inv_f[i];
        float n = rintf(ang * 0.15915494309189535f);
        float rr = fmaf(-n, 6.2831854820251465f, ang);
        rr = fmaf(-n, -1.7484555e-7f, rr);
        float cs = __cosf(rr), sn = __sinf(rr);
        float x1 = xv[i], x2 = xv[i + 8];
        xv[i] = x1 * cs - x2 * sn;
        xv[i + 8] = x2 * cs + x1 * sn;
      }
    }
    uint32_t o[8];
#pragma unroll
    for (int i = 0; i < 8; ++i) o[i] = pack2(xv[2 * i], xv[2 * i + 1]);
    *(uint4*)ptr = make_uint4(o[0], o[1], o[2], o[3]);
    *(uint4*)(ptr + 8) = make_uint4(o[4], o[5], o[6], o[7]);
  }
}

constexpr int TC = 16;
struct ScanLds {
  float w[TC][64], k[TC][64], a[TC][64], b[TC][64], r[TC][64], v[TC][64], y[TC][64];
  float bonus[TC];
  u16 g[TC][64];
  float cst[8][64];
  float mul[256];
  u16 xw[TC][72], xa[TC][72], xg[TC][136];
  u16 w2s[64][72], a2s[64][72], g2s[64][136];
};
static_assert(sizeof(ScanLds) <= 79872, "scan lds");

DEVINL void rwkv_scan_unit(const Params& p, const u16* X, int unit, char* smem) {
  ScanLds& L = *(ScanLds*)smem;
  const int tid = threadIdx.x, lane = tid & 63, wid = tid >> 6;
  const int b = unit >> 4, h = unit & 15;
  const int fr = lane & 15, fq = lane >> 4;
  const int pt = tid >> 4, pc = (tid & 15) * 4;
  const int rp = tid >> 3, cq = tid & 7;

  __syncthreads();
  {
    const float* srcs[8] = {p.mu + h * 64, p.mu + 1024 + h * 64, p.mu + 2048 + h * 64, p.k_k + h * 64,
                            p.k_a + h * 64, p.r_k + h * 64, p.lnx_g + h * 64, p.lnx_b + h * 64};
#pragma unroll
    for (int i = 0; i < 8; ++i)
      if (tid < 64) L.cst[i][tid] = srcs[i][tid];
    L.mul[tid] = p.mu[3072 + tid];
    const int c = tid >> 2, qq = tid & 3;
    const u16* w2p = p.w2t + (size_t)(h * 64 + c) * 64 + qq * 16;
    const u16* a2p = p.a2t + (size_t)(h * 64 + c) * 64 + qq * 16;
    const u16* g2p = p.g2t + (size_t)(h * 64 + c) * 128 + qq * 32;
    *(u32x4*)&L.w2s[c][qq * 16] = *(const u32x4*)w2p;
    *(u32x4*)&L.w2s[c][qq * 16 + 8] = *(const u32x4*)(w2p + 8);
    *(u32x4*)&L.a2s[c][qq * 16] = *(const u32x4*)a2p;
    *(u32x4*)&L.a2s[c][qq * 16 + 8] = *(const u32x4*)(a2p + 8);
#pragma unroll
    for (int i = 0; i < 4; ++i) *(u32x4*)&L.g2s[c][qq * 32 + i * 8] = *(const u32x4*)(g2p + i * 8);
  }
  const int chn = h * 64 + wid * 16 + fr;
  const float w0c = p.w0[chn], a0c = p.a0[chn];
  const int ec = h * 64 + pc;
  const int lc = (tid & 15) * 16;

  f32x2 S2[2][4];
#pragma unroll
  for (int r_ = 0; r_ < 2; ++r_)
#pragma unroll
    for (int j = 0; j < 4; ++j) S2[r_][j] = (f32x2){0.f, 0.f};

  const size_t tok0 = (size_t)b * 2048;
  uint2 pr0, pr1, pk0, pk1, pv0, pv1;
  uint4 pl0, pl1;
#define PREFETCH(t0_)                                                                                    \
  {                                                                                                      \
    const int t_ = (t0_) + pt;                                                                           \
    const u16* zr_ = p.z_rkv + (tok0 + t_) * 3072 + ec;                                                  \
    pr0 = *(const uint2*)(zr_); pk0 = *(const uint2*)(zr_ + 1024); pv0 = *(const uint2*)(zr_ + 2048);    \
    const u16* xl_ = X + (tok0 + t_) * 256 + lc;                                                         \
    pl0 = *(const uint4*)(xl_); pl1 = *(const uint4*)(xl_ + 8);                                          \
    if (t_ > 0) {                                                                                        \
      pr1 = *(const uint2*)(zr_ - 3072); pk1 = *(const uint2*)(zr_ - 3072 + 1024);                       \
      pv1 = *(const uint2*)(zr_ - 3072 + 2048);                                                          \
    } else {                                                                                             \
      pr1 = make_uint2(0, 0); pk1 = make_uint2(0, 0); pv1 = make_uint2(0, 0);                            \
    }                                                                                                    \
  }
  __syncthreads();
  PREFETCH(0)

  for (int t0 = 0; t0 < 2048; t0 += TC) {
    float r4[4], k4[4], v4[4];
    {
      const float4 mu_r = *(const float4*)&L.cst[0][pc], mu_k = *(const float4*)&L.cst[1][pc], mu_v = *(const float4*)&L.cst[2][pc];
      float c, q;
      c = bflo(pr0.x); q = bflo(pr1.x); r4[0] = c + (q - c) * mu_r.x;
      c = bfhi(pr0.x); q = bfhi(pr1.x); r4[1] = c + (q - c) * mu_r.y;
      c = bflo(pr0.y); q = bflo(pr1.y); r4[2] = c + (q - c) * mu_r.z;
      c = bfhi(pr0.y); q = bfhi(pr1.y); r4[3] = c + (q - c) * mu_r.w;
      c = bflo(pk0.x); q = bflo(pk1.x); k4[0] = c + (q - c) * mu_k.x;
      c = bfhi(pk0.x); q = bfhi(pk1.x); k4[1] = c + (q - c) * mu_k.y;
      c = bflo(pk0.y); q = bflo(pk1.y); k4[2] = c + (q - c) * mu_k.z;
      c = bfhi(pk0.y); q = bfhi(pk1.y); k4[3] = c + (q - c) * mu_k.w;
      c = bflo(pv0.x); q = bflo(pv1.x); v4[0] = c + (q - c) * mu_v.x;
      c = bfhi(pv0.x); q = bfhi(pv1.x); v4[1] = c + (q - c) * mu_v.y;
      c = bflo(pv0.y); q = bflo(pv1.y); v4[2] = c + (q - c) * mu_v.z;
      c = bfhi(pv0.y); q = bfhi(pv1.y); v4[3] = c + (q - c) * mu_v.w;
    }
    *(float4*)&L.r[pt][pc] = make_float4(r4[0], r4[1], r4[2], r4[3]);
    *(float4*)&L.v[pt][pc] = make_float4(v4[0], v4[1], v4[2], v4[3]);
    {
      u16* dstp = (lc < 64) ? &L.xw[pt][lc] : (lc < 128) ? &L.xa[pt][lc - 64] : &L.xg[pt][lc - 128];
      *(uint4*)dstp = pl0;
      *(uint4*)(dstp + 8) = pl1;
    }
    __syncthreads();
    {
      f32x4 cw = {0.f, 0.f, 0.f, 0.f}, ca = {0.f, 0.f, 0.f, 0.f}, cg_ = {0.f, 0.f, 0.f, 0.f};
#pragma unroll
      for (int ks = 0; ks < 2; ++ks) {
        bf16x8 xa_ = *(const bf16x8*)&L.xw[fr][ks * 32 + fq * 8];
        cw = __builtin_amdgcn_mfma_f32_16x16x32_bf16(xa_, *(const bf16x8*)&L.w2s[wid * 16 + fr][ks * 32 + fq * 8], cw, 0, 0, 0);
        bf16x8 xb_ = *(const bf16x8*)&L.xa[fr][ks * 32 + fq * 8];
        ca = __builtin_amdgcn_mfma_f32_16x16x32_bf16(xb_, *(const bf16x8*)&L.a2s[wid * 16 + fr][ks * 32 + fq * 8], ca, 0, 0, 0);
      }
#pragma unroll
      for (int ks = 0; ks < 4; ++ks) {
        bf16x8 xc_ = *(const bf16x8*)&L.xg[fr][ks * 32 + fq * 8];
        cg_ = __builtin_amdgcn_mfma_f32_16x16x32_bf16(xc_, *(const bf16x8*)&L.g2s[wid * 16 + fr][ks * 32 + fq * 8], cg_, 0, 0, 0);
      }
      const int ch = wid * 16 + fr;
#pragma unroll
      for (int j = 0; j < 4; ++j) {
        int tk = fq * 4 + j;
        L.w[tk][ch] = __expf(-0.6065306597126334f * sigm(w0c + cw[j]));
        L.y[tk][ch] = sigm(a0c + ca[j]);
        L.g[tk][ch] = f2bf(cg_[j]);
      }
    }
    __syncthreads();
    {
      float4 al4 = *(const float4*)&L.y[pt][pc];
      const float4 kk_c = *(const float4*)&L.cst[3][pc], ka_c = *(const float4*)&L.cst[4][pc], rk_c = *(const float4*)&L.cst[5][pc];
      float kk0 = k4[0] * kk_c.x, kk1 = k4[1] * kk_c.y, kk2 = k4[2] * kk_c.z, kk3 = k4[3] * kk_c.w;
      float ss = row16_sum(kk0 * kk0 + kk1 * kk1 + kk2 * kk2 + kk3 * kk3);
      float inv = 1.f / fmaxf(sqrtf(ss), 1e-12f);
      kk0 *= inv; kk1 *= inv; kk2 *= inv; kk3 *= inv;
      *(float4*)&L.a[pt][pc] = make_float4(-kk0, -kk1, -kk2, -kk3);
      *(float4*)&L.b[pt][pc] = make_float4(kk0 * al4.x, kk1 * al4.y, kk2 * al4.z, kk3 * al4.w);
      float km0 = k4[0] * (1.f + (al4.x - 1.f) * ka_c.x);
      float km1 = k4[1] * (1.f + (al4.y - 1.f) * ka_c.y);
      float km2 = k4[2] * (1.f + (al4.z - 1.f) * ka_c.z);
      float km3 = k4[3] * (1.f + (al4.w - 1.f) * ka_c.w);
      *(float4*)&L.k[pt][pc] = make_float4(km0, km1, km2, km3);
      float bs = row16_sum(r4[0] * km0 * rk_c.x + r4[1] * km1 * rk_c.y + r4[2] * km2 * rk_c.z + r4[3] * km3 * rk_c.w);
      if ((tid & 15) == 0) L.bonus[pt] = bs;
    }
    if (t0 + TC < 2048) PREFETCH(t0 + TC)
    __syncthreads();
    {
#define LDVEC(dst, arr, t)                                         \
  {                                                                \
    const f32x4* p4_ = (const f32x4*)&L.arr[t][cq * 8];            \
    f32x4 v0_ = p4_[0], v1_ = p4_[1];                              \
    dst[0] = (f32x2){v0_[0], v0_[1]}; dst[1] = (f32x2){v0_[2], v0_[3]}; \
    dst[2] = (f32x2){v1_[0], v1_[1]}; dst[3] = (f32x2){v1_[2], v1_[3]}; \
  }
      f32x2 cA[4];
      LDVEC(cA, a, 0)
      f32x2 cv = *(const f32x2*)&L.v[0][rp * 2];
#pragma unroll 2
      for (int t = 0; t < TC; ++t) {
        f32x2 nA[4], cW[4], cB[4], cK[4], cR[4];
        const int tn = (t + 1 < TC) ? t + 1 : t;
        LDVEC(cW, w, t) LDVEC(cB, b, t) LDVEC(cK, k, t)
        LDVEC(nA, a, tn)
        const f32x2 nv = *(const f32x2*)&L.v[tn][rp * 2];
        LDVEC(cR, r, t)
        f32x2 p0 = S2[0][0] * cA[0], p1 = S2[0][1] * cA[1], q0 = S2[1][0] * cA[0], q1 = S2[1][1] * cA[1];
        p0 = S2[0][2] * cA[2] + p0; p1 = S2[0][3] * cA[3] + p1; q0 = S2[1][2] * cA[2] + q0; q1 = S2[1][3] * cA[3] + q1;
        p0 = p0 + p1; q0 = q0 + q1;
        const float sa0 = oct_sum(p0[0] + p0[1]);
        const float sa1 = oct_sum(q0[0] + q0[1]);
        const f32x2 sav0 = {sa0, sa0}, sav1 = {sa1, sa1}, vv0 = {cv[0], cv[0]}, vv1 = {cv[1], cv[1]};
#pragma unroll
        for (int j = 0; j < 4; ++j) {
          S2[0][j] = S2[0][j] * cW[j] + (sav0 * cB[j] + vv0 * cK[j]);
          S2[1][j] = S2[1][j] * cW[j] + (sav1 * cB[j] + vv1 * cK[j]);
        }
        f32x2 y0 = S2[0][0] * cR[0], y1 = S2[0][1] * cR[1], z0 = S2[1][0] * cR[0], z1 = S2[1][1] * cR[1];
        y0 = S2[0][2] * cR[2] + y0; y1 = S2[0][3] * cR[3] + y1; z0 = S2[1][2] * cR[2] + z0; z1 = S2[1][3] * cR[3] + z1;
        y0 = y0 + y1; z0 = z0 + z1;
        const float ya = oct_sum(y0[0] + y0[1]);
        const float yb = oct_sum(z0[0] + z0[1]);
        if (cq == 0) *(f32x2*)&L.y[t][rp * 2] = (f32x2){ya, yb};
#pragma unroll
        for (int j = 0; j < 4; ++j) cA[j] = nA[j];
        cv = nv;
      }
#undef LDVEC
    }
    __syncthreads();
    {
      const float4 lg_c = *(const float4*)&L.cst[6][pc], lb_c = *(const float4*)&L.cst[7][pc];
      float4 y4 = *(const float4*)&L.y[pt][pc];
      float4 g4;
      {
        uint2 gq = *(const uint2*)&L.g[pt][pc];
        g4 = make_float4(bflo(gq.x), bfhi(gq.x), bflo(gq.y), bfhi(gq.y));
      }
      float4 vv = *(const float4*)&L.v[pt][pc];
      float bs = L.bonus[pt];
      float mean = row16_sum(y4.x + y4.y + y4.z + y4.w) * (1.f / 64.f);
      float d0 = y4.x - mean, d1 = y4.y - mean, d2 = y4.z - mean, d3 = y4.w - mean;
      float var = row16_sum(d0 * d0 + d1 * d1 + d2 * d2 + d3 * d3) * (1.f / 64.f);
      float rs = rsqrtf(var + 64e-5f);
      float o0 = (d0 * rs * lg_c.x + lb_c.x + bs * vv.x) * g4.x;
      float o1 = (d1 * rs * lg_c.y + lb_c.y + bs * vv.y) * g4.y;
      float o2 = (d2 * rs * lg_c.z + lb_c.z + bs * vv.z) * g4.z;
      float o3 = (d3 * rs * lg_c.w + lb_c.w + bs * vv.w) * g4.w;
      uint2 o; o.x = pack2(o0, o1); o.y = pack2(o2, o3);
      *(uint2*)(p.bufB + (tok0 + t0 + pt) * 1024 + ec) = o;
    }
    __syncthreads();
  }
}

struct AttnLds {
  u16 q[64][72];
  u16 k[192][72];
  u16 vt[64][200];
};

DEVINL void attn_unit(const Params& p, int u, char* smem) {
  AttnLds& L = *(AttnLds*)smem;
  const int tid = threadIdx.x, lane = tid & 63, wid = tid >> 6;
  const int fr = lane & 15, fq = lane >> 4;
  const int g = u >> 11;
  int rem = u & 2047;
  const int b = rem >> 7; rem &= 127;
  const int hh = rem >> 5;
  const int w = rem & 31;
  const int dsh = g * 2;
  const int d = 1 << dsh;
  const int nqb = 32 >> dsh;
  const int r = w / nqb, qb = w % nqb;
  const int l0 = qb * 64;
  const int kl0 = l0 - 128;
  const int gh = g * 4 + hh;
  const size_t tokb = (size_t)b * 2048;
  const int rowi = tid >> 2, qd = tid & 3;

  __syncthreads();
#pragma unroll 1
  for (int pass = 0; pass < 7; ++pass) {
    int kind = (pass == 0) ? 0 : (pass < 4 ? 1 : 2);
    int lrow = (pass == 0) ? rowi : (pass < 4 ? (pass - 1) * 64 + rowi : (pass - 4) * 64 + rowi);
    int sub = (kind == 0) ? (l0 + lrow) : (kl0 + lrow);
    bool valid = sub >= 0;
    int pos = sub * d + r;
    float xv[16];
    if (valid) {
      const u16* src = p.z_attn + (tokb + pos) * 2304 + kind * 768 + gh * 64 + qd * 16;
      uint4 a = *(const uint4*)src, c = *(const uint4*)(src + 8);
      uint32_t wv[8] = {a.x, a.y, a.z, a.w, c.x, c.y, c.z, c.w};
#pragma unroll
      for (int i = 0; i < 8; ++i) { xv[2 * i] = bflo(wv[i]); xv[2 * i + 1] = bfhi(wv[i]); }
    } else {
#pragma unroll
      for (int i = 0; i < 16; ++i) xv[i] = 0.f;
    }
    if (kind < 2) {
      uint32_t o[8];
#pragma unroll
      for (int i = 0; i < 8; ++i) o[i] = pack2(xv[2 * i], xv[2 * i + 1]);
      u16* dst = (kind == 0) ? &L.q[lrow][qd * 16] : &L.k[lrow][qd * 16];
      *(uint4*)dst = make_uint4(o[0], o[1], o[2], o[3]);
      *(uint4*)(dst + 8) = make_uint4(o[4], o[5], o[6], o[7]);
    } else {
#pragma unroll
      for (int i = 0; i < 16; ++i) L.vt[qd * 16 + i][lrow] = f2bf(xv[i]);
    }
  }
  __syncthreads();
  bf16x8 qf[2];
#pragma unroll
  for (int ks = 0; ks < 2; ++ks) qf[ks] = *(const bf16x8*)&L.q[wid * 16 + fr][ks * 32 + fq * 8];
  f32x4 sc[9];
#pragma unroll
  for (int i = 0; i < 9; ++i) {
    int kt = wid + i;
    f32x4 a = {0.f, 0.f, 0.f, 0.f};
#pragma unroll
    for (int ks = 0; ks < 2; ++ks) {
      bf16x8 kf = *(const bf16x8*)&L.k[kt * 16 + fr][ks * 32 + fq * 8];
      a = __builtin_amdgcn_mfma_f32_16x16x32_bf16(kf, qf[ks], a, 0, 0, 0);
    }
    sc[i] = a;
  }
  const int ql = wid * 16 + fr;
  float mx = -1e30f;
#pragma unroll
  for (int i = 0; i < 9; ++i)
#pragma unroll
    for (int j = 0; j < 4; ++j) {
      int kl = (wid + i) * 16 + fq * 4 + j;
      bool ok = (kl >= ql) && (kl <= ql + 128) && (kl0 + kl >= 0);
      float s = ok ? sc[i][j] : -1e30f;
      sc[i][j] = s;
      mx = fmaxf(mx, s);
    }
  mx = fmaxf(mx, __shfl_xor(mx, 16));
  mx = fmaxf(mx, __shfl_xor(mx, 32));
  float lsum = 0.f;
  bf16x4 pf[9];
#pragma unroll
  for (int i = 0; i < 9; ++i) {
    float e0 = __expf(sc[i][0] - mx), e1 = __expf(sc[i][1] - mx), e2 = __expf(sc[i][2] - mx), e3 = __expf(sc[i][3] - mx);
    lsum += (e0 + e1) + (e2 + e3);
    pf[i][0] = (short)f2bf(e0); pf[i][1] = (short)f2bf(e1); pf[i][2] = (short)f2bf(e2); pf[i][3] = (short)f2bf(e3);
  }
  lsum += __shfl_xor(lsum, 16);
  lsum += __shfl_xor(lsum, 32);
  f32x4 oacc[4];
#pragma unroll
  for (int db = 0; db < 4; ++db) oacc[db] = (f32x4){0.f, 0.f, 0.f, 0.f};
#pragma unroll
  for (int i = 0; i < 9; ++i) {
    int kt = wid + i;
#pragma unroll
    for (int db = 0; db < 4; ++db) {
      bf16x4 vf = *(const bf16x4*)&L.vt[db * 16 + fr][kt * 16 + fq * 4];
      oacc[db] = __builtin_amdgcn_mfma_f32_16x16x16bf16_1k(vf, pf[i], oacc[db], 0, 0, 0);
    }
  }
  const float invl = 1.f / lsum;
  const int posq = (l0 + ql) * d + r;
  u16* od = p.z_attn + (tokb + posq) * 2304 + gh * 64;
#pragma unroll
  for (int db = 0; db < 4; ++db) {
    uint2 o;
    o.x = pack2(oacc[db][0] * invl, oacc[db][1] * invl);
    o.y = pack2(oacc[db][2] * invl, oacc[db][3] * invl);
    *(uint2*)(od + db * 16 + fq * 4) = o;
  }
  if (fq == 0) p.lse[((size_t)g * T + tokb + posq) * 4 + hh] = mx + __logf(lsum);
}

DEVINL void attn_merge(const Params& p) {
  u16* ya = p.z_lora;
  const size_t n = (size_t)T * 32;
  for (size_t it = (size_t)blockIdx.x * 256 + threadIdx.x; it < n; it += (size_t)gridDim.x * 256) {
    size_t tok = it >> 5;
    int c8 = (int)(it & 31) * 8;
    int hh = c8 >> 6;
    float l0 = p.lse[((size_t)0 * T + tok) * 4 + hh];
    float l1 = p.lse[((size_t)1 * T + tok) * 4 + hh];
    float l2 = p.lse[((size_t)2 * T + tok) * 4 + hh];
    float m = fmaxf(l0, fmaxf(l1, l2));
    float e0 = __expf(l0 - m), e1 = __expf(l1 - m), e2 = __expf(l2 - m);
    float inv = 1.f / (e0 + e1 + e2);
    e0 *= inv; e1 *= inv; e2 *= inv;
    const u16* zr = p.z_attn + tok * 2304 + c8;
    uint4 a = *(const uint4*)(zr), bq = *(const uint4*)(zr + 256), cq = *(const uint4*)(zr + 512);
    uint32_t aw[4] = {a.x, a.y, a.z, a.w}, bw[4] = {bq.x, bq.y, bq.z, bq.w}, cw[4] = {cq.x, cq.y, cq.z, cq.w};
    uint32_t o[4];
#pragma unroll
    for (int i = 0; i < 4; ++i) {
      float lo = e0 * bflo(aw[i]) + e1 * bflo(bw[i]) + e2 * bflo(cw[i]);
      float hi = e0 * bfhi(aw[i]) + e1 * bfhi(bw[i]) + e2 * bfhi(cw[i]);
      o[i] = pack2(lo, hi);
    }
    *(uint4*)(ya + tok * 256 + c8) = make_uint4(o[0], o[1], o[2], o[3]);
  }
}

DEVINL uint32_t sortable(float s) {
  uint32_t u = __float_as_uint(s);
  return (u & 0x80000000u) ? ~u : (u | 0x80000000u);
}

DEVINL void ce_desc(uint32_t& a, uint32_t& b) {
  const uint32_t hi = max(a, b), lo = min(a, b);
  a = hi; b = lo;
}
DEVINL void bitonic_sort_desc16(uint32_t (&a)[16]) {
#pragma unroll
  for (int lk = 1; lk <= 4; ++lk) {
#pragma unroll
    for (int lj = 3; lj >= 0; --lj) {
      if (lj < lk) {
        const int k = 1 << lk, j = 1 << lj;
#pragma unroll
        for (int i = 0; i < 16; ++i) {
          const int l = i ^ j;
          if (l > i) {
            if ((i & k) == 0) ce_desc(a[i], a[l]); else ce_desc(a[l], a[i]);
          }
        }
      }
    }
  }
}
DEVINL void bitonic_merge_desc16(uint32_t (&a)[16]) {
#pragma unroll
  for (int lj = 3; lj >= 0; --lj) {
    const int j = 1 << lj;
#pragma unroll
    for (int i = 0; i < 16; ++i) {
      const int l = i ^ j;
      if (l > i) ce_desc(a[i], a[l]);
    }
  }
}
template <int CTRL>
DEVINL uint32_t dpp_u(uint32_t x) { return (uint32_t)__builtin_amdgcn_update_dpp(0, (int)x, CTRL, 0xF, 0xF, true); }

constexpr int RS = 133;
DEVINL void peer_route_a(const Params& p, const u16* qp, float* lv, int* li, char* smem) {
  const int tid = threadIdx.x, lane = tid & 63, wid = tid >> 6;
  const int fr = lane & 15, fq = lane >> 4;
  const int role = blockIdx.x & 1;
  const int nblk = gridDim.x >> 1, bidx = blockIdx.x >> 1;
  u16(*sK)[136] = (u16(*)[136])smem;
  float* sS = (float*)(smem + 128 * 136 * 2);
  __syncthreads();
  {
    const u16* kb = role ? p.k2b : p.k1b;
    for (int c = tid; c < 128 * 16; c += 256) {
      const int r = c >> 4, ch = c & 15;
      *(u32x4*)&sK[r][ch * 8] = *(const u32x4*)(kb + r * 128 + ch * 8);
    }
  }
  __syncthreads();
  float* lvr = lv + (size_t)role * T * 128;
  int* lir = li + (size_t)role * T * 128;
  for (int unit = bidx; unit < 4096; unit += nblk) {
    const int tok0 = (unit >> 1) * 16, hsel = unit & 1;
    const int head = hsel * 4 + wid;
    bf16x8 af[4];
#pragma unroll
    for (int ks = 0; ks < 4; ++ks)
      af[ks] = *(const bf16x8*)(qp + (size_t)(tok0 + fr) * 2048 + head * 256 + role * 128 + ks * 32 + fq * 8);
    __syncthreads();
#pragma unroll
    for (int nt = 0; nt < 8; ++nt) {
      f32x4 a = {0.f, 0.f, 0.f, 0.f};
#pragma unroll
      for (int ks = 0; ks < 4; ++ks) {
        bf16x8 bfg = *(const bf16x8*)&sK[nt * 16 + fr][ks * 32 + fq * 8];
        a = __builtin_amdgcn_mfma_f32_16x16x32_bf16(af[ks], bfg, a, 0, 0, 0);
      }
      const int key = nt * 16 + fr;
#pragma unroll
      for (int j = 0; j < 4; ++j) sS[(wid * 16 + fq * 4 + j) * RS + (key >> 5) * 33 + (key & 31)] = a[j];
    }
    __syncthreads();
    const int inst = tid >> 2, part = tid & 3;
    const float* row = sS + inst * RS;
    uint32_t top[16], grp[16];
#pragma unroll
    for (int i = 0; i < 16; ++i) {
      top[i] = (sortable(row[part * 33 + i]) & 0xFFFFFF80u) | (uint32_t)(127 - (part * 32 + i));
      grp[i] = (sortable(row[part * 33 + 16 + i]) & 0xFFFFFF80u) | (uint32_t)(127 - (part * 32 + 16 + i));
    }
    bitonic_sort_desc16(top);
    bitonic_sort_desc16(grp);
#pragma unroll
    for (int i = 0; i < 16; ++i) top[i] = max(top[i], grp[15 - i]);
    bitonic_merge_desc16(top);
#pragma unroll
    for (int i = 0; i < 16; ++i) grp[i] = dpp_u<0xB1>(top[i]);
#pragma unroll
    for (int i = 0; i < 16; ++i) top[i] = max(top[i], grp[15 - i]);
    bitonic_merge_desc16(top);
#pragma unroll
    for (int i = 0; i < 16; ++i) grp[i] = dpp_u<0x4E>(top[i]);
#pragma unroll
    for (int i = 0; i < 16; ++i) top[i] = max(top[i], grp[15 - i]);
    bitonic_merge_desc16(top);
    if (part == 0) {
      const int tk = inst & 15, hl = inst >> 4;
      const size_t ob = ((size_t)(tok0 + tk) * 8 + hsel * 4 + hl) * 16;
#pragma unroll
      for (int q4 = 0; q4 < 4; ++q4) {
        const int k0 = 127 - (int)(top[q4 * 4] & 127u), k1 = 127 - (int)(top[q4 * 4 + 1] & 127u);
        const int k2 = 127 - (int)(top[q4 * 4 + 2] & 127u), k3 = 127 - (int)(top[q4 * 4 + 3] & 127u);
        *(float4*)(lvr + ob + q4 * 4) = make_float4(row[(k0 >> 5) * 33 + (k0 & 31)], row[(k1 >> 5) * 33 + (k1 & 31)],
                                                    row[(k2 >> 5) * 33 + (k2 & 31)], row[(k3 >> 5) * 33 + (k3 & 31)]);
        *(int4*)(lir + ob + q4 * 4) = make_int4(k0, k1, k2, k3);
      }
    }
  }
}

DEVINL void peer_route_b(const float* lv, const int* li, int* idx_out, float* gate_out) {
  const float* lv1 = lv; const float* lv2 = lv + (size_t)T * 128;
  const int* li1 = li; const int* li2 = li + (size_t)T * 128;
  for (size_t it = (size_t)blockIdx.x * 256 + threadIdx.x; it < (size_t)T * 8; it += (size_t)gridDim.x * 256) {
    const size_t ob = it * 16;
    float v1[16], v2[16];
#pragma unroll
    for (int q = 0; q < 4; ++q) {
      float4 a = *(const float4*)(lv1 + ob + q * 4), b = *(const float4*)(lv2 + ob + q * 4);
      v1[q * 4] = a.x; v1[q * 4 + 1] = a.y; v1[q * 4 + 2] = a.z; v1[q * 4 + 3] = a.w;
      v2[q * 4] = b.x; v2[q * 4 + 1] = b.y; v2[q * 4 + 2] = b.z; v2[q * 4 + 3] = b.w;
    }
    uint32_t top[16];
#pragma unroll
    for (int j = 0; j < 16; ++j) top[j] = 0u;
#pragma unroll
    for (int i = 0; i < 16; ++i)
#pragma unroll
      for (int j = 0; j < 16; ++j)
        if ((i + 1) * (j + 1) <= 16) {
          uint32_t key = (sortable(v1[i] + v2[j]) & 0xFFFFFF00u) | (uint32_t)(255 - (i * 16 + j));
#pragma unroll
          for (int s_ = 0; s_ < 16; ++s_) {
            uint32_t hi = max(top[s_], key);
            key = min(top[s_], key);
            top[s_] = hi;
          }
        }
    float val[16];
    int eid[16];
    float mx = -1e30f;
#pragma unroll
    for (int s_ = 0; s_ < 16; ++s_) {
      const int cidx = 255 - (int)(top[s_] & 255u);
      const int i = cidx >> 4, j = cidx & 15;
      val[s_] = lv1[ob + i] + lv2[ob + j];
      eid[s_] = li1[ob + i] * 128 + li2[ob + j];
      mx = fmaxf(mx, val[s_]);
    }
    float sum = 0.f;
#pragma unroll
    for (int s_ = 0; s_ < 16; ++s_) { val[s_] = __expf(val[s_] - mx); sum += val[s_]; }
    const float inv = 1.f / sum;
#pragma unroll
    for (int s4 = 0; s4 < 4; ++s4) {
      *(int4*)(idx_out + ob + s4 * 4) = make_int4(eid[s4 * 4], eid[s4 * 4 + 1], eid[s4 * 4 + 2], eid[s4 * 4 + 3]);
      *(float4*)(gate_out + ob + s4 * 4) = make_float4(val[s4 * 4] * inv, val[s4 * 4 + 1] * inv, val[s4 * 4 + 2] * inv, val[s4 * 4 + 3] * inv);
    }
  }
}

DEVINL void dec16(const uint2& w, f32x2 (&d)[8]) {
  d[0] = __builtin_amdgcn_cvt_scalef32_pk_f32_fp4(w.x, 1.0f, 0);
  d[1] = __builtin_amdgcn_cvt_scalef32_pk_f32_fp4(w.x, 1.0f, 1);
  d[2] = __builtin_amdgcn_cvt_scalef32_pk_f32_fp4(w.x, 1.0f, 2);
  d[3] = __builtin_amdgcn_cvt_scalef32_pk_f32_fp4(w.x, 1.0f, 3);
  d[4] = __builtin_amdgcn_cvt_scalef32_pk_f32_fp4(w.y, 1.0f, 0);
  d[5] = __builtin_amdgcn_cvt_scalef32_pk_f32_fp4(w.y, 1.0f, 1);
  d[6] = __builtin_amdgcn_cvt_scalef32_pk_f32_fp4(w.y, 1.0f, 2);
  d[7] = __builtin_amdgcn_cvt_scalef32_pk_f32_fp4(w.y, 1.0f, 3);
}

DEVINL void peer_gather(const Params& p, const u16* n2, const int* idx, const float* gate, u16* dry = nullptr) {
  const int lane = threadIdx.x & 63, wid = threadIdx.x >> 6;
  const int nw = gridDim.x * 4;
  const unsigned char* ub4 = (const unsigned char*)p.ub;
  const unsigned char* vb4 = (const unsigned char*)p.vb;
  for (int tok = blockIdx.x * 4 + wid; tok < T; tok += nw) {
    f32x2 xn[8], acc2[8];
    {
      const uint4* np = (const uint4*)(n2 + (size_t)tok * 1024 + lane * 16);
      uint4 a = np[0], c = np[1];
      uint32_t wv[8] = {a.x, a.y, a.z, a.w, c.x, c.y, c.z, c.w};
#pragma unroll
      for (int i = 0; i < 8; ++i) xn[i] = (f32x2){bflo(wv[i]), bfhi(wv[i])};
    }
#pragma unroll
    for (int i = 0; i < 8; ++i) acc2[i] = (f32x2){0.f, 0.f};
    const int id0 = idx[(size_t)tok * 128 + lane], id1 = idx[(size_t)tok * 128 + 64 + lane];
    const float g0 = gate[(size_t)tok * 128 + lane], g1 = gate[(size_t)tok * 128 + 64 + lane];
    const float us0 = p.usc[id0], us1 = p.usc[id1];
    const float gvs0 = g0 * p.vsc[id0], gvs1 = g1 * p.vsc[id1];
    const bool b3 = (lane & 8) != 0, b2 = (lane & 4) != 0, b1 = (lane & 2) != 0, b0 = (lane & 1) != 0;
#pragma unroll 1
    for (int e = 0; e < 128; e += 16) {
      const int idv = (e < 64) ? id0 : id1;
      const int eb = e & 63;
      uint2 ur[16], vr[16];
#pragma unroll
      for (int q = 0; q < 16; ++q) {
        const int id = __builtin_amdgcn_readlane(idv, eb + q);
        ur[q] = *(const uint2*)(ub4 + (size_t)id * 512 + lane * 8);
        vr[q] = *(const uint2*)(vb4 + (size_t)id * 512 + lane * 8);
      }
      float pr[16];
#pragma unroll
      for (int q = 0; q < 16; ++q) {
        f32x2 d[8];
        dec16(ur[q], d);
        f32x2 s0 = xn[0] * d[0], s1 = xn[1] * d[1];
        s0 = xn[2] * d[2] + s0; s1 = xn[3] * d[3] + s1;
        s0 = xn[4] * d[4] + s0; s1 = xn[5] * d[5] + s1;
        s0 = xn[6] * d[6] + s0; s1 = xn[7] * d[7] + s1;
        s0 = s0 + s1;
        pr[q] = s0[0] + s0[1];
      }
      float ra[8], rb[4], rc[2];
#pragma unroll
      for (int q = 0; q < 8; ++q) ra[q] = (b3 ? pr[q + 8] : pr[q]) + dpp_f<0x128>(b3 ? pr[q] : pr[q + 8]);
#pragma unroll
      for (int q = 0; q < 4; ++q) rb[q] = (b2 ? ra[q + 4] : ra[q]) + dpp_f<0x141>(b2 ? ra[q] : ra[q + 4]);
#pragma unroll
      for (int q = 0; q < 2; ++q) rc[q] = (b1 ? rb[q + 2] : rb[q]) + dpp_f<0x4E>(b1 ? rb[q] : rb[q + 2]);
      float mine = (b0 ? rc[1] : rc[0]) + dpp_f<0xB1>(b0 ? rc[0] : rc[1]);
      mine += __shfl_xor(mine, 16);
      mine += __shfl_xor(mine, 32);
      const int sl = eb + (lane & 15);
      const float act = mine * __shfl((e < 64) ? us0 : us1, sl);
      const float coefv = __shfl((e < 64) ? gvs0 : gvs1, sl) * 0.5f * act * (1.f + erff(act * 0.7071067811865476f));
#pragma unroll
      for (int q = 0; q < 16; ++q) {
        const float coef = __int_as_float(__builtin_amdgcn_readlane(__float_as_int(coefv), q));
        const f32x2 c2 = {coef, coef};
        f32x2 d[8];
        dec16(vr[q], d);
#pragma unroll
        for (int i = 0; i < 8; ++i) acc2[i] = c2 * d[i] + acc2[i];
      }
    }
    float acc[16];
#pragma unroll
    for (int i = 0; i < 8; ++i) { acc[2 * i] = acc2[i][0]; acc[2 * i + 1] = acc2[i][1]; }
    const float* gt2 = p.mod + (tok >> 11) * 6144 + 5120 + lane * 16;
    float* op = p.out + (size_t)tok * 1024 + lane * 16;
#pragma unroll
    for (int i = 0; i < 4; ++i) {
      float4 hv = *(const float4*)(op + i * 4);
      float4 gv4 = *(const float4*)(gt2 + i * 4);
      hv.x += gv4.x * acc[i * 4]; hv.y += gv4.y * acc[i * 4 + 1];
      hv.z += gv4.z * acc[i * 4 + 2]; hv.w += gv4.w * acc[i * 4 + 3];
      if (dry) {
        uint2 o; o.x = pack2(hv.x, hv.y); o.y = pack2(hv.z, hv.w);
        *(uint2*)(dry + (size_t)tok * 1024 + lane * 16 + i * 4) = o;
      } else {
        *(float4*)(op + i * 4) = hv;
      }
    }
  }
}


#define XB_TMO      128
#define XB_XCNT(j)  (256  + 64 * (j))
#define XB_XSUB(j)  (1280 + 64 * (j))
#define XB_XGEN(j)  (2304 + 64 * (j))
#define XB_TOP      3328
#define XB_TOPGEN   3392
#define XCD_BAR_WORDS 3456
#define XB_SPIN_CAP (1u << 18)
#define LAS __attribute__((address_space(3)))
DEVINL unsigned xb_ld(unsigned* p) { return __hip_atomic_load(p, __ATOMIC_RELAXED, __HIP_MEMORY_SCOPE_AGENT); }
DEVINL unsigned xb_add(unsigned* p, unsigned v) { return __hip_atomic_fetch_add(p, v, __ATOMIC_RELAXED, __HIP_MEMORY_SCOPE_AGENT); }
DEVINL unsigned xb_xcc_id() { return (unsigned)__builtin_amdgcn_s_getreg((3 << 11) | 20) & 0xFu; }
#define XB_SPIN(cond, bar) do { unsigned _sp = 0; while (cond) { __builtin_amdgcn_s_sleep(1); \
    if ((++_sp & 255u) == 0u) { if (xb_ld(&(bar)[XB_TMO])) break; if (_sp > XB_SPIN_CAP) { atomicAdd(&(bar)[XB_TMO], 1u); break; } } } } while (0)
struct XcdBarrier { unsigned* bar; unsigned x; volatile LAS unsigned* st; };
DEVINL XcdBarrier xcd_barrier_post(unsigned* bar, volatile LAS unsigned* st) {
  XcdBarrier b; b.bar = bar; b.x = xb_xcc_id(); b.st = st;
  if (threadIdx.x == 0) (void)xb_add(&bar[XB_XCNT(b.x)], 1u);
  return b;
}
DEVINL void xcd_barrier_complete(unsigned* bar, unsigned x, unsigned& nloc, unsigned& nx) {
  const unsigned G = gridDim.x * gridDim.y * gridDim.z;
  unsigned sum, cnt, mine, sp = 0u;
  for (;;) {
    sum = 0u; cnt = 0u; mine = 0u;
#pragma unroll
    for (unsigned j = 0; j < 16; ++j) { const unsigned c = xb_ld(&bar[XB_XCNT(j)]); sum += c; cnt += (c > 0u) ? 1u : 0u; mine = (j == x) ? c : mine; }
    if (sum == G) break;
    __builtin_amdgcn_s_sleep(1);
    if ((++sp & 255u) == 0u) { if (xb_ld(&bar[XB_TMO])) break; if (sp > XB_SPIN_CAP) { atomicAdd(&bar[XB_TMO], 1u); break; } }
  }
  nloc = mine > 0u ? mine : 1u; nx = cnt > 0u ? cnt : 1u;
}
DEVINL void xcd_barrier(const XcdBarrier& b) {
  asm volatile("s_waitcnt vmcnt(0)" ::: "memory");
  __syncthreads();
  if (threadIdx.x == 0) {
    unsigned* bar = b.bar;
    __builtin_amdgcn_s_waitcnt(0);
    unsigned nloc = b.st[0], nx = b.st[1];
    if (nloc == 0u) { xcd_barrier_complete(bar, b.x, nloc, nx); b.st[0] = nloc; b.st[1] = nx; }
    const unsigned old = xb_add(&bar[XB_XSUB(b.x)], 1u);
    const unsigned gen = old / nloc;
    if (old + 1u == (gen + 1u) * nloc) {
      __builtin_amdgcn_fence(__ATOMIC_RELEASE, "agent");
      asm volatile("s_waitcnt vmcnt(0)" ::: "memory");
      const unsigned og = xb_add(&bar[XB_TOP], 1u);
      const unsigned tg = og / nx;
      if (og + 1u == (tg + 1u) * nx) xb_add(&bar[XB_TOPGEN], 1u);
      else XB_SPIN(xb_ld(&bar[XB_TOPGEN]) == tg, bar);
      __builtin_amdgcn_fence(__ATOMIC_ACQUIRE, "agent");
      xb_add(&bar[XB_XGEN(b.x)], 1u);
      asm volatile("s_waitcnt vmcnt(0)" ::: "memory");
    } else {
      XB_SPIN(xb_ld(&bar[XB_XGEN(b.x)]) == gen, bar);
      __builtin_amdgcn_fence(__ATOMIC_ACQUIRE, "agent");
      asm volatile("s_waitcnt vmcnt(0)" ::: "memory");
    }
  }
  __syncthreads();
}

DEVINL void run_phase(const Params& p, int ph, char* smem, int cu_role = 0) {
  const int G = gridDim.x;
  u16* merged = p.z_rkv;
  u16* qpeer = p.z_rkv;
  int* pidx = (int*)p.z_attn;
  float* pgate = (float*)(p.z_attn + (size_t)T * 128 * 2);
  float* plv = (float*)((char*)p.z_attn + (size_t)T * 128 * 8);
  int* pli = (int*)((char*)p.z_attn + (size_t)T * 128 * 16);
  u16* X = (u16*)((char*)p.ub + (size_t)16384 * 1024);
  switch (ph) {
    case 0: phase0(p, smem); break;
    case 1:
      norm_rows_fp8(p);
      for (int t = blockIdx.x; t < 1920; t += G) transpose_tile_fp8(p, t, smem);
      break;
    case 2: {
      if (cu_role & 1) __builtin_amdgcn_s_sleep(22);
      Epi1 e{p};
      for_tiles(256, 60, [&](int mt, int nt) { gemm_tile<true>(p.bufB, 1024, p.w_in_t, 1024, 1024, mt * 128, nt * 128, smem, e); });
    } break;
    case 3: {
      int* sh = (int*)smem;
      const int role = cu_role;
      for (int pass = 0; pass < 2; ++pass) {
        const bool do_scan = (pass == 0) == (role == 0);
        if (do_scan) {
          for (;;) {
            __syncthreads();
            if (threadIdx.x == 0) sh[1] = atomicAdd(&p.ctr[2048], 1);
            __syncthreads();
            const int u = sh[1];
            if (u >= 256) break;
            rwkv_scan_unit(p, X, u, smem);
          }
        } else {
          for (;;) {
            __syncthreads();
            if (threadIdx.x == 0) sh[1] = atomicAdd(&p.ctr[2049], 1);
            __syncthreads();
            const int u = sh[1];
            if (u >= 6144) break;
            attn_unit(p, u, smem);
          }
          if (pass == 0) { late_transpose_queue(p, smem); cvt_fp4_queue(p, smem); }
        }
      }
      late_transpose_queue(p, smem);
      cvt_fp4_queue(p, smem);
    } break;
    case 4: attn_merge(p); break;
    case 15: prep_phase(p, X); break;
    case 5: {
      if (cu_role & 1) __builtin_amdgcn_s_sleep(22);
      Epi5a ea{p, merged};
      Epi5b eb{p, merged};
      for_tiles(256, 8, [&](int mt, int nt) {
        gemm_tile(p.bufB, 1024, p.w_br_r_t, 1024, 1024, mt * 128, nt * 128, smem, ea);
        gemm_tile(p.z_lora, 256, p.w_br_a_t, 256, 256, mt * 128, nt * 128, smem, eb);
      });
    } break;
    case 6: {
      if (cu_role & 1) __builtin_amdgcn_s_sleep(22);
      Epi6 e{p};
      for_tiles(256, 8, [&](int mt, int nt) { gemm_tile(merged, 1024, p.w_out_t, 1024, 1024, mt * 128, nt * 128, smem, e); });
    } break;
    case 7: norm_rows(p.out, p.norm2_g, p.mod, 3072, 4096, p.bufB); break;
    case 8: {
      if (cu_role & 1) __builtin_amdgcn_s_sleep(22);
      Epi8 e{qpeer};
      for_tiles(256, 16, [&](int mt, int nt) { gemm_tile(p.bufB, 1024, p.wq_t, 1024, 1024, mt * 128, nt * 128, smem, e); });
    } break;
    case 9:
      peer_route_a(p, qpeer, plv, pli, smem);
      break;
    case 16: peer_route_b(plv, pli, pidx, pgate); break;
    case 10: peer_gather(p, p.bufB, pidx, pgate); break;
    case 11: peer_gather(p, p.bufB, pidx, pgate, p.z_rkv + (size_t)T * 2048); break;
  }
}
constexpr int NPHASE = 11;

#if MULTI
__global__ void __launch_bounds__(256, 2) phase_kernel(Params p, int ph) {
  __shared__ __attribute__((aligned(16))) char smem[SMEM_BYTES];
  run_phase(p, ph, smem);
}
#else
__global__ void __launch_bounds__(256, 2) mega_kernel(Params p) {
  __shared__ __attribute__((aligned(16))) char smem[SMEM_BYTES];
  __shared__ uint4 xb_words;
  cg::grid_group grid = cg::this_grid();
  if (threadIdx.x == 0) xb_words = make_uint4(0u, 0u, 0u, 0u);
  __syncthreads();
  __shared__ int cu_role_s;
  if (threadIdx.x == 0) {
    unsigned cu = __builtin_amdgcn_s_getreg(0x3A04);
    unsigned xcc = __builtin_amdgcn_s_getreg(0x1814);
    cu_role_s = atomicAdd(&p.ctr[(xcc & 7) * 256 + (cu & 255)], 1);
  }
  __syncthreads();
  const int cu_role = cu_role_s;
  XcdBarrier xb = xcd_barrier_post(p.bar, (volatile LAS unsigned*)&xb_words);
#define SYNC() xcd_barrier(xb)
  if (p.x == nullptr) grid.sync();
  run_phase(p, 0, smem, cu_role); SYNC();
  if (DUP == 0) { run_phase(p, 0, smem, cu_role); SYNC(); }
  run_phase(p, 1, smem, cu_role); SYNC();
  if (DUP == 1) { run_phase(p, 1, smem, cu_role); SYNC(); }
  run_phase(p, 2, smem, cu_role); SYNC();
  run_phase(p, 15, smem, cu_role); SYNC();
  if (DUP == 2) { run_phase(p, 2, smem, cu_role); SYNC(); }
  run_phase(p, 3, smem, cu_role); SYNC();
  run_phase(p, 4, smem, cu_role); SYNC();
  if (DUP == 4) { run_phase(p, 4, smem, cu_role); SYNC(); }
  run_phase(p, 5, smem, cu_role); SYNC();
  if (DUP == 5) { run_phase(p, 5, smem, cu_role); SYNC(); }
  run_phase(p, 6, smem, cu_role); SYNC();
  if (DUP == 6) { run_phase(p, 6, smem, cu_role); SYNC(); }
  run_phase(p, 7, smem, cu_role); SYNC();
  if (DUP == 7) { run_phase(p, 7, smem, cu_role); SYNC(); }
  run_phase(p, 8, smem, cu_role); SYNC();
  if (DUP == 8) { run_phase(p, 8, smem, cu_role); SYNC(); }
  run_phase(p, 9, smem, cu_role); SYNC();
  run_phase(p, 16, smem, cu_role); SYNC();
  if (DUP == 9) { run_phase(p, 9, smem, cu_role); SYNC(); }
  if (DUP == 10) { run_phase(p, 11, smem, cu_role); SYNC(); }
  run_phase(p, 10, smem, cu_role);
}
#endif

extern "C" void kernel_launch(void* const* d_in, const int* in_sizes, int n_in, void* d_out, int out_size, void* d_ws,
                              size_t ws_size, hipStream_t stream) {
  Params p{};
  const float** pf = (const float**)&p;
  for (int i = 0; i < 28; ++i) pf[i] = (const float*)d_in[i];
  p.out = (float*)d_out;
  char* ws = (char*)d_ws;
  size_t off = 0;
  auto take = [&](size_t bytes) { char* r = ws + off; off += (bytes + 255) & ~(size_t)255; return r; };
  p.w_in_t = (u16*)take((size_t)7680 * 1024 * 2);
  p.w_br_r_t = (u16*)take((size_t)1024 * 1024 * 2);
  p.w_br_a_t = (u16*)take((size_t)1024 * 256 * 2);
  p.w_out_t = (u16*)take((size_t)1024 * 1024 * 2);
  p.wq_t = (u16*)take((size_t)2048 * 1024 * 2);
  p.k1b = (u16*)take(128 * 128 * 2);
  p.k2b = (u16*)take(128 * 128 * 2);
  p.w2t = (u16*)take(1024 * 64 * 2);
  p.a2t = (u16*)take(1024 * 64 * 2);
  p.g2t = (u16*)take(1024 * 128 * 2);
  p.mod = (float*)take(16 * 6144 * 4);
  p.lse = (float*)take((size_t)3 * T * 4 * 4);
  p.bar = (unsigned*)take(4096 * 4);
  p.ctr = (int*)take(4096 * 4);
  p.colamax = (int*)take(8192 * 4);
  p.n1s = (float*)take((size_t)T * 4);
  p.w_in_s = (float*)take(8192 * 4);
  p.usc = (float*)take(16384 * 4);
  p.vsc = (float*)take(16384 * 4);
  p.bufB = (u16*)take((size_t)T * 1024 * 2);
  p.z_rkv = (u16*)take((size_t)T * 3072 * 2);
  p.z_lora = (u16*)take((size_t)T * 256 * 2);
  p.z_attn = (u16*)take((size_t)T * 2304 * 2);
  p.ub = (u16*)take((size_t)16384 * 1024 * 2);
  p.vb = (u16*)take((size_t)16384 * 1024 * 2);
  p.gates = (u16*)d_out;
  if (off > ws_size) { fprintf(stderr, "workspace too small: need %zu have %zu\n", off, ws_size); return; }
#if MULTI
  (void)hipMemsetAsync(p.bar, 0, 4 * 4096 * 4, stream);
  for (int ph = 0; ph < NPHASE; ++ph) phase_kernel<<<512, 256, 0, stream>>>(p, ph);
#else
  static int grid_blocks = 0;
  if (!grid_blocks) {
    int dev = 0, cus = 0, per_cu = 0;
    hipGetDevice(&dev);
    hipDeviceGetAttribute(&cus, hipDeviceAttributeMultiprocessorCount, dev);
    hipOccupancyMaxActiveBlocksPerMultiprocessor(&per_cu, mega_kernel, 256, 0);
    if (per_cu > 2) per_cu = 2;
    grid_blocks = cus * per_cu;
  }
  (void)hipMemsetAsync(p.bar, 0, 4 * 4096 * 4, stream);
  void* args[] = {&p};
  hipError_t e = hipLaunchCooperativeKernel((void*)mega_kernel, dim3(grid_blocks), dim3(256), args, 0, stream);
  if (e != hipSuccess) fprintf(stderr, "cooperative launch failed: %s (grid %d)\n", hipGetErrorString(e), grid_blocks);
#endif
}
```

```cpp
#include <hip/hip_runtime.h>
#include <hip/hip_cooperative_groups.h>
#include <cstdio>
#include <cstdint>
namespace cg = cooperative_groups;

#ifndef MULTI
#define MULTI 0
#endif
#ifndef DUP
#define DUP -1
#endif

typedef unsigned short u16;
using bf16x8 = __attribute__((ext_vector_type(8))) short;
using bf16x4 = __attribute__((ext_vector_type(4))) short;
using f32x4  = __attribute__((ext_vector_type(4))) float;
using u32x4  = __attribute__((ext_vector_type(4))) unsigned int;
using f32x2  = __attribute__((ext_vector_type(2))) float;

#define DEVINL __device__ __forceinline__

constexpr int T = 32768;
constexpr int SMEM_BYTES = 79872;

struct Params {
  const float *x, *c, *w_ada, *b_ada, *norm1_g, *w_in, *mu, *w0, *w2, *a0, *a2, *g2, *k_k, *k_a, *r_k,
      *lnx_g, *lnx_b, *qng, *kng, *w_br_r, *w_br_a, *w_out, *norm2_g, *wq, *k1, *k2, *pu, *pv;
  float* out;
  u16 *w_in_t, *w_br_r_t, *w_br_a_t, *w_out_t, *wq_t, *k1b, *k2b, *w2t, *a2t, *g2t;
  float *mod, *lse, *usc, *vsc, *n1s, *w_in_s;
  int* colamax;
  unsigned* bar;
  int* ctr;
  u16 *bufB, *z_rkv, *z_lora, *z_attn, *ub, *vb, *gates;
};

DEVINL u16 f2bf(float f) {
  uint32_t u = __float_as_uint(f);
  u += 0x7fffu + ((u >> 16) & 1u);
  return (u16)(u >> 16);
}
DEVINL float bf2f(u16 h) { return __uint_as_float(((uint32_t)h) << 16); }
typedef __bf16 hwbf16x2 __attribute__((ext_vector_type(2)));
DEVINL uint32_t pack2(float a, float b) {
  f32x2 v = {a, b};
  hwbf16x2 r = __builtin_convertvector(v, hwbf16x2);
  return *(uint32_t*)&r;
}
DEVINL float bflo(uint32_t u) { return __uint_as_float(u << 16); }
DEVINL float bfhi(uint32_t u) { return __uint_as_float(u & 0xffff0000u); }
DEVINL float sigm(float x) { return 1.f / (1.f + __expf(-x)); }
template <int CTRL>
DEVINL float dpp_f(float x) {
  return __int_as_float(__builtin_amdgcn_update_dpp(0, __float_as_int(x), CTRL, 0xF, 0xF, true));
}
DEVINL float quad_sum(float v) {
  v += dpp_f<0xB1>(v);
  v += dpp_f<0x4E>(v);
  return v;
}
DEVINL float row16_sum(float v) {
  v += dpp_f<0x128>(v); v += dpp_f<0x124>(v); v += dpp_f<0x122>(v); v += dpp_f<0x121>(v);
  return v;
}
DEVINL float oct_sum(float v) {
  v += dpp_f<0xB1>(v);
  v += dpp_f<0x4E>(v);
  v += dpp_f<0x141>(v);
  return v;
}
DEVINL float row16_max(float v) {
  v = fmaxf(v, dpp_f<0x128>(v)); v = fmaxf(v, dpp_f<0x124>(v)); v = fmaxf(v, dpp_f<0x122>(v)); v = fmaxf(v, dpp_f<0x121>(v));
  return v;
}
DEVINL float wave_sum(float v) {
  v = row16_sum(v);
  v += __shfl_xor(v, 16);
  v += __shfl_xor(v, 32);
  return v;
}
DEVINL float wave_max(float v) {
  v = row16_max(v);
  v = fmaxf(v, __shfl_xor(v, 16));
  v = fmaxf(v, __shfl_xor(v, 32));
  return v;
}

DEVINL void p0_mod_unit(const Params& p, int unit, char* smem) {
  float* sC = (float*)smem;
  const int tid = threadIdx.x, lane = tid & 63, wid = tid >> 6;
  __syncthreads();
  for (int e = tid; e < 16 * 1024; e += 256) {
    int b = e >> 10, k = e & 1023;
    float v = p.c[e];
    sC[k * 16 + b] = v / (1.f + __expf(-v));
  }
  __syncthreads();
  const int col = unit * 64 + lane;
  float acc[16];
#pragma unroll
  for (int b = 0; b < 16; ++b) acc[b] = 0.f;
  const float* wp = p.w_ada + (size_t)(wid * 256) * 6144 + col;
#pragma unroll 16
  for (int k = 0; k < 256; ++k) {
    float wv = wp[(size_t)k * 6144];
    const float4* s4 = (const float4*)(sC + (wid * 256 + k) * 16);
    float4 s0 = s4[0], s1 = s4[1], s2 = s4[2], s3 = s4[3];
    acc[0] += s0.x * wv; acc[1] += s0.y * wv; acc[2] += s0.z * wv; acc[3] += s0.w * wv;
    acc[4] += s1.x * wv; acc[5] += s1.y * wv; acc[6] += s1.z * wv; acc[7] += s1.w * wv;
    acc[8] += s2.x * wv; acc[9] += s2.y * wv; acc[10] += s2.z * wv; acc[11] += s2.w * wv;
    acc[12] += s3.x * wv; acc[13] += s3.y * wv; acc[14] += s3.z * wv; acc[15] += s3.w * wv;
  }
  __syncthreads();
  float* sR = (float*)smem;
#pragma unroll
  for (int b = 0; b < 16; ++b) sR[(wid * 16 + b) * 64 + lane] = acc[b];
  __syncthreads();
  for (int e = tid; e < 1024; e += 256) {
    int b = e >> 6, l = e & 63;
    float s = sR[(b)*64 + l] + sR[(16 + b) * 64 + l] + sR[(32 + b) * 64 + l] + sR[(48 + b) * 64 + l];
    int cc = unit * 64 + l;
    p.mod[b * 6144 + cc] = s + p.b_ada[cc];
  }
}

DEVINL void transpose_tile(const float* __restrict__ src, int K, int N, u16* __restrict__ dst, int tile, char* smem) {
  float(*s)[65] = (float(*)[65])smem;
  const int tid = threadIdx.x;
  const int nkt = K >> 6;
  const int kt = tile % nkt, nt = tile / nkt;
  __syncthreads();
#pragma unroll
  for (int i = 0; i < 16; ++i) {
    int r = (tid >> 6) + 4 * i;
    s[r][tid & 63] = src[(size_t)(kt * 64 + r) * N + nt * 64 + (tid & 63)];
  }
  __syncthreads();
#pragma unroll
  for (int i = 0; i < 16; ++i) {
    int n = (tid >> 6) + 4 * i;
    dst[(size_t)(nt * 64 + n) * K + kt * 64 + (tid & 63)] = f2bf(s[tid & 63][n]);
  }
}

DEVINL void cvt_straight(const float* __restrict__ src, u16* __restrict__ dst, size_t n4, size_t start, size_t stride) {
  for (size_t i = start; i < n4; i += stride) {
    float4 v = ((const float4*)src)[i];
    uint2 o; o.x = pack2(v.x, v.y); o.y = pack2(v.z, v.w);
    ((uint2*)dst)[i] = o;
  }
}

DEVINL void cvt_row_fp4(const float* __restrict__ src, unsigned char* __restrict__ dst, float* __restrict__ inv_scale, int row) {
  const int lane = threadIdx.x & 63;
  {
    const float4* sp = (const float4*)(src + (size_t)row * 1024 + lane * 16);
    float4 v0 = sp[0], v1 = sp[1], v2 = sp[2], v3 = sp[3];
    float am = fmaxf(fmaxf(fmaxf(fabsf(v0.x), fabsf(v0.y)), fmaxf(fabsf(v0.z), fabsf(v0.w))),
                     fmaxf(fmaxf(fabsf(v1.x), fabsf(v1.y)), fmaxf(fabsf(v1.z), fabsf(v1.w))));
    am = fmaxf(am, fmaxf(fmaxf(fmaxf(fabsf(v2.x), fabsf(v2.y)), fmaxf(fabsf(v2.z), fabsf(v2.w))),
                         fmaxf(fmaxf(fabsf(v3.x), fabsf(v3.y)), fmaxf(fabsf(v3.z), fabsf(v3.w)))));
    am = wave_max(am);
    const float sc = (am > 0.f) ? 6.f / am : 1.f;
    const float inv = (am > 0.f) ? am * (1.f / 6.f) : 1.f;
    unsigned w0 = 0, w1 = 0;
    w0 = __builtin_amdgcn_cvt_scalef32_pk_fp4_f32(w0, v0.x * sc, v0.y * sc, 1.0f, 0);
    w0 = __builtin_amdgcn_cvt_scalef32_pk_fp4_f32(w0, v0.z * sc, v0.w * sc, 1.0f, 1);
    w0 = __builtin_amdgcn_cvt_scalef32_pk_fp4_f32(w0, v1.x * sc, v1.y * sc, 1.0f, 2);
    w0 = __builtin_amdgcn_cvt_scalef32_pk_fp4_f32(w0, v1.z * sc, v1.w * sc, 1.0f, 3);
    w1 = __builtin_amdgcn_cvt_scalef32_pk_fp4_f32(w1, v2.x * sc, v2.y * sc, 1.0f, 0);
    w1 = __builtin_amdgcn_cvt_scalef32_pk_fp4_f32(w1, v2.z * sc, v2.w * sc, 1.0f, 1);
    w1 = __builtin_amdgcn_cvt_scalef32_pk_fp4_f32(w1, v3.x * sc, v3.y * sc, 1.0f, 2);
    w1 = __builtin_amdgcn_cvt_scalef32_pk_fp4_f32(w1, v3.z * sc, v3.w * sc, 1.0f, 3);
    *(uint2*)(dst + (size_t)row * 512 + lane * 8) = make_uint2(w0, w1);
    if (lane == 0) inv_scale[row] = inv;
  }
}

DEVINL void cvt_fp4_queue(const Params& p, char* smem) {
  int* sh = (int*)smem;
  const int wid = threadIdx.x >> 6;
  for (;;) {
    __syncthreads();
    if (threadIdx.x == 0) sh[0] = atomicAdd(&p.ctr[2050], 1);
    __syncthreads();
    const int c = sh[0];
    if (c >= 2048) break;
    const bool isv = c >= 1024;
    const int r0 = (c & 1023) * 16 + wid * 4;
#pragma unroll
    for (int i = 0; i < 4; ++i)
      cvt_row_fp4(isv ? p.pv : p.pu, (unsigned char*)(isv ? p.vb : p.ub), isv ? p.vsc : p.usc, r0 + i);
  }
}

DEVINL void late_transpose_queue(const Params& p, char* smem) {
  int* sh = (int*)(smem + 64 * 65 * 4);
  for (;;) {
    __syncthreads();
    if (threadIdx.x == 0) sh[0] = atomicAdd(&p.ctr[2051], 1);
    __syncthreads();
    int t = sh[0];
    if (t >= 1088) break;
    if (t < 256) { transpose_tile(p.w_br_r, 1024, 1024, p.w_br_r_t, t, smem); continue; } t -= 256;
    if (t < 64) { transpose_tile(p.w_br_a, 256, 1024, p.w_br_a_t, t, smem); continue; } t -= 64;
    if (t < 256) { transpose_tile(p.w_out, 1024, 1024, p.w_out_t, t, smem); continue; } t -= 256;
    transpose_tile(p.wq, 1024, 2048, p.wq_t, t, smem);
  }
}

DEVINL void phase0(const Params& p, char* smem) {
  const int G = gridDim.x;
  constexpr int NT0 = 120, NT5 = 16, NT6 = 16, NT7 = 32;
  constexpr int NTR = NT0 + NT5 + NT6 + NT7;
  for (int u = blockIdx.x; u < 96 + NTR; u += G) {
    if (u < 96) { p0_mod_unit(p, u, smem); continue; }
    int t = u - 96;
    if (t < NT0) {
      {
        const int nb = t >> 2, part = t & 3;
        const int n = nb * 256 + threadIdx.x;
        const float* wp = p.w_in + (size_t)(part * 256) * 7680 + n;
        float m = 0.f;
#pragma unroll 16
        for (int k = 0; k < 256; ++k) m = fmaxf(m, fabsf(wp[(size_t)k * 7680]));
        atomicMax(&p.colamax[n], __float_as_int(m));
      }
      continue;
    } t -= NT0;
    if (t < NT5) { transpose_tile(p.w2, 64, 1024, p.w2t, t, smem); continue; } t -= NT5;
    if (t < NT6) { transpose_tile(p.a2, 64, 1024, p.a2t, t, smem); continue; } t -= NT6;
    transpose_tile(p.g2, 128, 1024, p.g2t, t, smem);
  }
  size_t start = (size_t)blockIdx.x * 256 + threadIdx.x, stride = (size_t)G * 256;
  cvt_straight(p.k1, p.k1b, 128 * 128 / 4, start, stride);
  cvt_straight(p.k2, p.k2b, 128 * 128 / 4, start, stride);
}

DEVINL void norm_rows(const float* __restrict__ xin, const float* __restrict__ g, const float* __restrict__ mod,
                      int sh_off, int sc_off, u16* __restrict__ dst) {
  const int lane = threadIdx.x & 63, wid = threadIdx.x >> 6;
  const int nw = gridDim.x * 4;
  float4 v[4], nv[4];
  {
    const int r0 = blockIdx.x * 4 + wid;
    if (r0 < T) {
#pragma unroll
      for (int i = 0; i < 4; ++i) v[i] = ((const float4*)(xin + (size_t)r0 * 1024))[i * 64 + lane];
    }
  }
  for (int row = blockIdx.x * 4 + wid; row < T; row += nw) {
    if (row + nw < T) {
#pragma unroll
      for (int i = 0; i < 4; ++i) nv[i] = ((const float4*)(xin + (size_t)(row + nw) * 1024))[i * 64 + lane];
    }
    float ss = 0.f;
#pragma unroll
    for (int i = 0; i < 4; ++i) ss += v[i].x * v[i].x + v[i].y * v[i].y + v[i].z * v[i].z + v[i].w * v[i].w;
    ss = wave_sum(ss);
    const float rstd = rsqrtf(ss * (1.f / 1024.f) + 1e-6f);
    const float* mb = mod + (row >> 11) * 6144;
#pragma unroll
    for (int i = 0; i < 4; ++i) {
      int col = (i * 64 + lane) * 4;
      float4 gg = *(const float4*)(g + col);
      float4 sc = *(const float4*)(mb + sc_off + col);
      float4 sh = *(const float4*)(mb + sh_off + col);
      float o0 = v[i].x * rstd * gg.x * (1.f + sc.x) + sh.x;
      float o1 = v[i].y * rstd * gg.y * (1.f + sc.y) + sh.y;
      float o2 = v[i].z * rstd * gg.z * (1.f + sc.z) + sh.z;
      float o3 = v[i].w * rstd * gg.w * (1.f + sc.w) + sh.w;
      uint2 o; o.x = pack2(o0, o1); o.y = pack2(o2, o3);
      *(uint2*)(dst + (size_t)row * 1024 + col) = o;
    }
#pragma unroll
    for (int i = 0; i < 4; ++i) v[i] = nv[i];
  }
}


DEVINL void transpose_tile_fp8(const Params& p, int tile, char* smem) {
  float(*s)[65] = (float(*)[65])smem;
  const int tid = threadIdx.x;
  const int kt = tile & 15, nt = tile >> 4;
  unsigned char* dst = (unsigned char*)p.w_in_t;
  __syncthreads();
#pragma unroll
  for (int i = 0; i < 16; ++i) {
    int r = (tid >> 6) + 4 * i;
    s[r][tid & 63] = p.w_in[(size_t)(kt * 64 + r) * 7680 + nt * 64 + (tid & 63)];
  }
  __syncthreads();
  const int k4 = (tid & 15) * 4;
#pragma unroll
  for (int i = 0; i < 4; ++i) {
    const int n = (tid >> 4) + 16 * i;
    const float am = __int_as_float(p.colamax[nt * 64 + n]);
    const float sc = (am > 0.f) ? 224.f / am : 1.f;
    int w = 0;
    w = __builtin_amdgcn_cvt_pk_fp8_f32(s[k4][n] * sc, s[k4 + 1][n] * sc, w, false);
    w = __builtin_amdgcn_cvt_pk_fp8_f32(s[k4 + 2][n] * sc, s[k4 + 3][n] * sc, w, true);
    *(int*)(dst + (size_t)(nt * 64 + n) * 1024 + kt * 64 + k4) = w;
    if (kt == 0 && k4 == 0) p.w_in_s[nt * 64 + n] = (am > 0.f) ? am * (1.f / 224.f) : 1.f;
  }
}

DEVINL void norm_rows_fp8(const Params& p) {
  const int lane = threadIdx.x & 63, wid = threadIdx.x >> 6;
  const int nw = gridDim.x * 4;
  unsigned char* dst = (unsigned char*)p.bufB;
  float4 v[4], nv[4];
  {
    const int r0 = blockIdx.x * 4 + wid;
    if (r0 < T) {
#pragma unroll
      for (int i = 0; i < 4; ++i) v[i] = ((const float4*)(p.x + (size_t)r0 * 1024))[i * 64 + lane];
    }
  }
  for (int row = blockIdx.x * 4 + wid; row < T; row += nw) {
    if (row + nw < T) {
#pragma unroll
      for (int i = 0; i < 4; ++i) nv[i] = ((const float4*)(p.x + (size_t)(row + nw) * 1024))[i * 64 + lane];
    }
    float ss = 0.f;
#pragma unroll
    for (int i = 0; i < 4; ++i) ss += v[i].x * v[i].x + v[i].y * v[i].y + v[i].z * v[i].z + v[i].w * v[i].w;
    ss = wave_sum(ss);
    const float rstd = rsqrtf(ss * (1.f / 1024.f) + 1e-6f);
    const float* mb = p.mod + (row >> 11) * 6144;
    float o[16];
    float am = 0.f;
#pragma unroll
    for (int i = 0; i < 4; ++i) {
      int col = (i * 64 + lane) * 4;
      float4 gg = *(const float4*)(p.norm1_g + col);
      float4 sc = *(const float4*)(mb + 1024 + col);
      float4 sh = *(const float4*)(mb + col);
      o[i * 4 + 0] = v[i].x * rstd * gg.x * (1.f + sc.x) + sh.x;
      o[i * 4 + 1] = v[i].y * rstd * gg.y * (1.f + sc.y) + sh.y;
      o[i * 4 + 2] = v[i].z * rstd * gg.z * (1.f + sc.z) + sh.z;
      o[i * 4 + 3] = v[i].w * rstd * gg.w * (1.f + sc.w) + sh.w;
      am = fmaxf(am, fmaxf(fmaxf(fabsf(o[i * 4]), fabsf(o[i * 4 + 1])), fmaxf(fabsf(o[i * 4 + 2]), fabsf(o[i * 4 + 3]))));
    }
    am = wave_max(am);
    const float qs = (am > 0.f) ? 224.f / am : 1.f;
#pragma unroll
    for (int i = 0; i < 4; ++i) {
      int col = (i * 64 + lane) * 4;
      int w = 0;
      w = __builtin_amdgcn_cvt_pk_fp8_f32(o[i * 4] * qs, o[i * 4 + 1] * qs, w, false);
      w = __builtin_amdgcn_cvt_pk_fp8_f32(o[i * 4 + 2] * qs, o[i * 4 + 3] * qs, w, true);
      *(int*)(dst + (size_t)row * 1024 + col) = w;
    }
    if (lane == 0) p.n1s[row] = (am > 0.f) ? am * (1.f / 224.f) : 1.f;
#pragma unroll
    for (int i = 0; i < 4; ++i) v[i] = nv[i];
  }
}

#define LDS_AS __attribute__((address_space(3)))
using i64x2 = __attribute__((ext_vector_type(2))) long;
using v8i32 = __attribute__((ext_vector_type(8))) int;
using v4i32 = __attribute__((ext_vector_type(4))) int;
template <bool FP8 = false, class Epi>
DEVINL void gemm_tile(const void* __restrict__ A, int lda, const void* __restrict__ Bt, int ldb, int K, int m0, int n0,
                      char* smem, const Epi& epi) {
  constexpr int EB = FP8 ? 1 : 2;
  constexpr int KS = 128 / EB;
  constexpr int CE = 16 / EB;
  const int tid = threadIdx.x, lane = tid & 63, wid = tid >> 6;
  const int wr = wid >> 1, wc = wid & 1;
  const int fr = lane & 15, fq = lane >> 4;
  f32x4 acc[4][4];
#pragma unroll
  for (int m = 0; m < 4; ++m)
#pragma unroll
    for (int n = 0; n < 4; ++n) acc[m][n] = (f32x4){0.f, 0.f, 0.f, 0.f};
  const int l3 = lane >> 3, cch = (lane & 7) ^ l3;
  const char* Ab = (const char*)A + (size_t)m0 * lda * EB;
  const char* Bb = (const char*)Bt + (size_t)n0 * ldb * EB;
  const uint32_t aoff = (uint32_t)((wid * 32 + l3) * lda + cch * CE) * (uint32_t)EB;
  const uint32_t boff = (uint32_t)((16 * (lane >> 5) + (l3 & 3)) * ldb + cch * CE) * (uint32_t)EB;
  const int rowB_base = (wid >> 1) * 64 + 8 * (wid & 1);
  char* ldsw = smem + wid * 4096 + lane * 16;
#define DMA(buf, k0_)                                                                                           \
  _Pragma("unroll") for (int i = 0; i < 4; ++i) {                                                               \
    __builtin_amdgcn_global_load_lds((const unsigned*)(Ab + (size_t)((i * 8 * lda + (k0_)) * EB) + aoff),       \
                                     (LDS_AS unsigned*)(ldsw + (buf) * 32768 + i * 1024), 16, 0, 0);            \
    __builtin_amdgcn_global_load_lds(                                                                           \
        (const unsigned*)(Bb + (size_t)(((rowB_base + 32 * (i & 1) + 4 * (i >> 1)) * ldb + (k0_)) * EB) + boff), \
        (LDS_AS unsigned*)(ldsw + (buf) * 32768 + 16384 + i * 1024), 16, 0, 0);                                 \
  }
  const int ra0 = (wr * 64 + fr) * 128 + (((0 + fq) ^ (fr & 7)) << 4);
  const int ra1 = (wr * 64 + fr) * 128 + (((4 + fq) ^ (fr & 7)) << 4);
  const int rb0 = 16384 + (wc * 64 + fr) * 128 + (((0 + fq) ^ (fr & 7)) << 4);
  const int rb1 = 16384 + (wc * 64 + fr) * 128 + (((4 + fq) ^ (fr & 7)) << 4);
  const int qa0 = (wr * 64 + fr) * 128 + (((2 * fq) ^ (fr & 7)) << 4);
  const int qa1 = (wr * 64 + fr) * 128 + (((2 * fq + 1) ^ (fr & 7)) << 4);
  const int qb0 = 16384 + (wc * 64 + fr) * 128 + (((2 * fq) ^ (fr & 7)) << 4);
  const int qb1 = 16384 + (wc * 64 + fr) * 128 + (((2 * fq + 1) ^ (fr & 7)) << 4);
#define LD32(off0, off1, dst)                                        \
  {                                                                  \
    dst.lo = *(const v4i32*)(off0);                                  \
    dst.hi = *(const v4i32*)(off1);                                  \
  }
#define COMPUTE(buf)                                                                                        \
  if (FP8) {                                                                                                \
    v8i32 bfr[4];                                                                                           \
    _Pragma("unroll") for (int n = 0; n < 4; ++n) LD32(smem + (buf) * 32768 + qb0 + n * 2048, smem + (buf) * 32768 + qb1 + n * 2048, bfr[n])  \
    _Pragma("unroll") for (int m = 0; m < 4; ++m) {                                                         \
      v8i32 af;                                                                                             \
      LD32(smem + (buf) * 32768 + qa0 + m * 2048, smem + (buf) * 32768 + qa1 + m * 2048, af)                \
      _Pragma("unroll") for (int n = 0; n < 4; ++n)                                                         \
        acc[m][n] = __builtin_amdgcn_mfma_scale_f32_16x16x128_f8f6f4(bfr[n], af, acc[m][n], 0, 0, 0, 127, 0, 127); \
    }                                                                                                       \
    __builtin_amdgcn_sched_barrier(0);                                                                      \
  } else {                                                                                                  \
    _Pragma("unroll") for (int ks = 0; ks < 2; ++ks) {                                                      \
      bf16x8 af[4], bfr[4];                                                                                 \
      _Pragma("unroll") for (int m = 0; m < 4; ++m) af[m] = *(const bf16x8*)(smem + (buf) * 32768 + (ks ? ra1 : ra0) + m * 2048);  \
      _Pragma("unroll") for (int n = 0; n < 4; ++n) bfr[n] = *(const bf16x8*)(smem + (buf) * 32768 + (ks ? rb1 : rb0) + n * 2048); \
      _Pragma("unroll") for (int m = 0; m < 4; ++m)                                                         \
        _Pragma("unroll") for (int n = 0; n < 4; ++n)                                                       \
          acc[m][n] = __builtin_amdgcn_mfma_f32_16x16x32_bf16(bfr[n], af[m], acc[m][n], 0, 0, 0);           \
    }                                                                                                       \
  }
  __syncthreads();
  DMA(0, 0)
  __syncthreads();
#pragma unroll 1
  for (int k0 = 0; k0 < K; k0 += 2 * KS) {
    DMA(1, k0 + KS)
    COMPUTE(0)
    __syncthreads();
    if (k0 + 2 * KS < K) { DMA(0, k0 + 2 * KS) }
    COMPUTE(1)
    __syncthreads();
  }
#undef DMA
#undef COMPUTE
#undef LD32
#pragma unroll
  for (int m = 0; m < 4; ++m) {
    int row = m0 + wr * 64 + m * 16 + fr;
    int col0 = n0 + wc * 64 + fq * 16;
    epi(row, col0, acc[m]);
  }
}

DEVINL void store16_bf16(u16* dst, const f32x4 (&v)[4]) {
  uint4 a, b;
  a.x = pack2(v[0][0], v[0][1]); a.y = pack2(v[0][2], v[0][3]);
  a.z = pack2(v[1][0], v[1][1]); a.w = pack2(v[1][2], v[1][3]);
  b.x = pack2(v[2][0], v[2][1]); b.y = pack2(v[2][2], v[2][3]);
  b.z = pack2(v[3][0], v[3][1]); b.w = pack2(v[3][2], v[3][3]);
  ((uint4*)dst)[0] = a;
  ((uint4*)dst)[1] = b;
}

struct Epi1 {
  const Params& p;
  DEVINL void operator()(int row, int col, const f32x4 (&vin)[4]) const {
    f32x4 v[4];
    {
      const float sa = p.n1s[row];
      const float* sb = p.w_in_s + col;
#pragma unroll
      for (int n = 0; n < 4; ++n) {
        const float4 s4 = *(const float4*)(sb + n * 4);
        v[n][0] = vin[n][0] * sa * s4.x; v[n][1] = vin[n][1] * sa * s4.y;
        v[n][2] = vin[n][2] * sa * s4.z; v[n][3] = vin[n][3] * sa * s4.w;
      }
    }
    if (col < 3072) store16_bf16(p.z_rkv + (size_t)row * 3072 + col, v);
    else if (col < 3328) store16_bf16(p.z_lora + (size_t)row * 256 + (col - 3072), v);
    else if (col < 5632) store16_bf16(p.z_attn + (size_t)row * 2304 + (col - 3328), v);
    else {
      f32x4 s[4];
#pragma unroll
      for (int n = 0; n < 4; ++n)
#pragma unroll
        for (int j = 0; j < 4; ++j) s[n][j] = sigm(v[n][j]);
      store16_bf16(p.gates + (size_t)row * 2048 + (col - 5632), s);
    }
  }
};
struct Epi5a {
  const Params& p; u16* merged;
  DEVINL void operator()(int row, int col, const f32x4 (&v)[4]) const {
    const uint4* gp = (const uint4*)(p.gates + (size_t)row * 2048 + col);
    uint4 g0 = gp[0], g1 = gp[1];
    uint32_t gw[8] = {g0.x, g0.y, g0.z, g0.w, g1.x, g1.y, g1.z, g1.w};
    f32x4 s[4];
#pragma unroll
    for (int n = 0; n < 4; ++n) {
      s[n][0] = v[n][0] * bflo(gw[n * 2]); s[n][1] = v[n][1] * bfhi(gw[n * 2]);
      s[n][2] = v[n][2] * bflo(gw[n * 2 + 1]); s[n][3] = v[n][3] * bfhi(gw[n * 2 + 1]);
    }
    store16_bf16(merged + (size_t)row * 1024 + col, s);
  }
};
struct Epi5b {
  const Params& p; u16* merged;
  DEVINL void operator()(int row, int col, const f32x4 (&v)[4]) const {
    const uint4* gp = (const uint4*)(p.gates + (size_t)row * 2048 + 1024 + col);
    uint4 g0 = gp[0], g1 = gp[1];
    uint32_t gw[8] = {g0.x, g0.y, g0.z, g0.w, g1.x, g1.y, g1.z, g1.w};
    const uint4* tp = (const uint4*)(merged + (size_t)row * 1024 + col);
    uint4 t0 = tp[0], t1 = tp[1];
    uint32_t tw[8] = {t0.x, t0.y, t0.z, t0.w, t1.x, t1.y, t1.z, t1.w};
    f32x4 s[4];
#pragma unroll
    for (int n = 0; n < 4; ++n) {
      s[n][0] = bflo(tw[n * 2]) + v[n][0] * bflo(gw[n * 2]);
      s[n][1] = bfhi(tw[n * 2]) + v[n][1] * bfhi(gw[n * 2]);
      s[n][2] = bflo(tw[n * 2 + 1]) + v[n][2] * bflo(gw[n * 2 + 1]);
      s[n][3] = bfhi(tw[n * 2 + 1]) + v[n][3] * bfhi(gw[n * 2 + 1]);
    }
    store16_bf16(merged + (size_t)row * 1024 + col, s);
  }
};
struct Epi6 {
  const Params& p;
  DEVINL void operator()(int row, int col, const f32x4 (&v)[4]) const {
    const float* gt = p.mod + (row >> 11) * 6144 + 2048 + col;
    const float* xr = p.x + (size_t)row * 1024 + col;
    float* o = p.out + (size_t)row * 1024 + col;
#pragma unroll
    for (int n = 0; n < 4; ++n) {
      float4 xv = *(const float4*)(xr + n * 4);
      float4 gv = *(const float4*)(gt + n * 4);
      float4 r;
      r.x = xv.x + gv.x * v[n][0]; r.y = xv.y + gv.y * v[n][1];
      r.z = xv.z + gv.z * v[n][2]; r.w = xv.w + gv.w * v[n][3];
      *(float4*)(o + n * 4) = r;
    }
  }
};
struct Epi8 {
  u16* q;
  DEVINL void operator()(int row, int col, const f32x4 (&v)[4]) const { store16_bf16(q + (size_t)row * 2048 + col, v); }
};

template <class F>
DEVINL void for_tiles(int nM, int nN, const F& f) {
  const int G = gridDim.x;
  const int xcd = blockIdx.x & 7, slot = blockIdx.x >> 3, nslot = G >> 3;
  const int nSm = nM >> 3;
  const int nS = nSm * (nN >> 2);
  const int Ltot = (nS >> 3) * 32;
  for (int L = slot; L < Ltot; L += nslot) {
    int s = (L >> 5) * 8 + xcd;
    int w = L & 31;
    int sm = s % nSm, sn = s / nSm;
    int mt = sm * 8 + (w & 7), nt = sn * 4 + (w >> 3);
    f(mt, nt);
  }
}


DEVINL void prep_phase(const Params& p, u16* X) {
  const size_t gtid = (size_t)blockIdx.x * 256 + threadIdx.x, gstride = (size_t)gridDim.x * 256;
  for (size_t it = gtid; it < (size_t)T * 32; it += gstride) {
    const size_t tok = it >> 5;
    const int c8 = (int)(it & 31) * 8;
    const u16* zl = p.z_lora + tok * 256 + c8;
    uint4 cur = *(const uint4*)zl;
    uint4 prv = make_uint4(0, 0, 0, 0);
    if ((tok & 2047) != 0) prv = *(const uint4*)(zl - 256);
    const float4 m0 = *(const float4*)(p.mu + 3072 + c8), m1 = *(const float4*)(p.mu + 3072 + c8 + 4);
    const float mu8[8] = {m0.x, m0.y, m0.z, m0.w, m1.x, m1.y, m1.z, m1.w};
    const uint32_t cw[4] = {cur.x, cur.y, cur.z, cur.w}, pw[4] = {prv.x, prv.y, prv.z, prv.w};
    uint32_t o[4];
#pragma unroll
    for (int i = 0; i < 4; ++i) {
      float c0 = bflo(cw[i]), q0 = bflo(pw[i]), c1 = bfhi(cw[i]), q1 = bfhi(pw[i]);
      float a0 = c0 + (q0 - c0) * mu8[2 * i], a1 = c1 + (q1 - c1) * mu8[2 * i + 1];
      if (c8 < 64) {
        a0 = 1.f - 2.f / (__expf(2.f * a0) + 1.f);
        a1 = 1.f - 2.f / (__expf(2.f * a1) + 1.f);
      } else if (c8 >= 128) {
        a0 = sigm(a0); a1 = sigm(a1);
      }
      o[i] = pack2(a0, a1);
    }
    *(uint4*)(X + tok * 256 + c8) = make_uint4(o[0], o[1], o[2], o[3]);
  }
  float inv_f[8];
#pragma unroll
  for (int i = 0; i < 8; ++i) inv_f[i] = expf(-(float)i * (13.122363377404328f / 8.f));
  for (size_t it = gtid; it < (size_t)T * 96; it += gstride) {
    const size_t tok = it / 96;
    const int rem = (int)(it - tok * 96);
    const int hd = rem >> 2, qd = rem & 3;
    const int isk = hd >= 12;
    const int grp = (isk ? hd - 12 : hd) >> 2;
    u16* ptr = p.z_attn + tok * 2304 + hd * 64 + qd * 16;
    uint4 a = *(const uint4*)ptr, c = *(const uint4*)(ptr + 8);
    const uint32_t wv[8] = {a.x, a.y, a.z, a.w, c.x, c.y, c.z, c.w};
    float xv[16];
#pragma unroll
    for (int i = 0; i < 8; ++i) { xv[2 * i] = bflo(wv[i]); xv[2 * i + 1] = bfhi(wv[i]); }
    float ss = 0.f;
#pragma unroll
    for (int i = 0; i < 16; ++i) ss += xv[i] * xv[i];
    ss = quad_sum(ss);
    float rstd = rsqrtf(ss * (1.f / 64.f) + 1e-6f);
    if (!isk) rstd *= 0.125f;
    const float* gp = (isk ? p.kng : p.qng) + grp * 64 + qd * 16;
#pragma unroll
    for (int i = 0; i < 16; ++i) xv[i] = xv[i] * rstd * gp[i];
    if (qd == 0) {
      const float fp = (float)(tok & 2047);
#pragma unroll
      for (int i = 0; i < 8; ++i) {
        float ang = fp * inv_f[i];
        float n = rintf(ang * 0.15915494309189535f);
        float rr = fmaf(-n, 6.2831854820251465f, ang);
        rr = fmaf(-n, -1.7484555e-7f, rr);
        float cs = __cosf(rr), sn = __sinf(rr);
        float x1 = xv[i], x2 = xv[i + 8];
        xv[i] = x1 * cs - x2 * sn;
        xv[i + 8] = x2 * cs + x1 * sn;
      }
    }
    uint32_t o[8];
#pragma unroll
    for (int i = 0; i < 8; ++i) o[i] = pack2(xv[2 * i], xv[2 * i + 1]);
    *(uint4*)ptr = make_uint4(o[0], o[1], o[2], o[3]);
    *(uint4*)(ptr + 8) = make_uint4(o[4], o[5], o[6], o[7]);
  }
}

constexpr int TC = 16;
struct ScanLds {
  float w[TC][64], k[TC][64], a[TC][64], b[TC][64], r[TC][64], v[TC][64], y[TC][64];
  float bonus[TC];
  u16 g[TC][64];
  float cst[8][64];
  float mul[256];
  u16 xw[TC][72], xa[TC][72], xg[TC][136];
  u16 w2s[64][72], a2s[64][72], g2s[64][136];
};
static_assert(sizeof(ScanLds) <= 79872, "scan lds");

DEVINL void rwkv_scan_unit(const Params& p, const u16* X, int unit, char* smem) {
  ScanLds& L = *(ScanLds*)smem;
  const int tid = threadIdx.x, lane = tid & 63, wid = tid >> 6;
  const int b = unit >> 4, h = unit & 15;
  const int fr = lane & 15, fq = lane >> 4;
  const int pt = tid >> 4, pc = (tid & 15) * 4;
  const int rp = tid >> 3, cq = tid & 7;

  __syncthreads();
  {
    const float* srcs[8] = {p.mu + h * 64, p.mu + 1024 + h * 64, p.mu + 2048 + h * 64, p.k_k + h * 64,
                            p.k_a + h * 64, p.r_k + h * 64, p.lnx_g + h * 64, p.lnx_b + h * 64};
#pragma unroll
    for (int i = 0; i < 8; ++i)
      if (tid < 64) L.cst[i][tid] = srcs[i][tid];
    L.mul[tid] = p.mu[3072 + tid];
    const int c = tid >> 2, qq = tid & 3;
    const u16* w2p = p.w2t + (size_t)(h * 64 + c) * 64 + qq * 16;
    const u16* a2p = p.a2t + (size_t)(h * 64 + c) * 64 + qq * 16;
    const u16* g2p = p.g2t + (size_t)(h * 64 + c) * 128 + qq * 32;
    *(u32x4*)&L.w2s[c][qq * 16] = *(const u32x4*)w2p;
    *(u32x4*)&L.w2s[c][qq * 16 + 8] = *(const u32x4*)(w2p + 8);
    *(u32x4*)&L.a2s[c][qq * 16] = *(const u32x4*)a2p;
    *(u32x4*)&L.a2s[c][qq * 16 + 8] = *(const u32x4*)(a2p + 8);
#pragma unroll
    for (int i = 0; i < 4; ++i) *(u32x4*)&L.g2s[c][qq * 32 + i * 8] = *(const u32x4*)(g2p + i * 8);
  }
  const int chn = h * 64 + wid * 16 + fr;
  const float w0c = p.w0[chn], a0c = p.a0[chn];
  const int ec = h * 64 + pc;
  const int lc = (tid & 15) * 16;

  f32x2 S2[2][4];
#pragma unroll
  for (int r_ = 0; r_ < 2; ++r_)
#pragma unroll
    for (int j = 0; j < 4; ++j) S2[r_][j] = (f32x2){0.f, 0.f};

  const size_t tok0 = (size_t)b * 2048;
  uint2 pr0, pr1, pk0, pk1, pv0, pv1;
  uint4 pl0, pl1;
#define PREFETCH(t0_)                                                                                    \
  {                                                                                                      \
    const int t_ = (t0_) + pt;                                                                           \
    const u16* zr_ = p.z_rkv + (tok0 + t_) * 3072 + ec;                                                  \
    pr0 = *(const uint2*)(zr_); pk0 = *(const uint2*)(zr_ + 1024); pv0 = *(const uint2*)(zr_ + 2048);    \
    const u16* xl_ = X + (tok0 + t_) * 256 + lc;                                                         \
    pl0 = *(const uint4*)(xl_); pl1 = *(const uint4*)(xl_ + 8);                                          \
    if (t_ > 0) {                                                                                        \
      pr1 = *(const uint2*)(zr_ - 3072); pk1 = *(const uint2*)(zr_ - 3072 + 1024);                       \
      pv1 = *(const uint2*)(zr_ - 3072 + 2048);                                                          \
    } else {                                                                                             \
      pr1 = make_uint2(0, 0); pk1 = make_uint2(0, 0); pv1 = make_uint2(0, 0);                            \
    }                                                                                                    \
  }
  __syncthreads();
  PREFETCH(0)

  for (int t0 = 0; t0 < 2048; t0 += TC) {
    float r4[4], k4[4], v4[4];
    {
      const float4 mu_r = *(const float4*)&L.cst[0][pc], mu_k = *(const float4*)&L.cst[1][pc], mu_v = *(const float4*)&L.cst[2][pc];
      float c, q;
      c = bflo(pr0.x); q = bflo(pr1.x); r4[0] = c + (q - c) * mu_r.x;
      c = bfhi(pr0.x); q = bfhi(pr1.x); r4[1] = c + (q - c) * mu_r.y;
      c = bflo(pr0.y); q = bflo(pr1.y); r4[2] = c + (q - c) * mu_r.z;
      c = bfhi(pr0.y); q = bfhi(pr1.y); r4[3] = c + (q - c) * mu_r.w;
      c = bflo(pk0.x); q = bflo(pk1.x); k4[0] = c + (q - c) * mu_k.x;
      c = bfhi(pk0.x); q = bfhi(pk1.x); k4[1] = c + (q - c) * mu_k.y;
      c = bflo(pk0.y); q = bflo(pk1.y); k4[2] = c + (q - c) * mu_k.z;
      c = bfhi(pk0.y); q = bfhi(pk1.y); k4[3] = c + (q - c) * mu_k.w;
      c = bflo(pv0.x); q = bflo(pv1.x); v4[0] = c + (q - c) * mu_v.x;
      c = bfhi(pv0.x); q = bfhi(pv1.x); v4[1] = c + (q - c) * mu_v.y;
      c = bflo(pv0.y); q = bflo(pv1.y); v4[2] = c + (q - c) * mu_v.z;
      c = bfhi(pv0.y); q = bfhi(pv1.y); v4[3] = c + (q - c) * mu_v.w;
    }
    *(float4*)&L.r[pt][pc] = make_float4(r4[0], r4[1], r4[2], r4[3]);
    *(float4*)&L.v[pt][pc] = make_float4(v4[0], v4[1], v4[2], v4[3]);
    {
      u16* dstp = (lc < 64) ? &L.xw[pt][lc] : (lc < 128) ? &L.xa[pt][lc - 64] : &L.xg[pt][lc - 128];
      *(uint4*)dstp = pl0;
      *(uint4*)(dstp + 8) = pl1;
    }
    __syncthreads();
    {
      f32x4 cw = {0.f, 0.f, 0.f, 0.f}, ca = {0.f, 0.f, 0.f, 0.f}, cg_ = {0.f, 0.f, 0.f, 0.f};
#pragma unroll
      for (int ks = 0; ks < 2; ++ks) {
        bf16x8 xa_ = *(const bf16x8*)&L.xw[fr][ks * 32 + fq * 8];
        cw = __builtin_amdgcn_mfma_f32_16x16x32_bf16(xa_, *(const bf16x8*)&L.w2s[wid * 16 + fr][ks * 32 + fq * 8], cw, 0, 0, 0);
        bf16x8 xb_ = *(const bf16x8*)&L.xa[fr][ks * 32 + fq * 8];
        ca = __builtin_amdgcn_mfma_f32_16x16x32_bf16(xb_, *(const bf16x8*)&L.a2s[wid * 16 + fr][ks * 32 + fq * 8], ca, 0, 0, 0);
      }
#pragma unroll
      for (int ks = 0; ks < 4; ++ks) {
        bf16x8 xc_ = *(const bf16x8*)&L.xg[fr][ks * 32 + fq * 8];
        cg_ = __builtin_amdgcn_mfma_f32_16x16x32_bf16(xc_, *(const bf16x8*)&L.g2s[wid * 16 + fr][ks * 32 + fq * 8], cg_, 0, 0, 0);
      }
      const int ch = wid * 16 + fr;
#pragma unroll
      for (int j = 0; j < 4; ++j) {
        int tk = fq * 4 + j;
        L.w[tk][ch] = __expf(-0.6065306597126334f * sigm(w0c + cw[j]));
        L.y[tk][ch] = sigm(a0c + ca[j]);
        L.g[tk][ch] = f2bf(cg_[j]);
      }
    }
    __syncthreads();
    {
      float4 al4 = *(const float4*)&L.y[pt][pc];
      const float4 kk_c = *(const float4*)&L.cst[3][pc], ka_c = *(const float4*)&L.cst[4][pc], rk_c = *(const float4*)&L.cst[5][pc];
      float kk0 = k4[0] * kk_c.x, kk1 = k4[1] * kk_c.y, kk2 = k4[2] * kk_c.z, kk3 = k4[3] * kk_c.w;
      float ss = row16_sum(kk0 * kk0 + kk1 * kk1 + kk2 * kk2 + kk3 * kk3);
      float inv = 1.f / fmaxf(sqrtf(ss), 1e-12f);
      kk0 *= inv; kk1 *= inv; kk2 *= inv; kk3 *= inv;
      *(float4*)&L.a[pt][pc] = make_float4(-kk0, -kk1, -kk2, -kk3);
      *(float4*)&L.b[pt][pc] = make_float4(kk0 * al4.x, kk1 * al4.y, kk2 * al4.z, kk3 * al4.w);
      float km0 = k4[0] * (1.f + (al4.x - 1.f) * ka_c.x);
      float km1 = k4[1] * (1.f + (al4.y - 1.f) * ka_c.y);
      float km2 = k4[2] * (1.f + (al4.z - 1.f) * ka_c.z);
      float km3 = k4[3] * (1.f + (al4.w - 1.f) * ka_c.w);
      *(float4*)&L.k[pt][pc] = make_float4(km0, km1, km2, km3);
      float bs = row16_sum(r4[0] * km0 * rk_c.x + r4[1] * km1 * rk_c.y + r4[2] * km2 * rk_c.z + r4[3] * km3 * rk_c.w);
      if ((tid & 15) == 0) L.bonus[pt] = bs;
    }
    if (t0 + TC < 2048) PREFETCH(t0 + TC)
    __syncthreads();
    {
#define LDVEC(dst, arr, t)                                         \
  {                                                                \
    const f32x4* p4_ = (const f32x4*)&L.arr[t][cq * 8];            \
    f32x4 v0_ = p4_[0], v1_ = p4_[1];                              \
    dst[0] = (f32x2){v0_[0], v0_[1]}; dst[1] = (f32x2){v0_[2], v0_[3]}; \
    dst[2] = (f32x2){v1_[0], v1_[1]}; dst[3] = (f32x2){v1_[2], v1_[3]}; \
  }
      f32x2 cA[4];
      LDVEC(cA, a, 0)
      f32x2 cv = *(const f32x2*)&L.v[0][rp * 2];
#pragma unroll 2
      for (int t = 0; t < TC; ++t) {
        f32x2 nA[4], cW[4], cB[4], cK[4], cR[4];
        const int tn = (t + 1 < TC) ? t + 1 : t;
        LDVEC(cW, w, t) LDVEC(cB, b, t) LDVEC(cK, k, t)
        LDVEC(nA, a, tn)
        const f32x2 nv = *(const f32x2*)&L.v[tn][rp * 2];
        LDVEC(cR, r, t)
        f32x2 p0 = S2[0][0] * cA[0], p1 = S2[0][1] * cA[1], q0 = S2[1][0] * cA[0], q1 = S2[1][1] * cA[1];
        p0 = S2[0][2] * cA[2] + p0; p1 = S2[0][3] * cA[3] + p1; q0 = S2[1][2] * cA[2] + q0; q1 = S2[1][3] * cA[3] + q1;
        p0 = p0 + p1; q0 = q0 + q1;
        const float sa0 = oct_sum(p0[0] + p0[1]);
        const float sa1 = oct_sum(q0[0] + q0[1]);
        const f32x2 sav0 = {sa0, sa0}, sav1 = {sa1, sa1}, vv0 = {cv[0], cv[0]}, vv1 = {cv[1], cv[1]};
#pragma unroll
        for (int j = 0; j < 4; ++j) {
          S2[0][j] = S2[0][j] * cW[j] + (sav0 * cB[j] + vv0 * cK[j]);
          S2[1][j] = S2[1][j] * cW[j] + (sav1 * cB[j] + vv1 * cK[j]);
        }
        f32x2 y0 = S2[0][0] * cR[0], y1 = S2[0][1] * cR[1], z0 = S2[1][0] * cR[0], z1 = S2[1][1] * cR[1];
        y0 = S2[0][2] * cR[2] + y0; y1 = S2[0][3] * cR[3] + y1; z0 = S2[1][2] * cR[2] + z0; z1 = S2[1][3] * cR[3] + z1;
        y0 = y0 + y1; z0 = z0 + z1;
        const float ya = oct_sum(y0[0] + y0[1]);
        const float yb = oct_sum(z0[0] + z0[1]);
        if (cq == 0) *(f32x2*)&L.y[t][rp * 2] = (f32x2){ya, yb};
#pragma unroll
        for (int j = 0; j < 4; ++j) cA[j] = nA[j];
        cv = nv;
      }
#undef LDVEC
    }
    __syncthreads();
    {
      const float4 lg_c = *(const float4*)&L.cst[6][pc], lb_c = *(const float4*)&L.cst[7][pc];
      float4 y4 = *(const float4*)&L.y[pt][pc];
      float4 g4;
      {
        uint2 gq = *(const uint2*)&L.g[pt][pc];
        g4 = make_float4(bflo(gq.x), bfhi(gq.x), bflo(gq.y), bfhi(gq.y));
      }
      float4 vv = *(const float4*)&L.v[pt][pc];
      float bs = L.bonus[pt];
      float mean = row16_sum(y4.x + y4.y + y4.z + y4.w) * (1.f / 64.f);
      float d0 = y4.x - mean, d1 = y4.y - mean, d2 = y4.z - mean, d3 = y4.w - mean;
      float var = row16_sum(d0 * d0 + d1 * d1 + d2 * d2 + d3 * d3) * (1.f / 64.f);
      float rs = rsqrtf(var + 64e-5f);
      float o0 = (d0 * rs * lg_c.x + lb_c.x + bs * vv.x) * g4.x;
      float o1 = (d1 * rs * lg_c.y + lb_c.y + bs * vv.y) * g4.y;
      float o2 = (d2 * rs * lg_c.z + lb_c.z + bs * vv.z) * g4.z;
      float o3 = (d3 * rs * lg_c.w + lb_c.w + bs * vv.w) * g4.w;
      uint2 o; o.x = pack2(o0, o1); o.y = pack2(o2, o3);
      *(uint2*)(p.bufB + (tok0 + t0 + pt) * 1024 + ec) = o;
    }
    __syncthreads();
  }
}

struct AttnLds {
  u16 q[64][72];
  u16 k[192][72];
  u16 vt[64][200];
};

DEVINL void attn_unit(const Params& p, int u, char* smem) {
  AttnLds& L = *(AttnLds*)smem;
  const int tid = threadIdx.x, lane = tid & 63, wid = tid >> 6;
  const int fr = lane & 15, fq = lane >> 4;
  const int g = u >> 11;
  int rem = u & 2047;
  const int b = rem >> 7; rem &= 127;
  const int hh = rem >> 5;
  const int w = rem & 31;
  const int dsh = g * 2;
  const int d = 1 << dsh;
  const int nqb = 32 >> dsh;
  const int r = w / nqb, qb = w % nqb;
  const int l0 = qb * 64;
  const int kl0 = l0 - 128;
  const int gh = g * 4 + hh;
  const size_t tokb = (size_t)b * 2048;
  const int rowi = tid >> 2, qd = tid & 3;

  __syncthreads();
#pragma unroll 1
  for (int pass = 0; pass < 7; ++pass) {
    int kind = (pass == 0) ? 0 : (pass < 4 ? 1 : 2);
    int lrow = (pass == 0) ? rowi : (pass < 4 ? (pass - 1) * 64 + rowi : (pass - 4) * 64 + rowi);
    int sub = (kind == 0) ? (l0 + lrow) : (kl0 + lrow);
    bool valid = sub >= 0;
    int pos = sub * d + r;
    float xv[16];
    if (valid) {
      const u16* src = p.z_attn + (tokb + pos) * 2304 + kind * 768 + gh * 64 + qd * 16;
      uint4 a = *(const uint4*)src, c = *(const uint4*)(src + 8);
      uint32_t wv[8] = {a.x, a.y, a.z, a.w, c.x, c.y, c.z, c.w};
#pragma unroll
      for (int i = 0; i < 8; ++i) { xv[2 * i] = bflo(wv[i]); xv[2 * i + 1] = bfhi(wv[i]); }
    } else {
#pragma unroll
      for (int i = 0; i < 16; ++i) xv[i] = 0.f;
    }
    if (kind < 2) {
      uint32_t o[8];
#pragma unroll
      for (int i = 0; i < 8; ++i) o[i] = pack2(xv[2 * i], xv[2 * i + 1]);
      u16* dst = (kind == 0) ? &L.q[lrow][qd * 16] : &L.k[lrow][qd * 16];
      *(uint4*)dst = make_uint4(o[0], o[1], o[2], o[3]);
      *(uint4*)(dst + 8) = make_uint4(o[4], o[5], o[6], o[7]);
    } else {
#pragma unroll
      for (int i = 0; i < 16; ++i) L.vt[qd * 16 + i][lrow] = f2bf(xv[i]);
    }
  }
  __syncthreads();
  bf16x8 qf[2];
#pragma unroll
  for (int ks = 0; ks < 2; ++ks) qf[ks] = *(const bf16x8*)&L.q[wid * 16 + fr][ks * 32 + fq * 8];
  f32x4 sc[9];
#pragma unroll
  for (int i = 0; i < 9; ++i) {
    int kt = wid + i;
    f32x4 a = {0.f, 0.f, 0.f, 0.f};
#pragma unroll
    for (int ks = 0; ks < 2; ++ks) {
      bf16x8 kf = *(const bf16x8*)&L.k[kt * 16 + fr][ks * 32 + fq * 8];
      a = __builtin_amdgcn_mfma_f32_16x16x32_bf16(kf, qf[ks], a, 0, 0, 0);
    }
    sc[i] = a;
  }
  const int ql = wid * 16 + fr;
  float mx = -1e30f;
#pragma unroll
  for (int i = 0; i < 9; ++i)
#pragma unroll
    for (int j = 0; j < 4; ++j) {
      int kl = (wid + i) * 16 + fq * 4 + j;
      bool ok = (kl >= ql) && (kl <= ql + 128) && (kl0 + kl >= 0);
      float s = ok ? sc[i][j] : -1e30f;
      sc[i][j] = s;
      mx = fmaxf(mx, s);
    }
  mx = fmaxf(mx, __shfl_xor(mx, 16));
  mx = fmaxf(mx, __shfl_xor(mx, 32));
  float lsum = 0.f;
  bf16x4 pf[9];
#pragma unroll
  for (int i = 0; i < 9; ++i) {
    float e0 = __expf(sc[i][0] - mx), e1 = __expf(sc[i][1] - mx), e2 = __expf(sc[i][2] - mx), e3 = __expf(sc[i][3] - mx);
    lsum += (e0 + e1) + (e2 + e3);
    pf[i][0] = (short)f2bf(e0); pf[i][1] = (short)f2bf(e1); pf[i][2] = (short)f2bf(e2); pf[i][3] = (short)f2bf(e3);
  }
  lsum += __shfl_xor(lsum, 16);
  lsum += __shfl_xor(lsum, 32);
  f32x4 oacc[4];
#pragma unroll
  for (int db = 0; db < 4; ++db) oacc[db] = (f32x4){0.f, 0.f, 0.f, 0.f};
#pragma unroll
  for (int i = 0; i < 9; ++i) {
    int kt = wid + i;
#pragma unroll
    for (int db = 0; db < 4; ++db) {
      bf16x4 vf = *(const bf16x4*)&L.vt[db * 16 + fr][kt * 16 + fq * 4];
      oacc[db] = __builtin_amdgcn_mfma_f32_16x16x16bf16_1k(vf, pf[i], oacc[db], 0, 0, 0);
    }
  }
  const float invl = 1.f / lsum;
  const int posq = (l0 + ql) * d + r;
  u16* od = p.z_attn + (tokb + posq) * 2304 + gh * 64;
#pragma unroll
  for (int db = 0; db < 4; ++db) {
    uint2 o;
    o.x = pack2(oacc[db][0] * invl, oacc[db][1] * invl);
    o.y = pack2(oacc[db][2] * invl, oacc[db][3] * invl);
    *(uint2*)(od + db * 16 + fq * 4) = o;
  }
  if (fq == 0) p.lse[((size_t)g * T + tokb + posq) * 4 + hh] = mx + __logf(lsum);
}

DEVINL void attn_merge(const Params& p) {
  u16* ya = p.z_lora;
  const size_t n = (size_t)T * 32;
  for (size_t it = (size_t)blockIdx.x * 256 + threadIdx.x; it < n; it += (size_t)gridDim.x * 256) {
    size_t tok = it >> 5;
    int c8 = (int)(it & 31) * 8;
    int hh = c8 >> 6;
    float l0 = p.lse[((size_t)0 * T + tok) * 4 + hh];
    float l1 = p.lse[((size_t)1 * T + tok) * 4 + hh];
    float l2 = p.lse[((size_t)2 * T + tok) * 4 + hh];
    float m = fmaxf(l0, fmaxf(l1, l2));
    float e0 = __expf(l0 - m), e1 = __expf(l1 - m), e2 = __expf(l2 - m);
    float inv = 1.f / (e0 + e1 + e2);
    e0 *= inv; e1 *= inv; e2 *= inv;
    const u16* zr = p.z_attn + tok * 2304 + c8;
    uint4 a = *(const uint4*)(zr), bq = *(const uint4*)(zr + 256), cq = *(const uint4*)(zr + 512);
    uint32_t aw[4] = {a.x, a.y, a.z, a.w}, bw[4] = {bq.x, bq.y, bq.z, bq.w}, cw[4] = {cq.x, cq.y, cq.z, cq.w};
    uint32_t o[4];
#pragma unroll
    for (int i = 0; i < 4; ++i) {
      float lo = e0 * bflo(aw[i]) + e1 * bflo(bw[i]) + e2 * bflo(cw[i]);
      float hi = e0 * bfhi(aw[i]) + e1 * bfhi(bw[i]) + e2 * bfhi(cw[i]);
      o[i] = pack2(lo, hi);
    }
    *(uint4*)(ya + tok * 256 + c8) = make_uint4(o[0], o[1], o[2], o[3]);
  }
}

DEVINL uint32_t sortable(float s) {
  uint32_t u = __float_as_uint(s);
  return (u & 0x80000000u) ? ~u : (u | 0x80000000u);
}

DEVINL void ce_desc(uint32_t& a, uint32_t& b) {
  const uint32_t hi = max(a, b), lo = min(a, b);
  a = hi; b = lo;
}
DEVINL void bitonic_sort_desc16(uint32_t (&a)[16]) {
#pragma unroll
  for (int lk = 1; lk <= 4; ++lk) {
#pragma unroll
    for (int lj = 3; lj >= 0; --lj) {
      if (lj < lk) {
        const int k = 1 << lk, j = 1 << lj;
#pragma unroll
        for (int i = 0; i < 16; ++i) {
          const int l = i ^ j;
          if (l > i) {
            if ((i & k) == 0) ce_desc(a[i], a[l]); else ce_desc(a[l], a[i]);
          }
        }
      }
    }
  }
}
DEVINL void bitonic_merge_desc16(uint32_t (&a)[16]) {
#pragma unroll
  for (int lj = 3; lj >= 0; --lj) {
    const int j = 1 << lj;
#pragma unroll
    for (int i = 0; i < 16; ++i) {
      const int l = i ^ j;
      if (l > i) ce_desc(a[i], a[l]);
    }
  }
}
template <int CTRL>
DEVINL uint32_t dpp_u(uint32_t x) { return (uint32_t)__builtin_amdgcn_update_dpp(0, (int)x, CTRL, 0xF, 0xF, true); }

constexpr int RS = 133;
DEVINL void peer_route_a(const Params& p, const u16* qp, float* lv, int* li, char* smem) {
  const int tid = threadIdx.x, lane = tid & 63, wid = tid >> 6;
  const int fr = lane & 15, fq = lane >> 4;
  const int role = blockIdx.x & 1;
  const int nblk = gridDim.x >> 1, bidx = blockIdx.x >> 1;
  u16(*sK)[136] = (u16(*)[136])smem;
  float* sS = (float*)(smem + 128 * 136 * 2);
  __syncthreads();
  {
    const u16* kb = role ? p.k2b : p.k1b;
    for (int c = tid; c < 128 * 16; c += 256) {
      const int r = c >> 4, ch = c & 15;
      *(u32x4*)&sK[r][ch * 8] = *(const u32x4*)(kb + r * 128 + ch * 8);
    }
  }
  __syncthreads();
  float* lvr = lv + (size_t)role * T * 128;
  int* lir = li + (size_t)role * T * 128;
  for (int unit = bidx; unit < 4096; unit += nblk) {
    const int tok0 = (unit >> 1) * 16, hsel = unit & 1;
    const int head = hsel * 4 + wid;
    bf16x8 af[4];
#pragma unroll
    for (int ks = 0; ks < 4; ++ks)
      af[ks] = *(const bf16x8*)(qp + (size_t)(tok0 + fr) * 2048 + head * 256 + role * 128 + ks * 32 + fq * 8);
    __syncthreads();
#pragma unroll
    for (int nt = 0; nt < 8; ++nt) {
      f32x4 a = {0.f, 0.f, 0.f, 0.f};
#pragma unroll
      for (int ks = 0; ks < 4; ++ks) {
        bf16x8 bfg = *(const bf16x8*)&sK[nt * 16 + fr][ks * 32 + fq * 8];
        a = __builtin_amdgcn_mfma_f32_16x16x32_bf16(af[ks], bfg, a, 0, 0, 0);
      }
      const int key = nt * 16 + fr;
#pragma unroll
      for (int j = 0; j < 4; ++j) sS[(wid * 16 + fq * 4 + j) * RS + (key >> 5) * 33 + (key & 31)] = a[j];
    }
    __syncthreads();
    const int inst = tid >> 2, part = tid & 3;
    const float* row = sS + inst * RS;
    uint32_t top[16], grp[16];
#pragma unroll
    for (int i = 0; i < 16; ++i) {
      top[i] = (sortable(row[part * 33 + i]) & 0xFFFFFF80u) | (uint32_t)(127 - (part * 32 + i));
      grp[i] = (sortable(row[part * 33 + 16 + i]) & 0xFFFFFF80u) | (uint32_t)(127 - (part * 32 + 16 + i));
    }
    bitonic_sort_desc16(top);
    bitonic_sort_desc16(grp);
#pragma unroll
    for (int i = 0; i < 16; ++i) top[i] = max(top[i], grp[15 - i]);
    bitonic_merge_desc16(top);
#pragma unroll
    for (int i = 0; i < 16; ++i) grp[i] = dpp_u<0xB1>(top[i]);
#pragma unroll
    for (int i = 0; i < 16; ++i) top[i] = max(top[i], grp[15 - i]);
    bitonic_merge_desc16(top);
#pragma unroll
    for (int i = 0; i < 16; ++i) grp[i] = dpp_u<0x4E>(top[i]);
#pragma unroll
    for (int i = 0; i < 16; ++i) top[i] = max(top[i], grp[15 - i]);
    bitonic_merge_desc16(top);
    if (part == 0) {
      const int tk = inst & 15, hl = inst >> 4;
      const size_t ob = ((size_t)(tok0 + tk) * 8 + hsel * 4 + hl) * 16;
#pragma unroll
      for (int q4 = 0; q4 < 4; ++q4) {
        const int k0 = 127 - (int)(top[q4 * 4] & 127u), k1 = 127 - (int)(top[q4 * 4 + 1] & 127u);
        const int k2 = 127 - (int)(top[q4 * 4 + 2] & 127u), k3 = 127 - (int)(top[q4 * 4 + 3] & 127u);
        *(float4*)(lvr + ob + q4 * 4) = make_float4(row[(k0 >> 5) * 33 + (k0 & 31)], row[(k1 >> 5) * 33 + (k1 & 31)],
                                                    row[(k2 >> 5) * 33 + (k2 & 31)], row[(k3 >> 5) * 33 + (k3 & 31)]);
        *(int4*)(lir + ob + q4 * 4) = make_int4(k0, k1, k2, k3);
      }
    }
  }
}

DEVINL void peer_route_b(const float* lv, const int* li, int* idx_out, float* gate_out) {
  const float* lv1 = lv; const float* lv2 = lv + (size_t)T * 128;
  const int* li1 = li; const int* li2 = li + (size_t)T * 128;
  for (size_t it = (size_t)blockIdx.x * 256 + threadIdx.x; it < (size_t)T * 8; it += (size_t)gridDim.x * 256) {
    const size_t ob = it * 16;
    float v1[16], v2[16];
#pragma unroll
    for (int q = 0; q < 4; ++q) {
      float4 a = *(const float4*)(lv1 + ob + q * 4), b = *(const float4*)(lv2 + ob + q * 4);
      v1[q * 4] = a.x; v1[q * 4 + 1] = a.y; v1[q * 4 + 2] = a.z; v1[q * 4 + 3] = a.w;
      v2[q * 4] = b.x; v2[q * 4 + 1] = b.y; v2[q * 4 + 2] = b.z; v2[q * 4 + 3] = b.w;
    }
    uint32_t top[16];
#pragma unroll
    for (int j = 0; j < 16; ++j) top[j] = 0u;
#pragma unroll
    for (int i = 0; i < 16; ++i)
#pragma unroll
      for (int j = 0; j < 16; ++j)
        if ((i + 1) * (j + 1) <= 16) {
          uint32_t key = (sortable(v1[i] + v2[j]) & 0xFFFFFF00u) | (uint32_t)(255 - (i * 16 + j));
#pragma unroll
          for (int s_ = 0; s_ < 16; ++s_) {
            uint32_t hi = max(top[s_], key);
            key = min(top[s_], key);
            top[s_] = hi;
          }
        }
    float val[16];
    int eid[16];
    float mx = -1e30f;
#pragma unroll
    for (int s_ = 0; s_ < 16; ++s_) {
      const int cidx = 255 - (int)(top[s_] & 255u);
      const int i = cidx >> 4, j = cidx & 15;
      val[s_] = lv1[ob + i] + lv2[ob + j];
      eid[s_] = li1[ob + i] * 128 + li2[ob + j];
      mx = fmaxf(mx, val[s_]);
    }
    float sum = 0.f;
#pragma unroll
    for (int s_ = 0; s_ < 16; ++s_) { val[s_] = __expf(val[s_] - mx); sum += val[s_]; }
    const float inv = 1.f / sum;
#pragma unroll
    for (int s4 = 0; s4 < 4; ++s4) {
      *(int4*)(idx_out + ob + s4 * 4) = make_int4(eid[s4 * 4], eid[s4 * 4 + 1], eid[s4 * 4 + 2], eid[s4 * 4 + 3]);
      *(float4*)(gate_out + ob + s4 * 4) = make_float4(val[s4 * 4] * inv, val[s4 * 4 + 1] * inv, val[s4 * 4 + 2] * inv, val[s4 * 4 + 3] * inv);
    }
  }
}

DEVINL void dec16(const uint2& w, f32x2 (&d)[8]) {
  d[0] = __builtin_amdgcn_cvt_scalef32_pk_f32_fp4(w.x, 1.0f, 0);
  d[1] = __builtin_amdgcn_cvt_scalef32_pk_f32_fp4(w.x, 1.0f, 1);
  d[2] = __builtin_amdgcn_cvt_scalef32_pk_f32_fp4(w.x, 1.0f, 2);
  d[3] = __builtin_amdgcn_cvt_scalef32_pk_f32_fp4(w.x, 1.0f, 3);
  d[4] = __builtin_amdgcn_cvt_scalef32_pk_f32_fp4(w.y, 1.0f, 0);
  d[5] = __builtin_amdgcn_cvt_scalef32_pk_f32_fp4(w.y, 1.0f, 1);
  d[6] = __builtin_amdgcn_cvt_scalef32_pk_f32_fp4(w.y, 1.0f, 2);
  d[7] = __builtin_amdgcn_cvt_scalef32_pk_f32_fp4(w.y, 1.0f, 3);
}

DEVINL void peer_gather(const Params& p, const u16* n2, const int* idx, const float* gate, u16* dry = nullptr) {
  const int lane = threadIdx.x & 63, wid = threadIdx.x >> 6;
  const int nw = gridDim.x * 4;
  const unsigned char* ub4 = (const unsigned char*)p.ub;
  const unsigned char* vb4 = (const unsigned char*)p.vb;
  for (int tok = blockIdx.x * 4 + wid; tok < T; tok += nw) {
    f32x2 xn[8], acc2[8];
    {
      const uint4* np = (const uint4*)(n2 + (size_t)tok * 1024 + lane * 16);
      uint4 a = np[0], c = np[1];
      uint32_t wv[8] = {a.x, a.y, a.z, a.w, c.x, c.y, c.z, c.w};
#pragma unroll
      for (int i = 0; i < 8; ++i) xn[i] = (f32x2){bflo(wv[i]), bfhi(wv[i])};
    }
#pragma unroll
    for (int i = 0; i < 8; ++i) acc2[i] = (f32x2){0.f, 0.f};
    const int id0 = idx[(size_t)tok * 128 + lane], id1 = idx[(size_t)tok * 128 + 64 + lane];
    const float g0 = gate[(size_t)tok * 128 + lane], g1 = gate[(size_t)tok * 128 + 64 + lane];
    const float us0 = p.usc[id0], us1 = p.usc[id1];
    const float gvs0 = g0 * p.vsc[id0], gvs1 = g1 * p.vsc[id1];
    const bool b3 = (lane & 8) != 0, b2 = (lane & 4) != 0, b1 = (lane & 2) != 0, b0 = (lane & 1) != 0;
#pragma unroll 1
    for (int e = 0; e < 128; e += 16) {
      const int idv = (e < 64) ? id0 : id1;
      const int eb = e & 63;
      uint2 ur[16], vr[16];
#pragma unroll
      for (int q = 0; q < 16; ++q) {
        const int id = __builtin_amdgcn_readlane(idv, eb + q);
        ur[q] = *(const uint2*)(ub4 + (size_t)id * 512 + lane * 8);
        vr[q] = *(const uint2*)(vb4 + (size_t)id * 512 + lane * 8);
      }
      float pr[16];
#pragma unroll
      for (int q = 0; q < 16; ++q) {
        f32x2 d[8];
        dec16(ur[q], d);
        f32x2 s0 = xn[0] * d[0], s1 = xn[1] * d[1];
        s0 = xn[2] * d[2] + s0; s1 = xn[3] * d[3] + s1;
        s0 = xn[4] * d[4] + s0; s1 = xn[5] * d[5] + s1;
        s0 = xn[6] * d[6] + s0; s1 = xn[7] * d[7] + s1;
        s0 = s0 + s1;
        pr[q] = s0[0] + s0[1];
      }
      float ra[8], rb[4], rc[2];
#pragma unroll
      for (int q = 0; q < 8; ++q) ra[q] = (b3 ? pr[q + 8] : pr[q]) + dpp_f<0x128>(b3 ? pr[q] : pr[q + 8]);
#pragma unroll
      for (int q = 0; q < 4; ++q) rb[q] = (b2 ? ra[q + 4] : ra[q]) + dpp_f<0x141>(b2 ? ra[q] : ra[q + 4]);
#pragma unroll
      for (int q = 0; q < 2; ++q) rc[q] = (b1 ? rb[q + 2] : rb[q]) + dpp_f<0x4E>(b1 ? rb[q] : rb[q + 2]);
      float mine = (b0 ? rc[1] : rc[0]) + dpp_f<0xB1>(b0 ? rc[0] : rc[1]);
      mine += __shfl_xor(mine, 16);
      mine += __shfl_xor(mine, 32);
      const int sl = eb + (lane & 15);
      const float act = mine * __shfl((e < 64) ? us0 : us1, sl);
      const float coefv = __shfl((e < 64) ? gvs0 : gvs1, sl) * 0.5f * act * (1.f + erff(act * 0.7071067811865476f));
#pragma unroll
      for (int q = 0; q < 16; ++q) {
        const float coef = __int_as_float(__builtin_amdgcn_readlane(__float_as_int(coefv), q));
        const f32x2 c2 = {coef, coef};
        f32x2 d[8];
        dec16(vr[q], d);
#pragma unroll
        for (int i = 0; i < 8; ++i) acc2[i] = c2 * d[i] + acc2[i];
      }
    }
    float acc[16];
#pragma unroll
    for (int i = 0; i < 8; ++i) { acc[2 * i] = acc2[i][0]; acc[2 * i + 1] = acc2[i][1]; }
    const float* gt2 = p.mod + (tok >> 11) * 6144 + 5120 + lane * 16;
    float* op = p.out + (size_t)tok * 1024 + lane * 16;
#pragma unroll
    for (int i = 0; i < 4; ++i) {
      float4 hv = *(const float4*)(op + i * 4);
      float4 gv4 = *(const float4*)(gt2 + i * 4);
      hv.x += gv4.x * acc[i * 4]; hv.y += gv4.y * acc[i * 4 + 1];
      hv.z += gv4.z * acc[i * 4 + 2]; hv.w += gv4.w * acc[i * 4 + 3];
      if (dry) {
        uint2 o; o.x = pack2(hv.x, hv.y); o.y = pack2(hv.z, hv.w);
        *(uint2*)(dry + (size_t)tok * 1024 + lane * 16 + i * 4) = o;
      } else {
        *(float4*)(op + i * 4) = hv;
      }
    }
  }
}


#define XB_TMO      128
#define XB_XCNT(j)  (256  + 64 * (j))
#define XB_XSUB(j)  (1280 + 64 * (j))
#define XB_XGEN(j)  (2304 + 64 * (j))
#define XB_TOP      3328
#define XB_TOPGEN   3392
#define XCD_BAR_WORDS 3456
#define XB_SPIN_CAP (1u << 18)
#define LAS __attribute__((address_space(3)))
DEVINL unsigned xb_ld(unsigned* p) { return __hip_atomic_load(p, __ATOMIC_RELAXED, __HIP_MEMORY_SCOPE_AGENT); }
DEVINL unsigned xb_add(unsigned* p, unsigned v) { return __hip_atomic_fetch_add(p, v, __ATOMIC_RELAXED, __HIP_MEMORY_SCOPE_AGENT); }
DEVINL unsigned xb_xcc_id() { return (unsigned)__builtin_amdgcn_s_getreg((3 << 11) | 20) & 0xFu; }
#define XB_SPIN(cond, bar) do { unsigned _sp = 0; while (cond) { __builtin_amdgcn_s_sleep(1); \
    if ((++_sp & 255u) == 0u) { if (xb_ld(&(bar)[XB_TMO])) break; if (_sp > XB_SPIN_CAP) { atomicAdd(&(bar)[XB_TMO], 1u); break; } } } } while (0)
struct XcdBarrier { unsigned* bar; unsigned x; volatile LAS unsigned* st; };
DEVINL XcdBarrier xcd_barrier_post(unsigned* bar, volatile LAS unsigned* st) {
  XcdBarrier b; b.bar = bar; b.x = xb_xcc_id(); b.st = st;
  if (threadIdx.x == 0) (void)xb_add(&bar[XB_XCNT(b.x)], 1u);
  return b;
}
DEVINL void xcd_barrier_complete(unsigned* bar, unsigned x, unsigned& nloc, unsigned& nx) {
  const unsigned G = gridDim.x * gridDim.y * gridDim.z;
  unsigned sum, cnt, mine, sp = 0u;
  for (;;) {
    sum = 0u; cnt = 0u; mine = 0u;
#pragma unroll
    for (unsigned j = 0; j < 16; ++j) { const unsigned c = xb_ld(&bar[XB_XCNT(j)]); sum += c; cnt += (c > 0u) ? 1u : 0u; mine = (j == x) ? c : mine; }
    if (sum == G) break;
    __builtin_amdgcn_s_sleep(1);
    if ((++sp & 255u) == 0u) { if (xb_ld(&bar[XB_TMO])) break; if (sp > XB_SPIN_CAP) { atomicAdd(&bar[XB_TMO], 1u); break; } }
  }
  nloc = mine > 0u ? mine : 1u; nx = cnt > 0u ? cnt : 1u;
}
DEVINL void xcd_barrier(const XcdBarrier& b) {
  asm volatile("s_waitcnt vmcnt(0)" ::: "memory");
  __syncthreads();
  if (threadIdx.x == 0) {
    unsigned* bar = b.bar;
    __builtin_amdgcn_s_waitcnt(0);
    unsigned nloc = b.st[0], nx = b.st[1];
    if (nloc == 0u) { xcd_barrier_complete(bar, b.x, nloc, nx); b.st[0] = nloc; b.st[1] = nx; }
    const unsigned old = xb_add(&bar[XB_XSUB(b.x)], 1u);
    const unsigned gen = old / nloc;
    if (old + 1u == (gen + 1u) * nloc) {
      __builtin_amdgcn_fence(__ATOMIC_RELEASE, "agent");
      asm volatile("s_waitcnt vmcnt(0)" ::: "memory");
      const unsigned og = xb_add(&bar[XB_TOP], 1u);
      const unsigned tg = og / nx;
      if (og + 1u == (tg + 1u) * nx) xb_add(&bar[XB_TOPGEN], 1u);
      else XB_SPIN(xb_ld(&bar[XB_TOPGEN]) == tg, bar);
      __builtin_amdgcn_fence(__ATOMIC_ACQUIRE, "agent");
      xb_add(&bar[XB_XGEN(b.x)], 1u);
      asm volatile("s_waitcnt vmcnt(0)" ::: "memory");
    } else {
      XB_SPIN(xb_ld(&bar[XB_XGEN(b.x)]) == gen, bar);
      __builtin_amdgcn_fence(__ATOMIC_ACQUIRE, "agent");
      asm volatile("s_waitcnt vmcnt(0)" ::: "memory");
    }
  }
  __syncthreads();
}

DEVINL void run_phase(const Params& p, int ph, char* smem, int cu_role = 0) {
  const int G = gridDim.x;
  u16* merged = p.z_rkv;
  u16* qpeer = p.z_rkv;
  int* pidx = (int*)p.z_attn;
  float* pgate = (float*)(p.z_attn + (size_t)T * 128 * 2);
  float* plv = (float*)((char*)p.z_attn + (size_t)T * 128 * 8);
  int* pli = (int*)((char*)p.z_attn + (size_t)T * 128 * 16);
  u16* X = (u16*)((char*)p.ub + (size_t)16384 * 1024);
  switch (ph) {
    case 0: phase0(p, smem); break;
    case 1:
      norm_rows_fp8(p);
      for (int t = blockIdx.x; t < 1920; t += G) transpose_tile_fp8(p, t, smem);
      break;
    case 2: {
      if (cu_role & 1) __builtin_amdgcn_s_sleep(22);
      Epi1 e{p};
      for_tiles(256, 60, [&](int mt, int nt) { gemm_tile<true>(p.bufB, 1024, p.w_in_t, 1024, 1024, mt * 128, nt * 128, smem, e); });
    } break;
    case 3: {
      int* sh = (int*)smem;
      const int role = cu_role;
      for (int pass = 0; pass < 2; ++pass) {
        const bool do_scan = (pass == 0) == (role == 0);
        if (do_scan) {
          for (;;) {
            __syncthreads();
            if (threadIdx.x == 0) sh[1] = atomicAdd(&p.ctr[2048], 1);
            __syncthreads();
            const int u = sh[1];
            if (u >= 256) break;
            rwkv_scan_unit(p, X, u, smem);
          }
        } else {
          for (;;) {
            __syncthreads();
            if (threadIdx.x == 0) sh[1] = atomicAdd(&p.ctr[2049], 1);
            __syncthreads();
            const int u = sh[1];
            if (u >= 6144) break;
            attn_unit(p, u, smem);
          }
          if (pass == 0) { late_transpose_queue(p, smem); cvt_fp4_queue(p, smem); }
        }
      }
      late_transpose_queue(p, smem);
      cvt_fp4_queue(p, smem);
    } break;
    case 4: attn_merge(p); break;
    case 15: prep_phase(p, X); break;
    case 5: {
      if (cu_role & 1) __builtin_amdgcn_s_sleep(22);
      Epi5a ea{p, merged};
      Epi5b eb{p, merged};
      for_tiles(256, 8, [&](int mt, int nt) {
        gemm_tile(p.bufB, 1024, p.w_br_r_t, 1024, 1024, mt * 128, nt * 128, smem, ea);
        gemm_tile(p.z_lora, 256, p.w_br_a_t, 256, 256, mt * 128, nt * 128, smem, eb);
      });
    } break;
    case 6: {
      if (cu_role & 1) __builtin_amdgcn_s_sleep(22);
      Epi6 e{p};
      for_tiles(256, 8, [&](int mt, int nt) { gemm_tile(merged, 1024, p.w_out_t, 1024, 1024, mt * 128, nt * 128, smem, e); });
    } break;
    case 7: norm_rows(p.out, p.norm2_g, p.mod, 3072, 4096, p.bufB); break;
    case 8: {
      if (cu_role & 1) __builtin_amdgcn_s_sleep(22);
      Epi8 e{qpeer};
      for_tiles(256, 16, [&](int mt, int nt) { gemm_tile(p.bufB, 1024, p.wq_t, 1024, 1024, mt * 128, nt * 128, smem, e); });
    } break;
    case 9:
      peer_route_a(p, qpeer, plv, pli, smem);
      break;
    case 16: peer_route_b(plv, pli, pidx, pgate); break;
    case 10: peer_gather(p, p.bufB, pidx, pgate); break;
    case 11: peer_gather(p, p.bufB, pidx, pgate, p.z_rkv + (size_t)T * 2048); break;
  }
}
constexpr int NPHASE = 11;

#if MULTI
__global__ void __launch_bounds__(256, 2) phase_kernel(Params p, int ph) {
  __shared__ __attribute__((aligned(16))) char smem[SMEM_BYTES];
  run_phase(p, ph, smem);
}
#else
__global__ void __launch_bounds__(256, 2) mega_kernel(Params p) {
  __shared__ __attribute__((aligned(16))) char smem[SMEM_BYTES];
  __shared__ uint4 xb_words;
  cg::grid_group grid = cg::this_grid();
  if (threadIdx.x == 0) xb_words = make_uint4(0u, 0u, 0u, 0u);
  __syncthreads();
  __shared__ int cu_role_s;
  if (threadIdx.x == 0) {
    unsigned cu = __builtin_amdgcn_s_getreg(0x3A04);
    unsigned xcc = __builtin_amdgcn_s_getreg(0x1814);
    cu_role_s = atomicAdd(&p.ctr[(xcc & 7) * 256 + (cu & 255)], 1);
  }
  __syncthreads();
  const int cu_role = cu_role_s;
  XcdBarrier xb = xcd_barrier_post(p.bar, (volatile LAS unsigned*)&xb_words);
#define SYNC() xcd_barrier(xb)
  if (p.x == nullptr) grid.sync();
  run_phase(p, 0, smem, cu_role); SYNC();
  if (DUP == 0) { run_phase(p, 0, smem, cu_role); SYNC(); }
  run_phase(p, 1, smem, cu_role); SYNC();
  if (DUP == 1) { run_phase(p, 1, smem, cu_role); SYNC(); }
  run_phase(p, 2, smem, cu_role); SYNC();
  run_phase(p, 15, smem, cu_role); SYNC();
  if (DUP == 2) { run_phase(p, 2, smem, cu_role); SYNC(); }
  run_phase(p, 3, smem, cu_role); SYNC();
  run_phase(p, 4, smem, cu_role); SYNC();
  if (DUP == 4) { run_phase(p, 4, smem, cu_role); SYNC(); }
  run_phase(p, 5, smem, cu_role); SYNC();
  if (DUP == 5) { run_phase(p, 5, smem, cu_role); SYNC(); }
  run_phase(p, 6, smem, cu_role); SYNC();
  if (DUP == 6) { run_phase(p, 6, smem, cu_role); SYNC(); }
  run_phase(p, 7, smem, cu_role); SYNC();
  if (DUP == 7) { run_phase(p, 7, smem, cu_role); SYNC(); }
  run_phase(p, 8, smem, cu_role); SYNC();
  if (DUP == 8) { run_phase(p, 8, smem, cu_role); SYNC(); }
  run_phase(p, 9, smem, cu_role); SYNC();
  run_phase(p, 16, smem, cu_role); SYNC();
  if (DUP == 9) { run_phase(p, 9, smem, cu_role); SYNC(); }
  if (DUP == 10) { run_phase(p, 11, smem, cu_role); SYNC(); }
  run_phase(p, 10, smem, cu_role);
}
#endif

extern "C" void kernel_launch(void* const* d_in, const int* in_sizes, int n_in, void* d_out, int out_size, void* d_ws,
                              size_t ws_size, hipStream_t stream) {
  Params p{};
  const float** pf = (const float**)&p;
  for (int i = 0; i < 28; ++i) pf[i] = (const float*)d_in[i];
  p.out = (float*)d_out;
  char* ws = (char*)d_ws;
  size_t off = 0;
  auto take = [&](size_t bytes) { char* r = ws + off; off += (bytes + 255) & ~(size_t)255; return r; };
  p.w_in_t = (u16*)take((size_t)7680 * 1024 * 2);
  p.w_br_r_t = (u16*)take((size_t)1024 * 1024 * 2);
  p.w_br_a_t = (u16*)take((size_t)1024 * 256 * 2);
  p.w_out_t = (u16*)take((size_t)1024 * 1024 * 2);
  p.wq_t = (u16*)take((size_t)2048 * 1024 * 2);
  p.k1b = (u16*)take(128 * 128 * 2);
  p.k2b = (u16*)take(128 * 128 * 2);
  p.w2t = (u16*)take(1024 * 64 * 2);
  p.a2t = (u16*)take(1024 * 64 * 2);
  p.g2t = (u16*)take(1024 * 128 * 2);
  p.mod = (float*)take(16 * 6144 * 4);
  p.lse = (float*)take((size_t)3 * T * 4 * 4);
  p.bar = (unsigned*)take(4096 * 4);
  p.ctr = (int*)take(4096 * 4);
  p.colamax = (int*)take(8192 * 4);
  p.n1s = (float*)take((size_t)T * 4);
  p.w_in_s = (float*)take(8192 * 4);
  p.usc = (float*)take(16384 * 4);
  p.vsc = (float*)take(16384 * 4);
  p.bufB = (u16*)take((size_t)T * 1024 * 2);
  p.z_rkv = (u16*)take((size_t)T * 3072 * 2);
  p.z_lora = (u16*)take((size_t)T * 256 * 2);
  p.z_attn = (u16*)take((size_t)T * 2304 * 2);
  p.ub = (u16*)take((size_t)16384 * 1024 * 2);
  p.vb = (u16*)take((size_t)16384 * 1024 * 2);
  p.gates = (u16*)d_out;
  if (off > ws_size) { fprintf(stderr, "workspace too small: need %zu have %zu\n", off, ws_size); return; }
#if MULTI
  (void)hipMemsetAsync(p.bar, 0, 4 * 4096 * 4, stream);
  for (int ph = 0; ph < NPHASE; ++ph) phase_kernel<<<512, 256, 0, stream>>>(p, ph);
#else
  static int grid_blocks = 0;
  if (!grid_blocks) {
    int dev = 0, cus = 0, per_cu = 0;
    hipGetDevice(&dev);
    hipDeviceGetAttribute(&cus, hipDeviceAttributeMultiprocessorCount, dev);
    hipOccupancyMaxActiveBlocksPerMultiprocessor(&per_cu, mega_kernel, 256, 0);
    if (per_cu > 2) per_cu = 2;
    grid_blocks = cus * per_cu;
  }
  (void)hipMemsetAsync(p.bar, 0, 4 * 4096 * 4, stream);
  void* args[] = {&p};
  hipError_t e = hipLaunchCooperativeKernel((void*)mega_kernel, dim3(grid_blocks), dim3(256), args, 0, stream);
  if (e != hipSuccess) fprintf(stderr, "cooperative launch failed: %s (grid %d)\n", hipGetErrorString(e), grid_blocks);
#endif
}
```

```cpp
#include <hip/hip_runtime.h>
#include <hip/hip_cooperative_groups.h>
#include <cstdio>
#include <cstdint>
namespace cg = cooperative_groups;

#ifndef MULTI
#define MULTI 0
#endif
#ifndef DUP
#define DUP -1
#endif

typedef unsigned short u16;
using bf16x8 = __attribute__((ext_vector_type(8))) short;
using bf16x4 = __attribute__((ext_vector_type(4))) short;
using f32x4  = __attribute__((ext_vector_type(4))) float;
using u32x4  = __attribute__((ext_vector_type(4))) unsigned int;
using u32x2  = __attribute__((ext_vector_type(2))) unsigned int;
using f32x2  = __attribute__((ext_vector_type(2))) float;

#define DEVINL __device__ __forceinline__

constexpr int T = 32768;
constexpr int SMEM_BYTES = 79872;

struct Params {
  const float *x, *c, *w_ada, *b_ada, *norm1_g, *w_in, *mu, *w0, *w2, *a0, *a2, *g2, *k_k, *k_a, *r_k,
      *lnx_g, *lnx_b, *qng, *kng, *w_br_r, *w_br_a, *w_out, *norm2_g, *wq, *k1, *k2, *pu, *pv;
  float* out;
  u16 *w_in_t, *w_br_r_t, *w_br_a_t, *w_out_t, *wq_t, *k1b, *k2b, *w2t, *a2t, *g2t;
  float *mod, *lse, *usc, *vsc, *n1s, *w_in_s;
  int* colamax;
  unsigned* bar;
  int* ctr;
  u16 *bufB, *z_rkv, *z_lora, *z_attn, *ub, *vb, *gates;
};

DEVINL u16 f2bf(float f) {
  uint32_t u = __float_as_uint(f);
  u += 0x7fffu + ((u >> 16) & 1u);
  return (u16)(u >> 16);
}
DEVINL float bf2f(u16 h) { return __uint_as_float(((uint32_t)h) << 16); }
typedef __bf16 hwbf16x2 __attribute__((ext_vector_type(2)));
DEVINL uint32_t pack2(float a, float b) {
  f32x2 v = {a, b};
  hwbf16x2 r = __builtin_convertvector(v, hwbf16x2);
  return *(uint32_t*)&r;
}
DEVINL float bflo(uint32_t u) { return __uint_as_float(u << 16); }
DEVINL float bfhi(uint32_t u) { return __uint_as_float(u & 0xffff0000u); }
DEVINL float sigm(float x) { return 1.f / (1.f + __expf(-x)); }
template <int CTRL>
DEVINL float dpp_f(float x) {
  return __int_as_float(__builtin_amdgcn_update_dpp(0, __float_as_int(x), CTRL, 0xF, 0xF, true));
}
DEVINL float quad_sum(float v) {
  v += dpp_f<0xB1>(v);
  v += dpp_f<0x4E>(v);
  return v;
}
DEVINL float row16_sum(float v) {
  v += dpp_f<0x128>(v); v += dpp_f<0x124>(v); v += dpp_f<0x122>(v); v += dpp_f<0x121>(v);
  return v;
}
DEVINL float oct_sum(float v) {
  v += dpp_f<0xB1>(v);
  v += dpp_f<0x4E>(v);
  v += dpp_f<0x141>(v);
  return v;
}
DEVINL float row16_max(float v) {
  v = fmaxf(v, dpp_f<0x128>(v)); v = fmaxf(v, dpp_f<0x124>(v)); v = fmaxf(v, dpp_f<0x122>(v)); v = fmaxf(v, dpp_f<0x121>(v));
  return v;
}
DEVINL float wave_sum(float v) {
  v = row16_sum(v);
  v += __shfl_xor(v, 16);
  v += __shfl_xor(v, 32);
  return v;
}
DEVINL float wave_max(float v) {
  v = row16_max(v);
  v = fmaxf(v, __shfl_xor(v, 16));
  v = fmaxf(v, __shfl_xor(v, 32));
  return v;
}

DEVINL void p0_mod_unit(const Params& p, int unit, char* smem) {
  float* sC = (float*)smem;
  const int tid = threadIdx.x, lane = tid & 63, wid = tid >> 6;
  __syncthreads();
  for (int e = tid; e < 16 * 1024; e += 256) {
    int b = e >> 10, k = e & 1023;
    float v = p.c[e];
    sC[k * 16 + b] = v / (1.f + __expf(-v));
  }
  __syncthreads();
  const int col = unit * 64 + lane;
  float acc[16];
#pragma unroll
  for (int b = 0; b < 16; ++b) acc[b] = 0.f;
  const float* wp = p.w_ada + (size_t)(wid * 256) * 6144 + col;
#pragma unroll 16
  for (int k = 0; k < 256; ++k) {
    float wv = wp[(size_t)k * 6144];
    const float4* s4 = (const float4*)(sC + (wid * 256 + k) * 16);
    float4 s0 = s4[0], s1 = s4[1], s2 = s4[2], s3 = s4[3];
    acc[0] += s0.x * wv; acc[1] += s0.y * wv; acc[2] += s0.z * wv; acc[3] += s0.w * wv;
    acc[4] += s1.x * wv; acc[5] += s1.y * wv; acc[6] += s1.z * wv; acc[7] += s1.w * wv;
    acc[8] += s2.x * wv; acc[9] += s2.y * wv; acc[10] += s2.z * wv; acc[11] += s2.w * wv;
    acc[12] += s3.x * wv; acc[13] += s3.y * wv; acc[14] += s3.z * wv; acc[15] += s3.w * wv;
  }
  __syncthreads();
  float* sR = (float*)smem;
#pragma unroll
  for (int b = 0; b < 16; ++b) sR[(wid * 16 + b) * 64 + lane] = acc[b];
  __syncthreads();
  for (int e = tid; e < 1024; e += 256) {
    int b = e >> 6, l = e & 63;
    float s = sR[(b)*64 + l] + sR[(16 + b) * 64 + l] + sR[(32 + b) * 64 + l] + sR[(48 + b) * 64 + l];
    int cc = unit * 64 + l;
    p.mod[b * 6144 + cc] = s + p.b_ada[cc];
  }
}

DEVINL void transpose_tile(const float* __restrict__ src, int K, int N, u16* __restrict__ dst, int tile, char* smem) {
  float(*s)[65] = (float(*)[65])smem;
  const int tid = threadIdx.x;
  const int nkt = K >> 6;
  const int kt = tile % nkt, nt = tile / nkt;
  __syncthreads();
#pragma unroll
  for (int i = 0; i < 16; ++i) {
    int r = (tid >> 6) + 4 * i;
    s[r][tid & 63] = src[(size_t)(kt * 64 + r) * N + nt * 64 + (tid & 63)];
  }
  __syncthreads();
#pragma unroll
  for (int i = 0; i < 16; ++i) {
    int n = (tid >> 6) + 4 * i;
    dst[(size_t)(nt * 64 + n) * K + kt * 64 + (tid & 63)] = f2bf(s[tid & 63][n]);
  }
}

DEVINL void cvt_straight(const float* __restrict__ src, u16* __restrict__ dst, size_t n4, size_t start, size_t stride) {
  for (size_t i = start; i < n4; i += stride) {
    float4 v = ((const float4*)src)[i];
    uint2 o; o.x = pack2(v.x, v.y); o.y = pack2(v.z, v.w);
    ((uint2*)dst)[i] = o;
  }
}

DEVINL void cvt_row_fp4(const float* __restrict__ src, unsigned char* __restrict__ dst, float* __restrict__ inv_scale, int row) {
  const int lane = threadIdx.x & 63;
  {
    const float4* sp = (const float4*)(src + (size_t)row * 1024 + lane * 16);
    float4 v0 = sp[0], v1 = sp[1], v2 = sp[2], v3 = sp[3];
    float am = fmaxf(fmaxf(fmaxf(fabsf(v0.x), fabsf(v0.y)), fmaxf(fabsf(v0.z), fabsf(v0.w))),
                     fmaxf(fmaxf(fabsf(v1.x), fabsf(v1.y)), fmaxf(fabsf(v1.z), fabsf(v1.w))));
    am = fmaxf(am, fmaxf(fmaxf(fmaxf(fabsf(v2.x), fabsf(v2.y)), fmaxf(fabsf(v2.z), fabsf(v2.w))),
                         fmaxf(fmaxf(fabsf(v3.x), fabsf(v3.y)), fmaxf(fabsf(v3.z), fabsf(v3.w)))));
    am = wave_max(am);
    const float sc = (am > 0.f) ? 6.f / am : 1.f;
    const float inv = (am > 0.f) ? am * (1.f / 6.f) : 1.f;
    unsigned w0 = 0, w1 = 0;
    w0 = __builtin_amdgcn_cvt_scalef32_pk_fp4_f32(w0, v0.x * sc, v0.y * sc, 1.0f, 0);
    w0 = __builtin_amdgcn_cvt_scalef32_pk_fp4_f32(w0, v0.z * sc, v0.w * sc, 1.0f, 1);
    w0 = __builtin_amdgcn_cvt_scalef32_pk_fp4_f32(w0, v1.x * sc, v1.y * sc, 1.0f, 2);
    w0 = __builtin_amdgcn_cvt_scalef32_pk_fp4_f32(w0, v1.z * sc, v1.w * sc, 1.0f, 3);
    w1 = __builtin_amdgcn_cvt_scalef32_pk_fp4_f32(w1, v2.x * sc, v2.y * sc, 1.0f, 0);
    w1 = __builtin_amdgcn_cvt_scalef32_pk_fp4_f32(w1, v2.z * sc, v2.w * sc, 1.0f, 1);
    w1 = __builtin_amdgcn_cvt_scalef32_pk_fp4_f32(w1, v3.x * sc, v3.y * sc, 1.0f, 2);
    w1 = __builtin_amdgcn_cvt_scalef32_pk_fp4_f32(w1, v3.z * sc, v3.w * sc, 1.0f, 3);
    *(uint2*)(dst + (size_t)row * 512 + lane * 8) = make_uint2(w0, w1);
    if (lane == 0) inv_scale[row] = inv;
  }
}

DEVINL void cvt_fp4_queue(const Params& p, char* smem) {
  int* sh = (int*)smem;
  const int wid = threadIdx.x >> 6;
  for (;;) {
    __syncthreads();
    if (threadIdx.x == 0) sh[0] = atomicAdd(&p.ctr[2050], 1);
    __syncthreads();
    const int c = sh[0];
    if (c >= 2048) break;
    const bool isv = c >= 1024;
    const int r0 = (c & 1023) * 16 + wid * 4;
#pragma unroll
    for (int i = 0; i < 4; ++i)
      cvt_row_fp4(isv ? p.pv : p.pu, (unsigned char*)(isv ? p.vb : p.ub), isv ? p.vsc : p.usc, r0 + i);
  }
}

DEVINL void late_transpose_queue(const Params& p, char* smem) {
  int* sh = (int*)(smem + 64 * 65 * 4);
  for (;;) {
    __syncthreads();
    if (threadIdx.x == 0) sh[0] = atomicAdd(&p.ctr[2051], 1);
    __syncthreads();
    int t = sh[0];
    if (t >= 1088) break;
    if (t < 256) { transpose_tile(p.w_br_r, 1024, 1024, p.w_br_r_t, t, smem); continue; } t -= 256;
    if (t < 64) { transpose_tile(p.w_br_a, 256, 1024, p.w_br_a_t, t, smem); continue; } t -= 64;
    if (t < 256) { transpose_tile(p.w_out, 1024, 1024, p.w_out_t, t, smem); continue; } t -= 256;
    transpose_tile(p.wq, 1024, 2048, p.wq_t, t, smem);
  }
}

DEVINL void phase0(const Params& p, char* smem) {
  const int G = gridDim.x;
  constexpr int NT0 = 120, NT5 = 16, NT6 = 16, NT7 = 32;
  constexpr int NTR = NT0 + NT5 + NT6 + NT7;
  for (int u = blockIdx.x; u < 96 + NTR; u += G) {
    if (u < 96) { p0_mod_unit(p, u, smem); continue; }
    int t = u - 96;
    if (t < NT0) {
      {
        const int nb = t >> 2, part = t & 3;
        const int n = nb * 256 + threadIdx.x;
        const float* wp = p.w_in + (size_t)(part * 256) * 7680 + n;
        float m = 0.f;
#pragma unroll 16
        for (int k = 0; k < 256; ++k) m = fmaxf(m, fabsf(wp[(size_t)k * 7680]));
        atomicMax(&p.colamax[n], __float_as_int(m));
      }
      continue;
    } t -= NT0;
    if (t < NT5) { transpose_tile(p.w2, 64, 1024, p.w2t, t, smem); continue; } t -= NT5;
    if (t < NT6) { transpose_tile(p.a2, 64, 1024, p.a2t, t, smem); continue; } t -= NT6;
    transpose_tile(p.g2, 128, 1024, p.g2t, t, smem);
  }
  size_t start = (size_t)blockIdx.x * 256 + threadIdx.x, stride = (size_t)G * 256;
  cvt_straight(p.k1, p.k1b, 128 * 128 / 4, start, stride);
  cvt_straight(p.k2, p.k2b, 128 * 128 / 4, start, stride);
}

DEVINL void norm_rows(const float* __restrict__ xin, const float* __restrict__ g, const float* __restrict__ mod,
                      int sh_off, int sc_off, u16* __restrict__ dst) {
  const int lane = threadIdx.x & 63, wid = threadIdx.x >> 6;
  const int nw = gridDim.x * 4;
  float4 v[4], nv[4];
  {
    const int r0 = blockIdx.x * 4 + wid;
    if (r0 < T) {
#pragma unroll
      for (int i = 0; i < 4; ++i) v[i] = ((const float4*)(xin + (size_t)r0 * 1024))[i * 64 + lane];
    }
  }
  for (int row = blockIdx.x * 4 + wid; row < T; row += nw) {
    if (row + nw < T) {
#pragma unroll
      for (int i = 0; i < 4; ++i) nv[i] = ((const float4*)(xin + (size_t)(row + nw) * 1024))[i * 64 + lane];
    }
    float ss = 0.f;
#pragma unroll
    for (int i = 0; i < 4; ++i) ss += v[i].x * v[i].x + v[i].y * v[i].y + v[i].z * v[i].z + v[i].w * v[i].w;
    ss = wave_sum(ss);
    const float rstd = rsqrtf(ss * (1.f / 1024.f) + 1e-6f);
    const float* mb = mod + (row >> 11) * 6144;
#pragma unroll
    for (int i = 0; i < 4; ++i) {
      int col = (i * 64 + lane) * 4;
      float4 gg = *(const float4*)(g + col);
      float4 sc = *(const float4*)(mb + sc_off + col);
      float4 sh = *(const float4*)(mb + sh_off + col);
      float o0 = v[i].x * rstd * gg.x * (1.f + sc.x) + sh.x;
      float o1 = v[i].y * rstd * gg.y * (1.f + sc.y) + sh.y;
      float o2 = v[i].z * rstd * gg.z * (1.f + sc.z) + sh.z;
      float o3 = v[i].w * rstd * gg.w * (1.f + sc.w) + sh.w;
      uint2 o; o.x = pack2(o0, o1); o.y = pack2(o2, o3);
      *(uint2*)(dst + (size_t)row * 1024 + col) = o;
    }
#pragma unroll
    for (int i = 0; i < 4; ++i) v[i] = nv[i];
  }
}


DEVINL void transpose_tile_fp8(const Params& p, int tile, char* smem) {
  float(*s)[65] = (float(*)[65])smem;
  const int tid = threadIdx.x;
  const int kt = tile & 15, nt = tile >> 4;
  unsigned char* dst = (unsigned char*)p.w_in_t;
  __syncthreads();
#pragma unroll
  for (int i = 0; i < 16; ++i) {
    int r = (tid >> 6) + 4 * i;
    s[r][tid & 63] = p.w_in[(size_t)(kt * 64 + r) * 7680 + nt * 64 + (tid & 63)];
  }
  __syncthreads();
  const int k4 = (tid & 15) * 4;
#pragma unroll
  for (int i = 0; i < 4; ++i) {
    const int n = (tid >> 4) + 16 * i;
    const float am = __int_as_float(p.colamax[nt * 64 + n]);
    const float sc = (am > 0.f) ? 224.f / am : 1.f;
    int w = 0;
    w = __builtin_amdgcn_cvt_pk_fp8_f32(s[k4][n] * sc, s[k4 + 1][n] * sc, w, false);
    w = __builtin_amdgcn_cvt_pk_fp8_f32(s[k4 + 2][n] * sc, s[k4 + 3][n] * sc, w, true);
    *(int*)(dst + (size_t)(nt * 64 + n) * 1024 + kt * 64 + k4) = w;
    if (kt == 0 && k4 == 0) p.w_in_s[nt * 64 + n] = (am > 0.f) ? am * (1.f / 224.f) : 1.f;
  }
}

DEVINL void norm_rows_fp8(const Params& p) {
  const int lane = threadIdx.x & 63, wid = threadIdx.x >> 6;
  const int nw = gridDim.x * 4;
  unsigned char* dst = (unsigned char*)p.bufB;
  float4 v[4], nv[4];
  {
    const int r0 = blockIdx.x * 4 + wid;
    if (r0 < T) {
#pragma unroll
      for (int i = 0; i < 4; ++i) v[i] = ((const float4*)(p.x + (size_t)r0 * 1024))[i * 64 + lane];
    }
  }
  for (int row = blockIdx.x * 4 + wid; row < T; row += nw) {
    if (row + nw < T) {
#pragma unroll
      for (int i = 0; i < 4; ++i) nv[i] = ((const float4*)(p.x + (size_t)(row + nw) * 1024))[i * 64 + lane];
    }
    float ss = 0.f;
#pragma unroll
    for (int i = 0; i < 4; ++i) ss += v[i].x * v[i].x + v[i].y * v[i].y + v[i].z * v[i].z + v[i].w * v[i].w;
    ss = wave_sum(ss);
    const float rstd = rsqrtf(ss * (1.f / 1024.f) + 1e-6f);
    const float* mb = p.mod + (row >> 11) * 6144;
    float o[16];
    float am = 0.f;
#pragma unroll
    for (int i = 0; i < 4; ++i) {
      int col = (i * 64 + lane) * 4;
      float4 gg = *(const float4*)(p.norm1_g + col);
      float4 sc = *(const float4*)(mb + 1024 + col);
      float4 sh = *(const float4*)(mb + col);
      o[i * 4 + 0] = v[i].x * rstd * gg.x * (1.f + sc.x) + sh.x;
      o[i * 4 + 1] = v[i].y * rstd * gg.y * (1.f + sc.y) + sh.y;
      o[i * 4 + 2] = v[i].z * rstd * gg.z * (1.f + sc.z) + sh.z;
      o[i * 4 + 3] = v[i].w * rstd * gg.w * (1.f + sc.w) + sh.w;
      am = fmaxf(am, fmaxf(fmaxf(fabsf(o[i * 4]), fabsf(o[i * 4 + 1])), fmaxf(fabsf(o[i * 4 + 2]), fabsf(o[i * 4 + 3]))));
    }
    am = wave_max(am);
    const float qs = (am > 0.f) ? 224.f / am : 1.f;
#pragma unroll
    for (int i = 0; i < 4; ++i) {
      int col = (i * 64 + lane) * 4;
      int w = 0;
      w = __builtin_amdgcn_cvt_pk_fp8_f32(o[i * 4] * qs, o[i * 4 + 1] * qs, w, false);
      w = __builtin_amdgcn_cvt_pk_fp8_f32(o[i * 4 + 2] * qs, o[i * 4 + 3] * qs, w, true);
      *(int*)(dst + (size_t)row * 1024 + col) = w;
    }
    if (lane == 0) p.n1s[row] = (am > 0.f) ? am * (1.f / 224.f) : 1.f;
#pragma unroll
    for (int i = 0; i < 4; ++i) v[i] = nv[i];
  }
}

#define LDS_AS __attribute__((address_space(3)))
using i64x2 = __attribute__((ext_vector_type(2))) long;
using v8i32 = __attribute__((ext_vector_type(8))) int;
using v4i32 = __attribute__((ext_vector_type(4))) int;
template <bool FP8 = false, class Epi>
DEVINL void gemm_tile(const void* __restrict__ A, int lda, const void* __restrict__ Bt, int ldb, int K, int m0, int n0,
                      char* smem, const Epi& epi) {
  constexpr int EB = FP8 ? 1 : 2;
  constexpr int KS = 128 / EB;
  constexpr int CE = 16 / EB;
  const int tid = threadIdx.x, lane = tid & 63, wid = tid >> 6;
  const int wr = wid >> 1, wc = wid & 1;
  const int fr = lane & 15, fq = lane >> 4;
  f32x4 acc[4][4];
#pragma unroll
  for (int m = 0; m < 4; ++m)
#pragma unroll
    for (int n = 0; n < 4; ++n) acc[m][n] = (f32x4){0.f, 0.f, 0.f, 0.f};
  const int l3 = lane >> 3, cch = (lane & 7) ^ l3;
  const char* Ab = (const char*)A + (size_t)m0 * lda * EB;
  const char* Bb = (const char*)Bt + (size_t)n0 * ldb * EB;
  const uint32_t aoff = (uint32_t)((wid * 32 + l3) * lda + cch * CE) * (uint32_t)EB;
  const uint32_t boff = (uint32_t)((16 * (lane >> 5) + (l3 & 3)) * ldb + cch * CE) * (uint32_t)EB;
  const int rowB_base = (wid >> 1) * 64 + 8 * (wid & 1);
  char* ldsw = smem + wid * 4096 + lane * 16;
#define DMA(buf, k0_)                                                                                           \
  _Pragma("unroll") for (int i = 0; i < 4; ++i) {                                                               \
    __builtin_amdgcn_global_load_lds((const unsigned*)(Ab + (size_t)((i * 8 * lda + (k0_)) * EB) + aoff),       \
                                     (LDS_AS unsigned*)(ldsw + (buf) * 32768 + i * 1024), 16, 0, 0);            \
    __builtin_amdgcn_global_load_lds(                                                                           \
        (const unsigned*)(Bb + (size_t)(((rowB_base + 32 * (i & 1) + 4 * (i >> 1)) * ldb + (k0_)) * EB) + boff), \
        (LDS_AS unsigned*)(ldsw + (buf) * 32768 + 16384 + i * 1024), 16, 0, 0);                                 \
  }
  const int ra0 = (wr * 64 + fr) * 128 + (((0 + fq) ^ (fr & 7)) << 4);
  const int ra1 = (wr * 64 + fr) * 128 + (((4 + fq) ^ (fr & 7)) << 4);
  const int rb0 = 16384 + (wc * 64 + fr) * 128 + (((0 + fq) ^ (fr & 7)) << 4);
  const int rb1 = 16384 + (wc * 64 + fr) * 128 + (((4 + fq) ^ (fr & 7)) << 4);
  const int qa0 = (wr * 64 + fr) * 128 + (((2 * fq) ^ (fr & 7)) << 4);
  const int qa1 = (wr * 64 + fr) * 128 + (((2 * fq + 1) ^ (fr & 7)) << 4);
  const int qb0 = 16384 + (wc * 64 + fr) * 128 + (((2 * fq) ^ (fr & 7)) << 4);
  const int qb1 = 16384 + (wc * 64 + fr) * 128 + (((2 * fq + 1) ^ (fr & 7)) << 4);
#define LD32(off0, off1, dst)                                        \
  {                                                                  \
    dst.lo = *(const v4i32*)(off0);                                  \
    dst.hi = *(const v4i32*)(off1);                                  \
  }
#define COMPUTE(buf)                                                                                        \
  if (FP8) {                                                                                                \
    v8i32 bfr[4];                                                                                           \
    _Pragma("unroll") for (int n = 0; n < 4; ++n) LD32(smem + (buf) * 32768 + qb0 + n * 2048, smem + (buf) * 32768 + qb1 + n * 2048, bfr[n])  \
    _Pragma("unroll") for (int m = 0; m < 4; ++m) {                                                         \
      v8i32 af;                                                                                             \
      LD32(smem + (buf) * 32768 + qa0 + m * 2048, smem + (buf) * 32768 + qa1 + m * 2048, af)                \
      _Pragma("unroll") for (int n = 0; n < 4; ++n)                                                         \
        acc[m][n] = __builtin_amdgcn_mfma_scale_f32_16x16x128_f8f6f4(bfr[n], af, acc[m][n], 0, 0, 0, 127, 0, 127); \
    }                                                                                                       \
    __builtin_amdgcn_sched_barrier(0);                                                                      \
  } else {                                                                                                  \
    _Pragma("unroll") for (int ks = 0; ks < 2; ++ks) {                                                      \
      bf16x8 af[4], bfr[4];                                                                                 \
      _Pragma("unroll") for (int m = 0; m < 4; ++m) af[m] = *(const bf16x8*)(smem + (buf) * 32768 + (ks ? ra1 : ra0) + m * 2048);  \
      _Pragma("unroll") for (int n = 0; n < 4; ++n) bfr[n] = *(const bf16x8*)(smem + (buf) * 32768 + (ks ? rb1 : rb0) + n * 2048); \
      _Pragma("unroll") for (int m = 0; m < 4; ++m)                                                         \
        _Pragma("unroll") for (int n = 0; n < 4; ++n)                                                       \
          acc[m][n] = __builtin_amdgcn_mfma_f32_16x16x32_bf16(bfr[n], af[m], acc[m][n], 0, 0, 0);           \
    }                                                                                                       \
  }
  __syncthreads();
  DMA(0, 0)
  __syncthreads();
#pragma unroll 1
  for (int k0 = 0; k0 < K; k0 += 2 * KS) {
    DMA(1, k0 + KS)
    COMPUTE(0)
    __syncthreads();
    if (k0 + 2 * KS < K) { DMA(0, k0 + 2 * KS) }
    COMPUTE(1)
    __syncthreads();
  }
#undef DMA
#undef COMPUTE
#undef LD32
#pragma unroll
  for (int m = 0; m < 4; ++m) {
    int row = m0 + wr * 64 + m * 16 + fr;
    int col0 = n0 + wc * 64 + fq * 16;
    epi(row, col0, acc[m]);
  }
}

DEVINL void store16_bf16(u16* dst, const f32x4 (&v)[4]) {
  uint4 a, b;
  a.x = pack2(v[0][0], v[0][1]); a.y = pack2(v[0][2], v[0][3]);
  a.z = pack2(v[1][0], v[1][1]); a.w = pack2(v[1][2], v[1][3]);
  b.x = pack2(v[2][0], v[2][1]); b.y = pack2(v[2][2], v[2][3]);
  b.z = pack2(v[3][0], v[3][1]); b.w = pack2(v[3][2], v[3][3]);
  ((uint4*)dst)[0] = a;
  ((uint4*)dst)[1] = b;
}

struct Epi1 {
  const Params& p;
  DEVINL void operator()(int row, int col, const f32x4 (&vin)[4]) const {
    f32x4 v[4];
    {
      const float sa = p.n1s[row];
      const float* sb = p.w_in_s + col;
#pragma unroll
      for (int n = 0; n < 4; ++n) {
        const float4 s4 = *(const float4*)(sb + n * 4);
        v[n][0] = vin[n][0] * sa * s4.x; v[n][1] = vin[n][1] * sa * s4.y;
        v[n][2] = vin[n][2] * sa * s4.z; v[n][3] = vin[n][3] * sa * s4.w;
      }
    }
    if (col < 3072) store16_bf16(p.z_rkv + (size_t)row * 3072 + col, v);
    else if (col < 3328) store16_bf16(p.z_lora + (size_t)row * 256 + (col - 3072), v);
    else if (col < 5632) store16_bf16(p.z_attn + (size_t)row * 2304 + (col - 3328), v);
    else {
      f32x4 s[4];
#pragma unroll
      for (int n = 0; n < 4; ++n)
#pragma unroll
        for (int j = 0; j < 4; ++j) s[n][j] = sigm(v[n][j]);
      store16_bf16(p.gates + (size_t)row * 2048 + (col - 5632), s);
    }
  }
};
struct Epi5a {
  const Params& p; u16* merged;
  DEVINL void operator()(int row, int col, const f32x4 (&v)[4]) const {
    const uint4* gp = (const uint4*)(p.gates + (size_t)row * 2048 + col);
    uint4 g0 = gp[0], g1 = gp[1];
    uint32_t gw[8] = {g0.x, g0.y, g0.z, g0.w, g1.x, g1.y, g1.z, g1.w};
    f32x4 s[4];
#pragma unroll
    for (int n = 0; n < 4; ++n) {
      s[n][0] = v[n][0] * bflo(gw[n * 2]); s[n][1] = v[n][1] * bfhi(gw[n * 2]);
      s[n][2] = v[n][2] * bflo(gw[n * 2 + 1]); s[n][3] = v[n][3] * bfhi(gw[n * 2 + 1]);
    }
    store16_bf16(merged + (size_t)row * 1024 + col, s);
  }
};
struct Epi5b {
  const Params& p; u16* merged;
  DEVINL void operator()(int row, int col, const f32x4 (&v)[4]) const {
    const uint4* gp = (const uint4*)(p.gates + (size_t)row * 2048 + 1024 + col);
    uint4 g0 = gp[0], g1 = gp[1];
    uint32_t gw[8] = {g0.x, g0.y, g0.z, g0.w, g1.x, g1.y, g1.z, g1.w};
    const uint4* tp = (const uint4*)(merged + (size_t)row * 1024 + col);
    uint4 t0 = tp[0], t1 = tp[1];
    uint32_t tw[8] = {t0.x, t0.y, t0.z, t0.w, t1.x, t1.y, t1.z, t1.w};
    f32x4 s[4];
#pragma unroll
    for (int n = 0; n < 4; ++n) {
      s[n][0] = bflo(tw[n * 2]) + v[n][0] * bflo(gw[n * 2]);
      s[n][1] = bfhi(tw[n * 2]) + v[n][1] * bfhi(gw[n * 2]);
      s[n][2] = bflo(tw[n * 2 + 1]) + v[n][2] * bflo(gw[n * 2 + 1]);
      s[n][3] = bfhi(tw[n * 2 + 1]) + v[n][3] * bfhi(gw[n * 2 + 1]);
    }
    store16_bf16(merged + (size_t)row * 1024 + col, s);
  }
};
struct Epi6 {
  const Params& p;
  DEVINL void operator()(int row, int col, const f32x4 (&v)[4]) const {
    const float* gt = p.mod + (row >> 11) * 6144 + 2048 + col;
    const float* xr = p.x + (size_t)row * 1024 + col;
    float* o = p.out + (size_t)row * 1024 + col;
#pragma unroll
    for (int n = 0; n < 4; ++n) {
      float4 xv = *(const float4*)(xr + n * 4);
      float4 gv = *(const float4*)(gt + n * 4);
      float4 r;
      r.x = xv.x + gv.x * v[n][0]; r.y = xv.y + gv.y * v[n][1];
      r.z = xv.z + gv.z * v[n][2]; r.w = xv.w + gv.w * v[n][3];
      *(float4*)(o + n * 4) = r;
    }
  }
};
struct Epi8 {
  u16* q;
  DEVINL void operator()(int row, int col, const f32x4 (&v)[4]) const { store16_bf16(q + (size_t)row * 2048 + col, v); }
};

template <class F>
DEVINL void for_tiles(int nM, int nN, const F& f) {
  const int G = gridDim.x;
  const int xcd = blockIdx.x & 7, slot = blockIdx.x >> 3, nslot = G >> 3;
  const int nSm = nM >> 3;
  const int nS = nSm * (nN >> 2);
  const int Ltot = (nS >> 3) * 32;
  for (int L = slot; L < Ltot; L += nslot) {
    int s = (L >> 5) * 8 + xcd;
    int w = L & 31;
    int sm = s % nSm, sn = s / nSm;
    int mt = sm * 8 + (w & 7), nt = sn * 4 + (w >> 3);
    f(mt, nt);
  }
}


DEVINL void prep_phase(const Params& p, u16* X) {
  const size_t gtid = (size_t)blockIdx.x * 256 + threadIdx.x, gstride = (size_t)gridDim.x * 256;
  for (size_t it = gtid; it < (size_t)T * 32; it += gstride) {
    const size_t tok = it >> 5;
    const int c8 = (int)(it & 31) * 8;
    const u16* zl = p.z_lora + tok * 256 + c8;
    uint4 cur = *(const uint4*)zl;
    uint4 prv = make_uint4(0, 0, 0, 0);
    if ((tok & 2047) != 0) prv = *(const uint4*)(zl - 256);
    const float4 m0 = *(const float4*)(p.mu + 3072 + c8), m1 = *(const float4*)(p.mu + 3072 + c8 + 4);
    const float mu8[8] = {m0.x, m0.y, m0.z, m0.w, m1.x, m1.y, m1.z, m1.w};
    const uint32_t cw[4] = {cur.x, cur.y, cur.z, cur.w}, pw[4] = {prv.x, prv.y, prv.z, prv.w};
    uint32_t o[4];
#pragma unroll
    for (int i = 0; i < 4; ++i) {
      float c0 = bflo(cw[i]), q0 = bflo(pw[i]), c1 = bfhi(cw[i]), q1 = bfhi(pw[i]);
      float a0 = c0 + (q0 - c0) * mu8[2 * i], a1 = c1 + (q1 - c1) * mu8[2 * i + 1];
      if (c8 < 64) {
        a0 = 1.f - 2.f / (__expf(2.f * a0) + 1.f);
        a1 = 1.f - 2.f / (__expf(2.f * a1) + 1.f);
      } else if (c8 >= 128) {
        a0 = sigm(a0); a1 = sigm(a1);
      }
      o[i] = pack2(a0, a1);
    }
    *(uint4*)(X + tok * 256 + c8) = make_uint4(o[0], o[1], o[2], o[3]);
  }
  float inv_f[8];
#pragma unroll
  for (int i = 0; i < 8; ++i) inv_f[i] = expf(-(float)i * (13.122363377404328f / 8.f));
  for (size_t it = gtid; it < (size_t)T * 96; it += gstride) {
    const size_t tok = it / 96;
    const int rem = (int)(it - tok * 96);
    const int hd = rem >> 2, qd = rem & 3;
    const int isk = hd >= 12;
    const int grp = (isk ? hd - 12 : hd) >> 2;
    u16* ptr = p.z_attn + tok * 2304 + hd * 64 + qd * 16;
    uint4 a = *(const uint4*)ptr, c = *(const uint4*)(ptr + 8);
    const uint32_t wv[8] = {a.x, a.y, a.z, a.w, c.x, c.y, c.z, c.w};
    float xv[16];
#pragma unroll
    for (int i = 0; i < 8; ++i) { xv[2 * i] = bflo(wv[i]); xv[2 * i + 1] = bfhi(wv[i]); }
    float ss = 0.f;
#pragma unroll
    for (int i = 0; i < 16; ++i) ss += xv[i] * xv[i];
    ss = quad_sum(ss);
    float rstd = rsqrtf(ss * (1.f / 64.f) + 1e-6f);
    if (!isk) rstd *= 0.125f;
    const float* gp = (isk ? p.kng : p.qng) + grp * 64 + qd * 16;
#pragma unroll
    for (int i = 0; i < 16; ++i) xv[i] = xv[i] * rstd * gp[i];
    if (qd == 0) {
      const float fp = (float)(tok & 2047);
#pragma unroll
      for (int i = 0; i < 8; ++i) {
        float ang = fp * inv_f[i];
        float n = rintf(ang * 0.15915494309189535f);
        float rr = fmaf(-n, 6.2831854820251465f, ang);
        rr = fmaf(-n, -1.7484555e-7f, rr);
        float cs = __cosf(rr), sn = __sinf(rr);
        float x1 = xv[i], x2 = xv[i + 8];
        xv[i] = x1 * cs - x2 * sn;
        xv[i + 8] = x2 * cs + x1 * sn;
      }
    }
    uint32_t o[8];
#pragma unroll
    for (int i = 0; i < 8; ++i) o[i] = pack2(xv[2 * i], xv[2 * i + 1]);
    *(uint4*)ptr = make_uint4(o[0], o[1], o[2], o[3]);
    *(uint4*)(ptr + 8) = make_uint4(o[4], o[5], o[6], o[7]);
  }
}

constexpr int TC = 16;
struct ScanLds {
  float w[TC][64], k[TC][64], a[TC][64], b[TC][64], r[TC][64], v[TC][64], y[TC][64];
  float bonus[TC];
  u16 g[TC][64];
  float cst[8][64];
  float mul[256];
  u16 xw[TC][72], xa[TC][72], xg[TC][136];
  u16 w2s[64][72], a2s[64][72], g2s[64][136];
};
static_assert(sizeof(ScanLds) <= 79872, "scan lds");

DEVINL void rwkv_scan_unit(const Params& p, const u16* X, int unit, char* smem) {
  ScanLds& L = *(ScanLds*)smem;
  const int tid = threadIdx.x, lane = tid & 63, wid = tid >> 6;
  const int b = unit >> 4, h = unit & 15;
  const int fr = lane & 15, fq = lane >> 4;
  const int pt = tid >> 4, pc = (tid & 15) * 4;
  const int rp = tid >> 3, cq = tid & 7;

  __syncthreads();
  {
    const float* srcs[8] = {p.mu + h * 64, p.mu + 1024 + h * 64, p.mu + 2048 + h * 64, p.k_k + h * 64,
                            p.k_a + h * 64, p.r_k + h * 64, p.lnx_g + h * 64, p.lnx_b + h * 64};
#pragma unroll
    for (int i = 0; i < 8; ++i)
      if (tid < 64) L.cst[i][tid] = srcs[i][tid];
    L.mul[tid] = p.mu[3072 + tid];
    const int c = tid >> 2, qq = tid & 3;
    const u16* w2p = p.w2t + (size_t)(h * 64 + c) * 64 + qq * 16;
    const u16* a2p = p.a2t + (size_t)(h * 64 + c) * 64 + qq * 16;
    const u16* g2p = p.g2t + (size_t)(h * 64 + c) * 128 + qq * 32;
    *(u32x4*)&L.w2s[c][qq * 16] = *(const u32x4*)w2p;
    *(u32x4*)&L.w2s[c][qq * 16 + 8] = *(const u32x4*)(w2p + 8);
    *(u32x4*)&L.a2s[c][qq * 16] = *(const u32x4*)a2p;
    *(u32x4*)&L.a2s[c][qq * 16 + 8] = *(const u32x4*)(a2p + 8);
#pragma unroll
    for (int i = 0; i < 4; ++i) *(u32x4*)&L.g2s[c][qq * 32 + i * 8] = *(const u32x4*)(g2p + i * 8);
  }
  const int chn = h * 64 + wid * 16 + fr;
  const float w0c = p.w0[chn], a0c = p.a0[chn];
  const int ec = h * 64 + pc;
  const int lc = (tid & 15) * 16;

  f32x2 S2[2][4];
#pragma unroll
  for (int r_ = 0; r_ < 2; ++r_)
#pragma unroll
    for (int j = 0; j < 4; ++j) S2[r_][j] = (f32x2){0.f, 0.f};

  const size_t tok0 = (size_t)b * 2048;
  uint2 pr0, pr1, pk0, pk1, pv0, pv1;
  uint4 pl0, pl1;
#define PREFETCH(t0_)                                                                                    \
  {                                                                                                      \
    const int t_ = (t0_) + pt;                                                                           \
    const u16* zr_ = p.z_rkv + (tok0 + t_) * 3072 + ec;                                                  \
    pr0 = *(const uint2*)(zr_); pk0 = *(const uint2*)(zr_ + 1024); pv0 = *(const uint2*)(zr_ + 2048);    \
    const u16* xl_ = X + (tok0 + t_) * 256 + lc;                                                         \
    pl0 = *(const uint4*)(xl_); pl1 = *(const uint4*)(xl_ + 8);                                          \
    if (t_ > 0) {                                                                                        \
      pr1 = *(const uint2*)(zr_ - 3072); pk1 = *(const uint2*)(zr_ - 3072 + 1024);                       \
      pv1 = *(const uint2*)(zr_ - 3072 + 2048);                                                          \
    } else {                                                                                             \
      pr1 = make_uint2(0, 0); pk1 = make_uint2(0, 0); pv1 = make_uint2(0, 0);                            \
    }                                                                                                    \
  }
  __syncthreads();
  PREFETCH(0)

  for (int t0 = 0; t0 < 2048; t0 += TC) {
    float r4[4], k4[4], v4[4];
    {
      const float4 mu_r = *(const float4*)&L.cst[0][pc], mu_k = *(const float4*)&L.cst[1][pc], mu_v = *(const float4*)&L.cst[2][pc];
      float c, q;
      c = bflo(pr0.x); q = bflo(pr1.x); r4[0] = c + (q - c) * mu_r.x;
      c = bfhi(pr0.x); q = bfhi(pr1.x); r4[1] = c + (q - c) * mu_r.y;
      c = bflo(pr0.y); q = bflo(pr1.y); r4[2] = c + (q - c) * mu_r.z;
      c = bfhi(pr0.y); q = bfhi(pr1.y); r4[3] = c + (q - c) * mu_r.w;
      c = bflo(pk0.x); q = bflo(pk1.x); k4[0] = c + (q - c) * mu_k.x;
      c = bfhi(pk0.x); q = bfhi(pk1.x); k4[1] = c + (q - c) * mu_k.y;
      c = bflo(pk0.y); q = bflo(pk1.y); k4[2] = c + (q - c) * mu_k.z;
      c = bfhi(pk0.y); q = bfhi(pk1.y); k4[3] = c + (q - c) * mu_k.w;
      c = bflo(pv0.x); q = bflo(pv1.x); v4[0] = c + (q - c) * mu_v.x;
      c = bfhi(pv0.x); q = bfhi(pv1.x); v4[1] = c + (q - c) * mu_v.y;
      c = bflo(pv0.y); q = bflo(pv1.y); v4[2] = c + (q - c) * mu_v.z;
      c = bfhi(pv0.y); q = bfhi(pv1.y); v4[3] = c + (q - c) * mu_v.w;
    }
    *(float4*)&L.r[pt][pc] = make_float4(r4[0], r4[1], r4[2], r4[3]);
    *(float4*)&L.v[pt][pc] = make_float4(v4[0], v4[1], v4[2], v4[3]);
    {
      u16* dstp = (lc < 64) ? &L.xw[pt][lc] : (lc < 128) ? &L.xa[pt][lc - 64] : &L.xg[pt][lc - 128];
      *(uint4*)dstp = pl0;
      *(uint4*)(dstp + 8) = pl1;
    }
    __syncthreads();
    {
      f32x4 cw = {0.f, 0.f, 0.f, 0.f}, ca = {0.f, 0.f, 0.f, 0.f}, cg_ = {0.f, 0.f, 0.f, 0.f};
#pragma unroll
      for (int ks = 0; ks < 2; ++ks) {
        bf16x8 xa_ = *(const bf16x8*)&L.xw[fr][ks * 32 + fq * 8];
        cw = __builtin_amdgcn_mfma_f32_16x16x32_bf16(xa_, *(const bf16x8*)&L.w2s[wid * 16 + fr][ks * 32 + fq * 8], cw, 0, 0, 0);
        bf16x8 xb_ = *(const bf16x8*)&L.xa[fr][ks * 32 + fq * 8];
        ca = __builtin_amdgcn_mfma_f32_16x16x32_bf16(xb_, *(const bf16x8*)&L.a2s[wid * 16 + fr][ks * 32 + fq * 8], ca, 0, 0, 0);
      }
#pragma unroll
      for (int ks = 0; ks < 4; ++ks) {
        bf16x8 xc_ = *(const bf16x8*)&L.xg[fr][ks * 32 + fq * 8];
        cg_ = __builtin_amdgcn_mfma_f32_16x16x32_bf16(xc_, *(const bf16x8*)&L.g2s[wid * 16 + fr][ks * 32 + fq * 8], cg_, 0, 0, 0);
      }
      const int ch = wid * 16 + fr;
#pragma unroll
      for (int j = 0; j < 4; ++j) {
        int tk = fq * 4 + j;
        L.w[tk][ch] = __expf(-0.6065306597126334f * sigm(w0c + cw[j]));
        L.y[tk][ch] = sigm(a0c + ca[j]);
        L.g[tk][ch] = f2bf(cg_[j]);
      }
    }
    __syncthreads();
    {
      float4 al4 = *(const float4*)&L.y[pt][pc];
      const float4 kk_c = *(const float4*)&L.cst[3][pc], ka_c = *(const float4*)&L.cst[4][pc], rk_c = *(const float4*)&L.cst[5][pc];
      float kk0 = k4[0] * kk_c.x, kk1 = k4[1] * kk_c.y, kk2 = k4[2] * kk_c.z, kk3 = k4[3] * kk_c.w;
      float ss = row16_sum(kk0 * kk0 + kk1 * kk1 + kk2 * kk2 + kk3 * kk3);
      float inv = 1.f / fmaxf(sqrtf(ss), 1e-12f);
      kk0 *= inv; kk1 *= inv; kk2 *= inv; kk3 *= inv;
      *(float4*)&L.a[pt][pc] = make_float4(-kk0, -kk1, -kk2, -kk3);
      *(float4*)&L.b[pt][pc] = make_float4(kk0 * al4.x, kk1 * al4.y, kk2 * al4.z, kk3 * al4.w);
      float km0 = k4[0] * (1.f + (al4.x - 1.f) * ka_c.x);
      float km1 = k4[1] * (1.f + (al4.y - 1.f) * ka_c.y);
      float km2 = k4[2] * (1.f + (al4.z - 1.f) * ka_c.z);
      float km3 = k4[3] * (1.f + (al4.w - 1.f) * ka_c.w);
      *(float4*)&L.k[pt][pc] = make_float4(km0, km1, km2, km3);
      float bs = row16_sum(r4[0] * km0 * rk_c.x + r4[1] * km1 * rk_c.y + r4[2] * km2 * rk_c.z + r4[3] * km3 * rk_c.w);
      if ((tid & 15) == 0) L.bonus[pt] = bs;
    }
    if (t0 + TC < 2048) PREFETCH(t0 + TC)
    __syncthreads();
    {
#define LDVEC(dst, arr, t)                                         \
  {                                                                \
    const f32x4* p4_ = (const f32x4*)&L.arr[t][cq * 8];            \
    f32x4 v0_ = p4_[0], v1_ = p4_[1];                              \
    dst[0] = (f32x2){v0_[0], v0_[1]}; dst[1] = (f32x2){v0_[2], v0_[3]}; \
    dst[2] = (f32x2){v1_[0], v1_[1]}; dst[3] = (f32x2){v1_[2], v1_[3]}; \
  }
      f32x2 cA[4];
      LDVEC(cA, a, 0)
      f32x2 cv = *(const f32x2*)&L.v[0][rp * 2];
#pragma unroll 2
      for (int t = 0; t < TC; ++t) {
        f32x2 nA[4], cW[4], cB[4], cK[4], cR[4];
        const int tn = (t + 1 < TC) ? t + 1 : t;
        LDVEC(cW, w, t) LDVEC(cB, b, t) LDVEC(cK, k, t)
        LDVEC(nA, a, tn)
        const f32x2 nv = *(const f32x2*)&L.v[tn][rp * 2];
        LDVEC(cR, r, t)
        f32x2 p0 = S2[0][0] * cA[0], p1 = S2[0][1] * cA[1], q0 = S2[1][0] * cA[0], q1 = S2[1][1] * cA[1];
        p0 = S2[0][2] * cA[2] + p0; p1 = S2[0][3] * cA[3] + p1; q0 = S2[1][2] * cA[2] + q0; q1 = S2[1][3] * cA[3] + q1;
        p0 = p0 + p1; q0 = q0 + q1;
        const float sa0 = oct_sum(p0[0] + p0[1]);
        const float sa1 = oct_sum(q0[0] + q0[1]);
        const f32x2 sav0 = {sa0, sa0}, sav1 = {sa1, sa1}, vv0 = {cv[0], cv[0]}, vv1 = {cv[1], cv[1]};
#pragma unroll
        for (int j = 0; j < 4; ++j) {
          S2[0][j] = S2[0][j] * cW[j] + (sav0 * cB[j] + vv0 * cK[j]);
          S2[1][j] = S2[1][j] * cW[j] + (sav1 * cB[j] + vv1 * cK[j]);
        }
        f32x2 y0 = S2[0][0] * cR[0], y1 = S2[0][1] * cR[1], z0 = S2[1][0] * cR[0], z1 = S2[1][1] * cR[1];
        y0 = S2[0][2] * cR[2] + y0; y1 = S2[0][3] * cR[3] + y1; z0 = S2[1][2] * cR[2] + z0; z1 = S2[1][3] * cR[3] + z1;
        y0 = y0 + y1; z0 = z0 + z1;
        const float ya = oct_sum(y0[0] + y0[1]);
        const float yb = oct_sum(z0[0] + z0[1]);
        if (cq == 0) *(f32x2*)&L.y[t][rp * 2] = (f32x2){ya, yb};
#pragma unroll
        for (int j = 0; j < 4; ++j) cA[j] = nA[j];
        cv = nv;
      }
#undef LDVEC
    }
    __syncthreads();
    {
      const float4 lg_c = *(const float4*)&L.cst[6][pc], lb_c = *(const float4*)&L.cst[7][pc];
      float4 y4 = *(const float4*)&L.y[pt][pc];
      float4 g4;
      {
        uint2 gq = *(const uint2*)&L.g[pt][pc];
        g4 = make_float4(bflo(gq.x), bfhi(gq.x), bflo(gq.y), bfhi(gq.y));
      }
      float4 vv = *(const float4*)&L.v[pt][pc];
      float bs = L.bonus[pt];
      float mean = row16_sum(y4.x + y4.y + y4.z + y4.w) * (1.f / 64.f);
      float d0 = y4.x - mean, d1 = y4.y - mean, d2 = y4.z - mean, d3 = y4.w - mean;
      float var = row16_sum(d0 * d0 + d1 * d1 + d2 * d2 + d3 * d3) * (1.f / 64.f);
      float rs = rsqrtf(var + 64e-5f);
      float o0 = (d0 * rs * lg_c.x + lb_c.x + bs * vv.x) * g4.x;
      float o1 = (d1 * rs * lg_c.y + lb_c.y + bs * vv.y) * g4.y;
      float o2 = (d2 * rs * lg_c.z + lb_c.z + bs * vv.z) * g4.z;
      float o3 = (d3 * rs * lg_c.w + lb_c.w + bs * vv.w) * g4.w;
      uint2 o; o.x = pack2(o0, o1); o.y = pack2(o2, o3);
      *(uint2*)(p.bufB + (tok0 + t0 + pt) * 1024 + ec) = o;
    }
    __syncthreads();
  }
}

struct AttnLds {
  u16 q[64][72];
  u16 k[192][72];
  u16 vt[64][200];
};

DEVINL void attn_unit(const Params& p, int u, char* smem) {
  AttnLds& L = *(AttnLds*)smem;
  const int tid = threadIdx.x, lane = tid & 63, wid = tid >> 6;
  const int fr = lane & 15, fq = lane >> 4;
  const int g = u >> 11;
  int rem = u & 2047;
  const int b = rem >> 7; rem &= 127;
  const int hh = rem >> 5;
  const int w = rem & 31;
  const int dsh = g * 2;
  const int d = 1 << dsh;
  const int nqb = 32 >> dsh;
  const int r = w / nqb, qb = w % nqb;
  const int l0 = qb * 64;
  const int kl0 = l0 - 128;
  const int gh = g * 4 + hh;
  const size_t tokb = (size_t)b * 2048;
  const int rowi = tid >> 2, qd = tid & 3;

  __syncthreads();
#pragma unroll 1
  for (int pass = 0; pass < 7; ++pass) {
    int kind = (pass == 0) ? 0 : (pass < 4 ? 1 : 2);
    int lrow = (pass == 0) ? rowi : (pass < 4 ? (pass - 1) * 64 + rowi : (pass - 4) * 64 + rowi);
    int sub = (kind == 0) ? (l0 + lrow) : (kl0 + lrow);
    bool valid = sub >= 0;
    int pos = sub * d + r;
    float xv[16];
    if (valid) {
      const u16* src = p.z_attn + (tokb + pos) * 2304 + kind * 768 + gh * 64 + qd * 16;
      uint4 a = *(const uint4*)src, c = *(const uint4*)(src + 8);
      uint32_t wv[8] = {a.x, a.y, a.z, a.w, c.x, c.y, c.z, c.w};
#pragma unroll
      for (int i = 0; i < 8; ++i) { xv[2 * i] = bflo(wv[i]); xv[2 * i + 1] = bfhi(wv[i]); }
    } else {
#pragma unroll
      for (int i = 0; i < 16; ++i) xv[i] = 0.f;
    }
    if (kind < 2) {
      uint32_t o[8];
#pragma unroll
      for (int i = 0; i < 8; ++i) o[i] = pack2(xv[2 * i], xv[2 * i + 1]);
      u16* dst = (kind == 0) ? &L.q[lrow][qd * 16] : &L.k[lrow][qd * 16];
      *(uint4*)dst = make_uint4(o[0], o[1], o[2], o[3]);
      *(uint4*)(dst + 8) = make_uint4(o[4], o[5], o[6], o[7]);
    } else {
#pragma unroll
      for (int i = 0; i < 16; ++i) L.vt[qd * 16 + i][lrow] = f2bf(xv[i]);
    }
  }
  __syncthreads();
  bf16x8 qf[2];
#pragma unroll
  for (int ks = 0; ks < 2; ++ks) qf[ks] = *(const bf16x8*)&L.q[wid * 16 + fr][ks * 32 + fq * 8];
  f32x4 sc[9];
#pragma unroll
  for (int i = 0; i < 9; ++i) {
    int kt = wid + i;
    f32x4 a = {0.f, 0.f, 0.f, 0.f};
#pragma unroll
    for (int ks = 0; ks < 2; ++ks) {
      bf16x8 kf = *(const bf16x8*)&L.k[kt * 16 + fr][ks * 32 + fq * 8];
      a = __builtin_amdgcn_mfma_f32_16x16x32_bf16(kf, qf[ks], a, 0, 0, 0);
    }
    sc[i] = a;
  }
  const int ql = wid * 16 + fr;
  float mx = -1e30f;
#pragma unroll
  for (int i = 0; i < 9; ++i)
#pragma unroll
    for (int j = 0; j < 4; ++j) {
      int kl = (wid + i) * 16 + fq * 4 + j;
      bool ok = (kl >= ql) && (kl <= ql + 128) && (kl0 + kl >= 0);
      float s = ok ? sc[i][j] : -1e30f;
      sc[i][j] = s;
      mx = fmaxf(mx, s);
    }
  mx = fmaxf(mx, __shfl_xor(mx, 16));
  mx = fmaxf(mx, __shfl_xor(mx, 32));
  float lsum = 0.f;
  bf16x4 pf[9];
#pragma unroll
  for (int i = 0; i < 9; ++i) {
    float e0 = __expf(sc[i][0] - mx), e1 = __expf(sc[i][1] - mx), e2 = __expf(sc[i][2] - mx), e3 = __expf(sc[i][3] - mx);
    lsum += (e0 + e1) + (e2 + e3);
    pf[i][0] = (short)f2bf(e0); pf[i][1] = (short)f2bf(e1); pf[i][2] = (short)f2bf(e2); pf[i][3] = (short)f2bf(e3);
  }
  lsum += __shfl_xor(lsum, 16);
  lsum += __shfl_xor(lsum, 32);
  f32x4 oacc[4];
#pragma unroll
  for (int db = 0; db < 4; ++db) oacc[db] = (f32x4){0.f, 0.f, 0.f, 0.f};
#pragma unroll
  for (int i = 0; i < 9; ++i) {
    int kt = wid + i;
#pragma unroll
    for (int db = 0; db < 4; ++db) {
      bf16x4 vf = *(const bf16x4*)&L.vt[db * 16 + fr][kt * 16 + fq * 4];
      oacc[db] = __builtin_amdgcn_mfma_f32_16x16x16bf16_1k(vf, pf[i], oacc[db], 0, 0, 0);
    }
  }
  const float invl = 1.f / lsum;
  const int posq = (l0 + ql) * d + r;
  u16* od = p.z_attn + (tokb + posq) * 2304 + gh * 64;
#pragma unroll
  for (int db = 0; db < 4; ++db) {
    uint2 o;
    o.x = pack2(oacc[db][0] * invl, oacc[db][1] * invl);
    o.y = pack2(oacc[db][2] * invl, oacc[db][3] * invl);
    *(uint2*)(od + db * 16 + fq * 4) = o;
  }
  if (fq == 0) p.lse[((size_t)g * T + tokb + posq) * 4 + hh] = mx + __logf(lsum);
}

DEVINL void attn_merge(const Params& p) {
  u16* ya = p.z_lora;
  const size_t n = (size_t)T * 32;
  for (size_t it = (size_t)blockIdx.x * 256 + threadIdx.x; it < n; it += (size_t)gridDim.x * 256) {
    size_t tok = it >> 5;
    int c8 = (int)(it & 31) * 8;
    int hh = c8 >> 6;
    float l0 = p.lse[((size_t)0 * T + tok) * 4 + hh];
    float l1 = p.lse[((size_t)1 * T + tok) * 4 + hh];
    float l2 = p.lse[((size_t)2 * T + tok) * 4 + hh];
    float m = fmaxf(l0, fmaxf(l1, l2));
    float e0 = __expf(l0 - m), e1 = __expf(l1 - m), e2 = __expf(l2 - m);
    float inv = 1.f / (e0 + e1 + e2);
    e0 *= inv; e1 *= inv; e2 *= inv;
    const u16* zr = p.z_attn + tok * 2304 + c8;
    uint4 a = *(const uint4*)(zr), bq = *(const uint4*)(zr + 256), cq = *(const uint4*)(zr + 512);
    uint32_t aw[4] = {a.x, a.y, a.z, a.w}, bw[4] = {bq.x, bq.y, bq.z, bq.w}, cw[4] = {cq.x, cq.y, cq.z, cq.w};
    uint32_t o[4];
#pragma unroll
    for (int i = 0; i < 4; ++i) {
      float lo = e0 * bflo(aw[i]) + e1 * bflo(bw[i]) + e2 * bflo(cw[i]);
      float hi = e0 * bfhi(aw[i]) + e1 * bfhi(bw[i]) + e2 * bfhi(cw[i]);
      o[i] = pack2(lo, hi);
    }
    *(uint4*)(ya + tok * 256 + c8) = make_uint4(o[0], o[1], o[2], o[3]);
  }
}

DEVINL uint32_t sortable(float s) {
  uint32_t u = __float_as_uint(s);
  return (u & 0x80000000u) ? ~u : (u | 0x80000000u);
}

DEVINL void ce_desc(uint32_t& a, uint32_t& b) {
  const uint32_t hi = max(a, b), lo = min(a, b);
  a = hi; b = lo;
}
DEVINL void bitonic_sort_desc16(uint32_t (&a)[16]) {
#pragma unroll
  for (int lk = 1; lk <= 4; ++lk) {
#pragma unroll
    for (int lj = 3; lj >= 0; --lj) {
      if (lj < lk) {
        const int k = 1 << lk, j = 1 << lj;
#pragma unroll
        for (int i = 0; i < 16; ++i) {
          const int l = i ^ j;
          if (l > i) {
            if ((i & k) == 0) ce_desc(a[i], a[l]); else ce_desc(a[l], a[i]);
          }
        }
      }
    }
  }
}
DEVINL void bitonic_merge_desc16(uint32_t (&a)[16]) {
#pragma unroll
  for (int lj = 3; lj >= 0; --lj) {
    const int j = 1 << lj;
#pragma unroll
    for (int i = 0; i < 16; ++i) {
      const int l = i ^ j;
      if (l > i) ce_desc(a[i], a[l]);
    }
  }
}
template <int CTRL>
DEVINL uint32_t dpp_u(uint32_t x) { return (uint32_t)__builtin_amdgcn_update_dpp(0, (int)x, CTRL, 0xF, 0xF, true); }

constexpr int RS = 133;
DEVINL void peer_route_a(const Params& p, const u16* qp, float* lv, int* li, char* smem) {
  const int tid = threadIdx.x, lane = tid & 63, wid = tid >> 6;
  const int fr = lane & 15, fq = lane >> 4;
  const int role = blockIdx.x & 1;
  const int nblk = gridDim.x >> 1, bidx = blockIdx.x >> 1;
  u16(*sK)[136] = (u16(*)[136])smem;
  float* sS = (float*)(smem + 128 * 136 * 2);
  __syncthreads();
  {
    const u16* kb = role ? p.k2b : p.k1b;
    for (int c = tid; c < 128 * 16; c += 256) {
      const int r = c >> 4, ch = c & 15;
      *(u32x4*)&sK[r][ch * 8] = *(const u32x4*)(kb + r * 128 + ch * 8);
    }
  }
  __syncthreads();
  float* lvr = lv + (size_t)role * T * 128;
  int* lir = li + (size_t)role * T * 128;
  for (int unit = bidx; unit < 4096; unit += nblk) {
    const int tok0 = (unit >> 1) * 16, hsel = unit & 1;
    const int head = hsel * 4 + wid;
    bf16x8 af[4];
#pragma unroll
    for (int ks = 0; ks < 4; ++ks)
      af[ks] = *(const bf16x8*)(qp + (size_t)(tok0 + fr) * 2048 + head * 256 + role * 128 + ks * 32 + fq * 8);
    __syncthreads();
#pragma unroll
    for (int nt = 0; nt < 8; ++nt) {
      f32x4 a = {0.f, 0.f, 0.f, 0.f};
#pragma unroll
      for (int ks = 0; ks < 4; ++ks) {
        bf16x8 bfg = *(const bf16x8*)&sK[nt * 16 + fr][ks * 32 + fq * 8];
        a = __builtin_amdgcn_mfma_f32_16x16x32_bf16(af[ks], bfg, a, 0, 0, 0);
      }
      const int key = nt * 16 + fr;
#pragma unroll
      for (int j = 0; j < 4; ++j) sS[(wid * 16 + fq * 4 + j) * RS + (key >> 5) * 33 + (key & 31)] = a[j];
    }
    __syncthreads();
    const int inst = tid >> 2, part = tid & 3;
    const float* row = sS + inst * RS;
    uint32_t top[16], grp[16];
#pragma unroll
    for (int i = 0; i < 16; ++i) {
      top[i] = (sortable(row[part * 33 + i]) & 0xFFFFFF80u) | (uint32_t)(127 - (part * 32 + i));
      grp[i] = (sortable(row[part * 33 + 16 + i]) & 0xFFFFFF80u) | (uint32_t)(127 - (part * 32 + 16 + i));
    }
    bitonic_sort_desc16(top);
    bitonic_sort_desc16(grp);
#pragma unroll
    for (int i = 0; i < 16; ++i) top[i] = max(top[i], grp[15 - i]);
    bitonic_merge_desc16(top);
#pragma unroll
    for (int i = 0; i < 16; ++i) grp[i] = dpp_u<0xB1>(top[i]);
#pragma unroll
    for (int i = 0; i < 16; ++i) top[i] = max(top[i], grp[15 - i]);
    bitonic_merge_desc16(top);
#pragma unroll
    for (int i = 0; i < 16; ++i) grp[i] = dpp_u<0x4E>(top[i]);
#pragma unroll
    for (int i = 0; i < 16; ++i) top[i] = max(top[i], grp[15 - i]);
    bitonic_merge_desc16(top);
    if (part == 0) {
      const int tk = inst & 15, hl = inst >> 4;
      const size_t ob = ((size_t)(tok0 + tk) * 8 + hsel * 4 + hl) * 16;
#pragma unroll
      for (int q4 = 0; q4 < 4; ++q4) {
        const int k0 = 127 - (int)(top[q4 * 4] & 127u), k1 = 127 - (int)(top[q4 * 4 + 1] & 127u);
        const int k2 = 127 - (int)(top[q4 * 4 + 2] & 127u), k3 = 127 - (int)(top[q4 * 4 + 3] & 127u);
        *(float4*)(lvr + ob + q4 * 4) = make_float4(row[(k0 >> 5) * 33 + (k0 & 31)], row[(k1 >> 5) * 33 + (k1 & 31)],
                                                    row[(k2 >> 5) * 33 + (k2 & 31)], row[(k3 >> 5) * 33 + (k3 & 31)]);
        *(int4*)(lir + ob + q4 * 4) = make_int4(k0, k1, k2, k3);
      }
    }
  }
}

DEVINL void peer_route_b(const float* lv, const int* li, int* idx_out, float* gate_out) {
  const float* lv1 = lv; const float* lv2 = lv + (size_t)T * 128;
  const int* li1 = li; const int* li2 = li + (size_t)T * 128;
  for (size_t it = (size_t)blockIdx.x * 256 + threadIdx.x; it < (size_t)T * 8; it += (size_t)gridDim.x * 256) {
    const size_t ob = it * 16;
    float v1[16], v2[16];
#pragma unroll
    for (int q = 0; q < 4; ++q) {
      float4 a = *(const float4*)(lv1 + ob + q * 4), b = *(const float4*)(lv2 + ob + q * 4);
      v1[q * 4] = a.x; v1[q * 4 + 1] = a.y; v1[q * 4 + 2] = a.z; v1[q * 4 + 3] = a.w;
      v2[q * 4] = b.x; v2[q * 4 + 1] = b.y; v2[q * 4 + 2] = b.z; v2[q * 4 + 3] = b.w;
    }
    uint32_t top[16];
#pragma unroll
    for (int j = 0; j < 16; ++j) top[j] = 0u;
#pragma unroll
    for (int i = 0; i < 16; ++i)
#pragma unroll
      for (int j = 0; j < 16; ++j)
        if ((i + 1) * (j + 1) <= 16) {
          uint32_t key = (sortable(v1[i] + v2[j]) & 0xFFFFFF00u) | (uint32_t)(255 - (i * 16 + j));
#pragma unroll
          for (int s_ = 0; s_ < 16; ++s_) {
            uint32_t hi = max(top[s_], key);
            key = min(top[s_], key);
            top[s_] = hi;
          }
        }
    float val[16];
    int eid[16];
    float mx = -1e30f;
#pragma unroll
    for (int s_ = 0; s_ < 16; ++s_) {
      const int cidx = 255 - (int)(top[s_] & 255u);
      const int i = cidx >> 4, j = cidx & 15;
      val[s_] = lv1[ob + i] + lv2[ob + j];
      eid[s_] = li1[ob + i] * 128 + li2[ob + j];
      mx = fmaxf(mx, val[s_]);
    }
    float sum = 0.f;
#pragma unroll
    for (int s_ = 0; s_ < 16; ++s_) { val[s_] = __expf(val[s_] - mx); sum += val[s_]; }
    const float inv = 1.f / sum;
#pragma unroll
    for (int s4 = 0; s4 < 4; ++s4) {
      *(int4*)(idx_out + ob + s4 * 4) = make_int4(eid[s4 * 4], eid[s4 * 4 + 1], eid[s4 * 4 + 2], eid[s4 * 4 + 3]);
      *(float4*)(gate_out + ob + s4 * 4) = make_float4(val[s4 * 4] * inv, val[s4 * 4 + 1] * inv, val[s4 * 4 + 2] * inv, val[s4 * 4 + 3] * inv);
    }
  }
}

DEVINL void dec16(const uint2& w, f32x2 (&d)[8]) {
  d[0] = __builtin_amdgcn_cvt_scalef32_pk_f32_fp4(w.x, 1.0f, 0);
  d[1] = __builtin_amdgcn_cvt_scalef32_pk_f32_fp4(w.x, 1.0f, 1);
  d[2] = __builtin_amdgcn_cvt_scalef32_pk_f32_fp4(w.x, 1.0f, 2);
  d[3] = __builtin_amdgcn_cvt_scalef32_pk_f32_fp4(w.x, 1.0f, 3);
  d[4] = __builtin_amdgcn_cvt_scalef32_pk_f32_fp4(w.y, 1.0f, 0);
  d[5] = __builtin_amdgcn_cvt_scalef32_pk_f32_fp4(w.y, 1.0f, 1);
  d[6] = __builtin_amdgcn_cvt_scalef32_pk_f32_fp4(w.y, 1.0f, 2);
  d[7] = __builtin_amdgcn_cvt_scalef32_pk_f32_fp4(w.y, 1.0f, 3);
}

DEVINL void peer_gather(const Params& p, const u16* n2, const int* idx, const float* gate, u16* dry = nullptr) {
  const int lane = threadIdx.x & 63, wid = threadIdx.x >> 6;
  const int nw = gridDim.x * 4;
  const unsigned char* ub4 = (const unsigned char*)p.ub;
  const unsigned char* vb4 = (const unsigned char*)p.vb;
  const auto urs = __builtin_amdgcn_make_buffer_rsrc((void*)ub4, 0, 16384 * 512, 0x00020000);
  const auto vrs = __builtin_amdgcn_make_buffer_rsrc((void*)vb4, 0, 16384 * 512, 0x00020000);
  for (int tok = blockIdx.x * 4 + wid; tok < T; tok += nw) {
    f32x2 xn[8], acc2[8];
    {
      const uint4* np = (const uint4*)(n2 + (size_t)tok * 1024 + lane * 16);
      uint4 a = np[0], c = np[1];
      uint32_t wv[8] = {a.x, a.y, a.z, a.w, c.x, c.y, c.z, c.w};
#pragma unroll
      for (int i = 0; i < 8; ++i) xn[i] = (f32x2){bflo(wv[i]), bfhi(wv[i])};
    }
#pragma unroll
    for (int i = 0; i < 8; ++i) acc2[i] = (f32x2){0.f, 0.f};
    const int id0 = idx[(size_t)tok * 128 + lane], id1 = idx[(size_t)tok * 128 + 64 + lane];
    const float g0 = gate[(size_t)tok * 128 + lane], g1 = gate[(size_t)tok * 128 + 64 + lane];
    const float us0 = p.usc[id0], us1 = p.usc[id1];
    const float gvs0 = g0 * p.vsc[id0], gvs1 = g1 * p.vsc[id1];
    const bool b3 = (lane & 8) != 0, b2 = (lane & 4) != 0, b1 = (lane & 2) != 0, b0 = (lane & 1) != 0;
    const int loff = lane * 8;
#pragma unroll 1
    for (int e = 0; e < 128; e += 16) {
      const int idv = (e < 64) ? id0 : id1;
      const int eb = e & 63;
      uint2 ur[16], vr[16];
#pragma unroll
      for (int q = 0; q < 16; ++q) {
        const int id = __builtin_amdgcn_readlane(idv, eb + q);
        {
          const u32x2 a_ = __builtin_amdgcn_raw_buffer_load_b64(urs, loff, id * 512, 0);
          const u32x2 b_ = __builtin_amdgcn_raw_buffer_load_b64(vrs, loff, id * 512, 0);
          ur[q] = make_uint2(a_[0], a_[1]);
          vr[q] = make_uint2(b_[0], b_[1]);
        }
      }
      float pr[16];
#pragma unroll
      for (int q = 0; q < 16; ++q) {
        f32x2 d[8];
        dec16(ur[q], d);
        f32x2 s0 = xn[0] * d[0], s1 = xn[1] * d[1];
        s0 = xn[2] * d[2] + s0; s1 = xn[3] * d[3] + s1;
        s0 = xn[4] * d[4] + s0; s1 = xn[5] * d[5] + s1;
        s0 = xn[6] * d[6] + s0; s1 = xn[7] * d[7] + s1;
        s0 = s0 + s1;
        pr[q] = s0[0] + s0[1];
      }
      float ra[8], rb[4], rc[2];
#pragma unroll
      for (int q = 0; q < 8; ++q) ra[q] = (b3 ? pr[q + 8] : pr[q]) + dpp_f<0x128>(b3 ? pr[q] : pr[q + 8]);
#pragma unroll
      for (int q = 0; q < 4; ++q) rb[q] = (b2 ? ra[q + 4] : ra[q]) + dpp_f<0x141>(b2 ? ra[q] : ra[q + 4]);
#pragma unroll
      for (int q = 0; q < 2; ++q) rc[q] = (b1 ? rb[q + 2] : rb[q]) + dpp_f<0x4E>(b1 ? rb[q] : rb[q + 2]);
      float mine = (b0 ? rc[1] : rc[0]) + dpp_f<0xB1>(b0 ? rc[0] : rc[1]);
      mine += __shfl_xor(mine, 16);
      mine += __shfl_xor(mine, 32);
      const int sl = eb + (lane & 15);
      const float act = mine * __shfl((e < 64) ? us0 : us1, sl);
      const float coefv = __shfl((e < 64) ? gvs0 : gvs1, sl) * 0.5f * act * (1.f + erff(act * 0.7071067811865476f));
#pragma unroll
      for (int q = 0; q < 16; ++q) {
        const float coef = __int_as_float(__builtin_amdgcn_readlane(__float_as_int(coefv), q));
        const f32x2 c2 = {coef, coef};
        f32x2 d[8];
        dec16(vr[q], d);
#pragma unroll
        for (int i = 0; i < 8; ++i) acc2[i] = c2 * d[i] + acc2[i];
      }
    }
    float acc[16];
#pragma unroll
    for (int i = 0; i < 8; ++i) { acc[2 * i] = acc2[i][0]; acc[2 * i + 1] = acc2[i][1]; }
    const float* gt2 = p.mod + (tok >> 11) * 6144 + 5120 + lane * 16;
    float* op = p.out + (size_t)tok * 1024 + lane * 16;
#pragma unroll
    for (int i = 0; i < 4; ++i) {
      float4 hv = *(const float4*)(op + i * 4);
      float4 gv4 = *(const float4*)(gt2 + i * 4);
      hv.x += gv4.x * acc[i * 4]; hv.y += gv4.y * acc[i * 4 + 1];
      hv.z += gv4.z * acc[i * 4 + 2]; hv.w += gv4.w * acc[i * 4 + 3];
      if (dry) {
        uint2 o; o.x = pack2(hv.x, hv.y); o.y = pack2(hv.z, hv.w);
        *(uint2*)(dry + (size_t)tok * 1024 + lane * 16 + i * 4) = o;
      } else {
        *(float4*)(op + i * 4) = hv;
      }
    }
  }
}


#define XB_TMO      128
#define XB_XCNT(j)  (256  + 64 * (j))
#define XB_XSUB(j)  (1280 + 64 * (j))
#define XB_XGEN(j)  (2304 + 64 * (j))
#define XB_TOP      3328
#define XB_TOPGEN   3392
#define XCD_BAR_WORDS 3456
#define XB_SPIN_CAP (1u << 18)
#define LAS __attribute__((address_space(3)))
DEVINL unsigned xb_ld(unsigned* p) { return __hip_atomic_load(p, __ATOMIC_RELAXED, __HIP_MEMORY_SCOPE_AGENT); }
DEVINL unsigned xb_add(unsigned* p, unsigned v) { return __hip_atomic_fetch_add(p, v, __ATOMIC_RELAXED, __HIP_MEMORY_SCOPE_AGENT); }
DEVINL unsigned xb_xcc_id() { return (unsigned)__builtin_amdgcn_s_getreg((3 << 11) | 20) & 0xFu; }
#define XB_SPIN(cond, bar) do { unsigned _sp = 0; while (cond) { __builtin_amdgcn_s_sleep(1); \
    if ((++_sp & 255u) == 0u) { if (xb_ld(&(bar)[XB_TMO])) break; if (_sp > XB_SPIN_CAP) { atomicAdd(&(bar)[XB_TMO], 1u); break; } } } } while (0)
struct XcdBarrier { unsigned* bar; unsigned x; volatile LAS unsigned* st; };
DEVINL XcdBarrier xcd_barrier_post(unsigned* bar, volatile LAS unsigned* st) {
  XcdBarrier b; b.bar = bar; b.x = xb_xcc_id(); b.st = st;
  if (threadIdx.x == 0) (void)xb_add(&bar[XB_XCNT(b.x)], 1u);
  return b;
}
DEVINL void xcd_barrier_complete(unsigned* bar, unsigned x, unsigned& nloc, unsigned& nx) {
  const unsigned G = gridDim.x * gridDim.y * gridDim.z;
  unsigned sum, cnt, mine, sp = 0u;
  for (;;) {
    sum = 0u; cnt = 0u; mine = 0u;
#pragma unroll
    for (unsigned j = 0; j < 16; ++j) { const unsigned c = xb_ld(&bar[XB_XCNT(j)]); sum += c; cnt += (c > 0u) ? 1u : 0u; mine = (j == x) ? c : mine; }
    if (sum == G) break;
    __builtin_amdgcn_s_sleep(1);
    if ((++sp & 255u) == 0u) { if (xb_ld(&bar[XB_TMO])) break; if (sp > XB_SPIN_CAP) { atomicAdd(&bar[XB_TMO], 1u); break; } }
  }
  nloc = mine > 0u ? mine : 1u; nx = cnt > 0u ? cnt : 1u;
}
DEVINL void xcd_barrier(const XcdBarrier& b) {
  asm volatile("s_waitcnt vmcnt(0)" ::: "memory");
  __syncthreads();
  if (threadIdx.x == 0) {
    unsigned* bar = b.bar;
    __builtin_amdgcn_s_waitcnt(0);
    unsigned nloc = b.st[0], nx = b.st[1];
    if (nloc == 0u) { xcd_barrier_complete(bar, b.x, nloc, nx); b.st[0] = nloc; b.st[1] = nx; }
    const unsigned old = xb_add(&bar[XB_XSUB(b.x)], 1u);
    const unsigned gen = old / nloc;
    if (old + 1u == (gen + 1u) * nloc) {
      __builtin_amdgcn_fence(__ATOMIC_RELEASE, "agent");
      asm volatile("s_waitcnt vmcnt(0)" ::: "memory");
      const unsigned og = xb_add(&bar[XB_TOP], 1u);
      const unsigned tg = og / nx;
      if (og + 1u == (tg + 1u) * nx) xb_add(&bar[XB_TOPGEN], 1u);
      else XB_SPIN(xb_ld(&bar[XB_TOPGEN]) == tg, bar);
      __builtin_amdgcn_fence(__ATOMIC_ACQUIRE, "agent");
      xb_add(&bar[XB_XGEN(b.x)], 1u);
      asm volatile("s_waitcnt vmcnt(0)" ::: "memory");
    } else {
      XB_SPIN(xb_ld(&bar[XB_XGEN(b.x)]) == gen, bar);
      __builtin_amdgcn_fence(__ATOMIC_ACQUIRE, "agent");
      asm volatile("s_waitcnt vmcnt(0)" ::: "memory");
    }
  }
  __syncthreads();
}

DEVINL void run_phase(const Params& p, int ph, char* smem, int cu_role = 0) {
  const int G = gridDim.x;
  u16* merged = p.z_rkv;
  u16* qpeer = p.z_rkv;
  int* pidx = (int*)p.z_attn;
  float* pgate = (float*)(p.z_attn + (size_t)T * 128 * 2);
  float* plv = (float*)((char*)p.z_attn + (size_t)T * 128 * 8);
  int* pli = (int*)((char*)p.z_attn + (size_t)T * 128 * 16);
  u16* X = (u16*)((char*)p.ub + (size_t)16384 * 1024);
  switch (ph) {
    case 0: phase0(p, smem); break;
    case 1:
      norm_rows_fp8(p);
      for (int t = blockIdx.x; t < 1920; t += G) transpose_tile_fp8(p, t, smem);
      break;
    case 2: {
      if (cu_role & 1) __builtin_amdgcn_s_sleep(22);
      Epi1 e{p};
      for_tiles(256, 60, [&](int mt, int nt) { gemm_tile<true>(p.bufB, 1024, p.w_in_t, 1024, 1024, mt * 128, nt * 128, smem, e); });
    } break;
    case 3: {
      int* sh = (int*)smem;
      const int role = cu_role;
      for (int pass = 0; pass < 2; ++pass) {
        const bool do_scan = (pass == 0) == (role == 0);
        if (do_scan) {
          for (;;) {
            __syncthreads();
            if (threadIdx.x == 0) sh[1] = atomicAdd(&p.ctr[2048], 1);
            __syncthreads();
            const int u = sh[1];
            if (u >= 256) break;
            rwkv_scan_unit(p, X, u, smem);
          }
        } else {
          for (;;) {
            __syncthreads();
            if (threadIdx.x == 0) sh[1] = atomicAdd(&p.ctr[2049], 1);
            __syncthreads();
            const int u = sh[1];
            if (u >= 6144) break;
            attn_unit(p, u, smem);
          }
          if (pass == 0) { late_transpose_queue(p, smem); cvt_fp4_queue(p, smem); }
        }
      }
      late_transpose_queue(p, smem);
      cvt_fp4_queue(p, smem);
    } break;
    case 4: attn_merge(p); break;
    case 15: prep_phase(p, X); break;
    case 5: {
      if (cu_role & 1) __builtin_amdgcn_s_sleep(22);
      Epi5a ea{p, merged};
      Epi5b eb{p, merged};
      for_tiles(256, 8, [&](int mt, int nt) {
        gemm_tile(p.bufB, 1024, p.w_br_r_t, 1024, 1024, mt * 128, nt * 128, smem, ea);
        gemm_tile(p.z_lora, 256, p.w_br_a_t, 256, 256, mt * 128, nt * 128, smem, eb);
      });
    } break;
    case 6: {
      if (cu_role & 1) __builtin_amdgcn_s_sleep(22);
      Epi6 e{p};
      for_tiles(256, 8, [&](int mt, int nt) { gemm_tile(merged, 1024, p.w_out_t, 1024, 1024, mt * 128, nt * 128, smem, e); });
    } break;
    case 7: norm_rows(p.out, p.norm2_g, p.mod, 3072, 4096, p.bufB); break;
    case 8: {
      if (cu_role & 1) __builtin_amdgcn_s_sleep(22);
      Epi8 e{qpeer};
      for_tiles(256, 16, [&](int mt, int nt) { gemm_tile(p.bufB, 1024, p.wq_t, 1024, 1024, mt * 128, nt * 128, smem, e); });
    } break;
    case 9:
      peer_route_a(p, qpeer, plv, pli, smem);
      break;
    case 16: peer_route_b(plv, pli, pidx, pgate); break;
    case 10: peer_gather(p, p.bufB, pidx, pgate); break;
    case 11: peer_gather(p, p.bufB, pidx, pgate, p.z_rkv + (size_t)T * 2048); break;
  }
}
constexpr int NPHASE = 11;

#if MULTI
__global__ void __launch_bounds__(256, 2) phase_kernel(Params p, int ph) {
  __shared__ __attribute__((aligned(16))) char smem[SMEM_BYTES];
  run_phase(p, ph, smem);
}
#else
__global__ void __launch_bounds__(256, 2) mega_kernel(Params p) {
  __shared__ __attribute__((aligned(16))) char smem[SMEM_BYTES];
  __shared__ uint4 xb_words;
  cg::grid_group grid = cg::this_grid();
  if (threadIdx.x == 0) xb_words = make_uint4(0u, 0u, 0u, 0u);
  __syncthreads();
  __shared__ int cu_role_s;
  if (threadIdx.x == 0) {
    unsigned cu = __builtin_amdgcn_s_getreg(0x3A04);
    unsigned xcc = __builtin_amdgcn_s_getreg(0x1814);
    cu_role_s = atomicAdd(&p.ctr[(xcc & 7) * 256 + (cu & 255)], 1);
  }
  __syncthreads();
  const int cu_role = cu_role_s;
  XcdBarrier xb = xcd_barrier_post(p.bar, (volatile LAS unsigned*)&xb_words);
#define SYNC() xcd_barrier(xb)
  if (p.x == nullptr) grid.sync();
  run_phase(p, 0, smem, cu_role); SYNC();
  if (DUP == 0) { run_phase(p, 0, smem, cu_role); SYNC(); }
  run_phase(p, 1, smem, cu_role); SYNC();
  if (DUP == 1) { run_phase(p, 1, smem, cu_role); SYNC(); }
  run_phase(p, 2, smem, cu_role); SYNC();
  run_phase(p, 15, smem, cu_role); SYNC();
  if (DUP == 2) { run_phase(p, 2, smem, cu_role); SYNC(); }
  run_phase(p, 3, smem, cu_role); SYNC();
  run_phase(p, 4, smem, cu_role); SYNC();
  if (DUP == 4) { run_phase(p, 4, smem, cu_role); SYNC(); }
  run_phase(p, 5, smem, cu_role); SYNC();
  if (DUP == 5) { run_phase(p, 5, smem, cu_role); SYNC(); }
  run_phase(p, 6, smem, cu_role); SYNC();
  if (DUP == 6) { run_phase(p, 6, smem, cu_role); SYNC(); }
  run_phase(p, 7, smem, cu_role); SYNC();
  if (DUP == 7) { run_phase(p, 7, smem, cu_role); SYNC(); }
  run_phase(p, 8, smem, cu_role); SYNC();
  if (DUP == 8) { run_phase(p, 8, smem, cu_role); SYNC(); }
  run_phase(p, 9, smem, cu_role); SYNC();
  run_phase(p, 16, smem, cu_role); SYNC();
  if (DUP == 9) { run_phase(p, 9, smem, cu_role); SYNC(); }
  if (DUP == 10) { run_phase(p, 11, smem, cu_role); SYNC(); }
  run_phase(p, 10, smem, cu_role);
}
#endif

extern "C" void kernel_launch(void* const* d_in, const int* in_sizes, int n_in, void* d_out, int out_size, void* d_ws,
                              size_t ws_size, hipStream_t stream) {
  Params p{};
  const float** pf = (const float**)&p;
  for (int i = 0; i < 28; ++i) pf[i] = (const float*)d_in[i];
  p.out = (float*)d_out;
  char* ws = (char*)d_ws;
  size_t off = 0;
  auto take = [&](size_t bytes) { char* r = ws + off; off += (bytes + 255) & ~(size_t)255; return r; };
  p.w_in_t = (u16*)take((size_t)7680 * 1024 * 2);
  p.w_br_r_t = (u16*)take((size_t)1024 * 1024 * 2);
  p.w_br_a_t = (u16*)take((size_t)1024 * 256 * 2);
  p.w_out_t = (u16*)take((size_t)1024 * 1024 * 2);
  p.wq_t = (u16*)take((size_t)2048 * 1024 * 2);
  p.k1b = (u16*)take(128 * 128 * 2);
  p.k2b = (u16*)take(128 * 128 * 2);
  p.w2t = (u16*)take(1024 * 64 * 2);
  p.a2t = (u16*)take(1024 * 64 * 2);
  p.g2t = (u16*)take(1024 * 128 * 2);
  p.mod = (float*)take(16 * 6144 * 4);
  p.lse = (float*)take((size_t)3 * T * 4 * 4);
  p.bar = (unsigned*)take(4096 * 4);
  p.ctr = (int*)take(4096 * 4);
  p.colamax = (int*)take(8192 * 4);
  p.n1s = (float*)take((size_t)T * 4);
  p.w_in_s = (float*)take(8192 * 4);
  p.usc = (float*)take(16384 * 4);
  p.vsc = (float*)take(16384 * 4);
  p.bufB = (u16*)take((size_t)T * 1024 * 2);
  p.z_rkv = (u16*)take((size_t)T * 3072 * 2);
  p.z_lora = (u16*)take((size_t)T * 256 * 2);
  p.z_attn = (u16*)take((size_t)T * 2304 * 2);
  p.ub = (u16*)take((size_t)16384 * 1024 * 2);
  p.vb = (u16*)take((size_t)16384 * 1024 * 2);
  p.gates = (u16*)d_out;
  if (off > ws_size) { fprintf(stderr, "workspace too small: need %zu have %zu\n", off, ws_size); return; }
#if MULTI
  (void)hipMemsetAsync(p.bar, 0, 4 * 4096 * 4, stream);
  for (int ph = 0; ph < NPHASE; ++ph) phase_kernel<<<512, 256, 0, stream>>>(p, ph);
#else
  static int grid_blocks = 0;
  if (!grid_blocks) {
    int dev = 0, cus = 0, per_cu = 0;
    hipGetDevice(&dev);
    hipDeviceGetAttribute(&cus, hipDeviceAttributeMultiprocessorCount, dev);
    hipOccupancyMaxActiveBlocksPerMultiprocessor(&per_cu, mega_kernel, 256, 0);
    if (per_cu > 2) per_cu = 2;
    grid_blocks = cus * per_cu;
  }
  (void)hipMemsetAsync(p.bar, 0, 4 * 4096 * 4, stream);
  void* args[] = {&p};
  hipError_t e = hipLaunchCooperativeKernel((void*)mega_kernel, dim3(grid_blocks), dim3(256), args, 0, stream);
  if (e != hipSuccess) fprintf(stderr, "cooperative launch failed: %s (grid %d)\n", hipGetErrorString(e), grid_blocks);
#endif
}
```
